# Optimizing an MI355X kernel written in HIP

```python
import math
import jax
import jax.numpy as jnp
from jax import lax
import numpy as np

D_MODEL = 1024
BATCH = 32
SEQ = 256
DEPTH = 2
DEC_BATCH = 4
DEC_SEQ = 1024
PAST_LEN = 256

GRID_W = 64
N_ATTN = 4
DH_ATTN = 64
W_ATTN = N_ATTN * 2 * DH_ATTN
N_FOUR = 4
DG_FOUR = 128
W_FOUR = N_FOUR * DG_FOUR
N_MLSTM = 4
DH_MLSTM = 128
W_MLSTM = N_MLSTM * DH_MLSTM
N_GATE = 4 * N_MLSTM
P_IN = 3 * W_ATTN + W_FOUR + 4 * W_MLSTM + N_GATE
SPLIT_AT = (W_ATTN, 2 * W_ATTN, 3 * W_ATTN, 3 * W_ATTN + W_FOUR,
            3 * W_ATTN + W_FOUR + W_MLSTM, 3 * W_ATTN + W_FOUR + 2 * W_MLSTM,
            3 * W_ATTN + W_FOUR + 3 * W_MLSTM, 3 * W_ATTN + W_FOUR + 4 * W_MLSTM)
N_BRANCH = 3
D_FF = 2816
N_MOD = 9
CHUNK = 64
Q_BLOCK = 128
ROPE_BASE = 10000.0
ROPE_AXIS_PAIRS = DH_ATTN // 4
ATTN_SCALE = DH_ATTN ** -0.5
MLSTM_K_SCALE = DH_MLSTM ** -0.5
EPS = 1e-6

kernel_name = 'hybrid_diffattn_fnet_mlstm_macaron_step'


def rms_norm(x, g):
    xf = x.astype(jnp.float32)
    y = xf * lax.rsqrt(jnp.mean(xf * xf, axis=-1, keepdims=True) + EPS)
    return (y * g.astype(jnp.float32)).astype(x.dtype)


def modulate(x, shift, scale):
    return x * (1 + scale[:, None, :]) + shift[:, None, :]


def adaln(cvec, w, b):
    m = jax.nn.silu(cvec) @ w + b
    return jnp.split(m, N_MOD, axis=-1)


def swiglu(u, w_in, w_out):
    a, g = jnp.split(u @ w_in, 2, axis=-1)
    return (jax.nn.silu(a) * g) @ w_out


def grid_rope(n_tok):
    rows = n_tok // GRID_W
    row = jnp.repeat(jnp.arange(rows, dtype=jnp.float32), GRID_W)
    col = (jnp.arange(n_tok) % GRID_W).astype(jnp.float32)
    inv = ROPE_BASE ** (-jnp.arange(ROPE_AXIS_PAIRS, dtype=jnp.float32) / ROPE_AXIS_PAIRS)
    ang = jnp.concatenate([row[:, None] * inv, col[:, None] * inv], axis=-1)
    return jnp.cos(ang), jnp.sin(ang)


def apply_rope(x, cos, sin):
    B, H, T, _ = x.shape
    xm = x.reshape(B, H, T, 2, DH_ATTN)
    c = cos[:, None, :].astype(x.dtype)
    s = sin[:, None, :].astype(x.dtype)
    half = DH_ATTN // 2
    x1, x2 = xm[..., :half], xm[..., half:]
    out = jnp.concatenate([x1 * c - x2 * s, x1 * s + x2 * c], axis=-1)
    return out.reshape(B, H, T, 2 * DH_ATTN)


def diff_lambda(lam_p, lam_init):
    lp = lam_p.astype(jnp.float32)
    return jnp.exp(jnp.sum(lp[0] * lp[1])) - jnp.exp(jnp.sum(lp[2] * lp[3])) + lam_init


def diff_attention(q, k, v, lam, lam_init, g_sub):
    B, H, Tq, _ = q.shape
    nb = Tq // Q_BLOCK
    k1, k2 = k[..., :DH_ATTN], k[..., DH_ATTN:]

    def block(qb):
        s1 = jnp.einsum('bhqd,bhkd->bhqk', qb[..., :DH_ATTN], k1).astype(jnp.float32) * ATTN_SCALE
        s2 = jnp.einsum('bhqd,bhkd->bhqk', qb[..., DH_ATTN:], k2).astype(jnp.float32) * ATTN_SCALE
        p = jax.nn.softmax(s1, axis=-1) - lam * jax.nn.softmax(s2, axis=-1)
        return jnp.einsum('bhqk,bhkd->bhqd', p.astype(v.dtype), v)

    qs = jnp.moveaxis(q.reshape(B, H, nb, Q_BLOCK, 2 * DH_ATTN), 2, 0)
    o = lax.map(block, qs)
    o = jnp.moveaxis(o, 0, 2).reshape(B, H, Tq, 2 * DH_ATTN)
    return rms_norm(o, g_sub) * (1.0 - lam_init)


def fourier_mix(z):
    B, T, _ = z.shape
    zg = z.reshape(B, T, N_FOUR, DG_FOUR).astype(jnp.float32)
    f = jnp.fft.fft2(zg, axes=(1, 3), norm='ortho').real
    return f.reshape(B, T, W_FOUR).astype(z.dtype)


def mlstm_scan(q, k, v, ig, lf, C0, n0, m0):
    B, H, T, D = q.shape
    nc = T // CHUNK

    def chunks(a):
        return jnp.moveaxis(a.reshape((B, H, nc, CHUNK) + a.shape[3:]), 2, 0)

    lower = jnp.tril(jnp.ones((CHUNK, CHUNK), dtype=bool))

    def step(carry, xs):
        C, n, m = carry
        qc, kc, vc, ic, fc = xs
        b = jnp.cumsum(fc, axis=-1)
        logw = jnp.where(lower, b[..., :, None] - b[..., None, :] + ic[..., None, :], -jnp.inf)
        prev = b + m[..., None]
        m_t = jnp.maximum(prev, jnp.max(logw, axis=-1))
        w = jnp.exp(logw - m_t[..., None])
        sp = jnp.exp(prev - m_t)
        s = jnp.einsum('bhtd,bhsd->bhts', qc, kc) * w
        num = sp[..., None] * jnp.einsum('bhvk,bhtk->bhtv', C, qc) + jnp.einsum('bhts,bhsv->bhtv', s, vc)
        den = sp * jnp.einsum('bhk,bhtk->bht', n, qc) + jnp.sum(s, axis=-1)
        h = num / jnp.maximum(jnp.abs(den), jnp.exp(-m_t))[..., None]
        m_new = m_t[..., -1]
        wl = jnp.exp(b[..., -1:] - b + ic - m_new[..., None])
        decay = jnp.exp(b[..., -1] + m - m_new)
        C_new = decay[..., None, None] * C + jnp.einsum('bhs,bhsv,bhsk->bhvk', wl, vc, kc)
        n_new = decay[..., None] * n + jnp.einsum('bhs,bhsk->bhk', wl, kc)
        return (C_new, n_new, m_new), h

    (C1, n1, m1), hs = lax.scan(step, (C0, n0, m0),
                                (chunks(q), chunks(k), chunks(v), chunks(ig), chunks(lf)))
    return jnp.moveaxis(hs, 0, 2).reshape(B, H, T, D), (C1, n1, m1)


def mlstm_bidirectional(q, k, v, ig_f, lf_f, ig_b, lf_b, C0, n0, m0):
    h_f, (Cf, nf, mf) = mlstm_scan(q, k, v, ig_f, lf_f, C0[:, 0], n0[:, 0], m0[:, 0])

    def rev(a):
        return jnp.flip(a, axis=2)

    h_b, (Cb, nb, mb) = mlstm_scan(rev(q), rev(k), rev(v), rev(ig_b), rev(lf_b),
                                   C0[:, 1], n0[:, 1], m0[:, 1])
    return h_f + rev(h_b), (jnp.stack([Cf, Cb], axis=1), jnp.stack([nf, nb], axis=1),
                            jnp.stack([mf, mb], axis=1))


def token_mixer(u, lp, lam_init, ctx):
    B, T, _ = u.shape
    z = u @ lp['w_in']
    za_q, za_k, za_v, zf, zm_q, zm_k, zm_v, zm_o, zg = jnp.split(z, SPLIT_AT, axis=-1)

    def attn_heads(a):
        return a.reshape(B, T, N_ATTN, 2 * DH_ATTN).transpose(0, 2, 1, 3)

    q, k, v = attn_heads(za_q), attn_heads(za_k), attn_heads(za_v)
    if ctx is None:
        q_use, k_use, v_use = q, k, v
    else:
        k_ctx, v_ctx, C0, n0, m0 = ctx
        cos, sin = grid_rope(T)
        q_use = apply_rope(q, cos, sin)
        k_use = jnp.concatenate([k_ctx.astype(k.dtype), apply_rope(k, cos, sin)], axis=2)
        v_use = jnp.concatenate([v_ctx.astype(v.dtype), v], axis=2)
    lam = diff_lambda(lp['attn_lambda'], lam_init)
    a_out = diff_attention(q_use, k_use, v_use, lam, lam_init, lp['g_attn_sub'])
    a_out = a_out.transpose(0, 2, 1, 3).reshape(B, T, W_ATTN)

    f_out = fourier_mix(zf)

    def mlstm_heads(a):
        return a.reshape(B, T, N_MLSTM, DH_MLSTM).transpose(0, 2, 1, 3).astype(jnp.float32)

    mq, mk, mv = mlstm_heads(zm_q), mlstm_heads(zm_k) * MLSTM_K_SCALE, mlstm_heads(zm_v)
    gates = (zg + lp['b_mgate']).astype(jnp.float32).reshape(B, T, 4, N_MLSTM).transpose(2, 0, 3, 1)
    ig_f, lf_f = gates[0], jax.nn.log_sigmoid(gates[1])
    ig_b, lf_b = gates[2], jax.nn.log_sigmoid(gates[3])
    if ctx is None:
        C0 = jnp.zeros((B, 2, N_MLSTM, DH_MLSTM, DH_MLSTM), jnp.float32)
        n0 = jnp.zeros((B, 2, N_MLSTM, DH_MLSTM), jnp.float32)
        m0 = jnp.zeros((B, 2, N_MLSTM), jnp.float32)
    h, (C1, n1, m1) = mlstm_bidirectional(mq, mk, mv, ig_f, lf_f, ig_b, lf_b,
                                          C0.astype(jnp.float32), n0.astype(jnp.float32),
                                          m0.astype(jnp.float32))
    h = rms_norm(h, lp['g_mlstm']).transpose(0, 2, 1, 3).reshape(B, T, W_MLSTM).astype(u.dtype)
    m_out = h * jax.nn.sigmoid(zm_o)

    gb = jax.nn.sigmoid(u @ lp['w_branch_gate']).reshape(B, T, N_BRANCH, D_MODEL)
    merged = (gb[:, :, 0] * (a_out @ lp['w_br_attn'])
              + gb[:, :, 1] * (f_out @ lp['w_br_four'])
              + gb[:, :, 2] * (m_out @ lp['w_br_mlstm']))
    out = merged @ lp['w_out']
    if ctx is None:
        dt = u.dtype
        return out, (k, v, C1.astype(dt), n1.astype(dt), m1.astype(dt))
    return out, None


def trunk_layer(x, mods, lp, lam_init, ctx):
    sh1, sc1, gt1, sh2, sc2, gt2, sh3, sc3, gt3 = mods
    g = lp['g_norm']
    u = modulate(rms_norm(x, g[0]), sh1, sc1)
    x = x + 0.5 * gt1[:, None, :] * swiglu(u, lp['w_ffn1_in'], lp['w_ffn1_out'])
    u = modulate(rms_norm(x, g[1]), sh2, sc2)
    y, ctx_out = token_mixer(u, lp, lam_init, ctx)
    x = x + gt2[:, None, :] * y
    u = modulate(rms_norm(x, g[2]), sh3, sc3)
    x = x + 0.5 * gt3[:, None, :] * swiglu(u, lp['w_ffn2_in'], lp['w_ffn2_out'])
    return x, ctx_out


def setup_inputs(seed: int = 0) -> dict:
    key = jax.random.key(seed)
    ks = jax.random.split(key, 32)
    D = D_MODEL

    def nrm(k, shape, scale):
        return scale * jax.random.normal(k, shape, jnp.float32)

    is_forget = jnp.array([False, True, False, True])
    b_in_gate = nrm(ks[16], (DEPTH, 4, N_MLSTM), 0.1)
    b_fg_gate = 3.0 + 3.0 * jax.random.uniform(ks[17], (DEPTH, 4, N_MLSTM), jnp.float32)
    b_mgate = jnp.where(is_forget[None, :, None], b_fg_gate, b_in_gate).reshape(DEPTH, N_GATE)
    return {
        'x_prompt': nrm(ks[0], (BATCH, SEQ, D), 1.0),
        'x_sample': nrm(ks[1], (DEC_BATCH, DEC_SEQ, D), 1.0),
        'cache_k': nrm(ks[2], (DEC_BATCH, DEPTH, N_ATTN, PAST_LEN, 2 * DH_ATTN), 1.0),
        'cache_v': nrm(ks[3], (DEC_BATCH, DEPTH, N_ATTN, PAST_LEN, 2 * DH_ATTN), 1.0),
        'state_C': nrm(ks[4], (DEC_BATCH, DEPTH, 2, N_MLSTM, DH_MLSTM, DH_MLSTM), 0.3),
        'state_n': nrm(ks[5], (DEC_BATCH, DEPTH, 2, N_MLSTM, DH_MLSTM), 0.3),
        'state_m': nrm(ks[6], (DEC_BATCH, DEPTH, 2, N_MLSTM), 1.0),
        'c': nrm(ks[7], (DEC_BATCH, D), 1.0),
        'c_ctx': nrm(ks[8], (D,), 1.0),
        'w_ada': nrm(ks[9], (DEPTH, D, N_MOD * D), 0.5 * D ** -0.5),
        'b_ada': nrm(ks[10], (DEPTH, N_MOD * D), 0.02),
        'g_norm': 1.0 + nrm(ks[11], (DEPTH, 3, D), 0.02),
        'w_ffn1_in': nrm(ks[12], (DEPTH, D, 2 * D_FF), D ** -0.5),
        'w_ffn1_out': nrm(ks[13], (DEPTH, D_FF, D), D_FF ** -0.5),
        'w_ffn2_in': nrm(ks[14], (DEPTH, D, 2 * D_FF), D ** -0.5),
        'w_ffn2_out': nrm(ks[15], (DEPTH, D_FF, D), D_FF ** -0.5),
        'w_in': nrm(ks[18], (DEPTH, D, P_IN), D ** -0.5),
        'b_mgate': b_mgate,
        'attn_lambda': nrm(ks[19], (DEPTH, 4, DH_ATTN), 0.1),
        'g_attn_sub': 1.0 + nrm(ks[20], (DEPTH, 2 * DH_ATTN), 0.02),
        'g_mlstm': 1.0 + nrm(ks[21], (DEPTH, DH_MLSTM), 0.02),
        'w_branch_gate': nrm(ks[22], (DEPTH, D, N_BRANCH * D), D ** -0.5),
        'w_br_attn': nrm(ks[23], (DEPTH, W_ATTN, D), W_ATTN ** -0.5),
        'w_br_four': nrm(ks[24], (DEPTH, W_FOUR, D), W_FOUR ** -0.5),
        'w_br_mlstm': nrm(ks[25], (DEPTH, W_MLSTM, D), W_MLSTM ** -0.5),
        'w_out': nrm(ks[26], (DEPTH, D, D), D ** -0.5),
        'g_final': 1.0 + nrm(ks[27], (D,), 0.02),
    }


def reference(x_prompt, x_sample, cache_k, cache_v, state_C, state_n, state_m, c, c_ctx,
              w_ada, b_ada, g_norm, w_ffn1_in, w_ffn1_out, w_ffn2_in, w_ffn2_out, w_in, b_mgate,
              attn_lambda, g_attn_sub, g_mlstm, w_branch_gate, w_br_attn, w_br_four, w_br_mlstm,
              w_out, g_final):
    hp = x_prompt
    hs = x_sample
    ks_l, vs_l, Cs_l, ns_l, ms_l = [], [], [], [], []
    for l in range(DEPTH):
        lam_init = 0.8 - 0.6 * math.exp(-0.3 * l)
        lp = {
            'g_norm': g_norm[l], 'w_ffn1_in': w_ffn1_in[l], 'w_ffn1_out': w_ffn1_out[l],
            'w_ffn2_in': w_ffn2_in[l], 'w_ffn2_out': w_ffn2_out[l], 'w_in': w_in[l],
            'b_mgate': b_mgate[l], 'attn_lambda': attn_lambda[l], 'g_attn_sub': g_attn_sub[l],
            'g_mlstm': g_mlstm[l], 'w_branch_gate': w_branch_gate[l], 'w_br_attn': w_br_attn[l],
            'w_br_four': w_br_four[l], 'w_br_mlstm': w_br_mlstm[l], 'w_out': w_out[l],
        }
        mods_ctx = adaln(c_ctx[None, :], w_ada[l], b_ada[l])
        mods_lat = adaln(c, w_ada[l], b_ada[l])
        hp, (k_l, v_l, C_l, n_l, m_l) = trunk_layer(hp, mods_ctx, lp, lam_init, None)
        ctx_l = (cache_k[:, l], cache_v[:, l], state_C[:, l], state_n[:, l], state_m[:, l])
        hs, _ = trunk_layer(hs, mods_lat, lp, lam_init, ctx_l)
        ks_l.append(k_l)
        vs_l.append(v_l)
        Cs_l.append(C_l)
        ns_l.append(n_l)
        ms_l.append(m_l)
    y_prompt = rms_norm(hp, g_final)
    y_sample = rms_norm(hs, g_final)
    new_cache_k = jnp.stack(ks_l, axis=1)
    new_cache_v = jnp.stack(vs_l, axis=1)
    new_state_C = jnp.stack(Cs_l, axis=1)
    new_state_n = jnp.stack(ns_l, axis=1)
    new_state_m = jnp.stack(ms_l, axis=1)
    return (y_prompt, y_sample, new_cache_k, new_cache_v, new_state_C, new_state_n, new_state_m)
```

```cpp
#include <hip/hip_runtime.h>
#include <hip/hip_cooperative_groups.h>
#include <cstdio>
namespace cg = cooperative_groups;

typedef unsigned short u16;
typedef short bf16x8 __attribute__((ext_vector_type(8)));
typedef short bf16x4 __attribute__((ext_vector_type(4)));
typedef float f32x4 __attribute__((ext_vector_type(4)));
#define LAS __attribute__((address_space(3)))

constexpr int D = 1024, NTOK = 12288, NCTX = 8192, DFF = 2816, PIN = 4112, NBIG = 7680, ZLD = 3584, GBLD = 3072;
constexpr int LDS_BYTES = 131072;
#ifndef PROBE
#define PROBE 0
#endif
constexpr float EPS = 1e-6f;
constexpr size_t O_Y = 0, O_CK = 12582912, O_CV = 20971520, O_SC = 29360128, O_SN = 37748736, O_SM = 37814272;

struct Params {
  const float *x_prompt, *x_sample, *cache_k, *cache_v, *state_C, *state_n, *state_m, *c, *c_ctx, *w_ada, *b_ada, *g_norm,
      *w_ffn1_in, *w_ffn1_out, *w_ffn2_in, *w_ffn2_out, *w_in, *b_mgate, *attn_lambda, *g_attn_sub, *g_mlstm, *w_branch_gate,
      *w_br_attn, *w_br_four, *w_br_mlstm, *w_out, *g_final;
  float* out;
  u16 *wt_ffn1_in, *wt_ffn1_out, *wt_ffn2_in, *wt_ffn2_out, *wt_big, *wt_br, *wt_out;
  u16 *u, *zA, *gb, *Yt, *brin, *hdir, *cs1024, *cs256;
  float *mods, *gate, *rope, *lam;
  unsigned* ctr;
};

typedef float f32x2_ __attribute__((ext_vector_type(2)));
typedef __bf16 bf16v2_ __attribute__((ext_vector_type(2)));
__device__ __forceinline__ unsigned cvt_pk_bf16(float lo, float hi) { f32x2_ v = {lo, hi}; bf16v2_ r = __builtin_convertvector(v, bf16v2_); return __builtin_bit_cast(unsigned, r); }
__device__ __forceinline__ u16 f2bf(float f) { return (u16)cvt_pk_bf16(f, 0.f); }
typedef unsigned u32x4 __attribute__((ext_vector_type(4)));
typedef unsigned u32x2 __attribute__((ext_vector_type(2)));
__device__ __forceinline__ float bf2f(u16 h) { return __uint_as_float(((unsigned)h) << 16); }
__device__ __forceinline__ int tid_opaque() { int t = threadIdx.x; asm volatile("" : "+v"(t)); return t; }
__device__ __forceinline__ float sigmoidf_(float x) { return __builtin_amdgcn_rcpf(1.f + __builtin_amdgcn_exp2f(-1.4426950408889634f * x)); }
__device__ __forceinline__ int cond_of(int row) { return row < NCTX ? 0 : 1 + ((row - NCTX) >> 10); }
__device__ __forceinline__ float lam_init_of(int l) { return l == 0 ? 0.2f : (0.8f - 0.6f * 0.74081822068f); }


#define XB_TMO      128
#define XB_XCNT(j)  (256  + 64 * (j))
#define XB_XSUB(j)  (1280 + 64 * (j))
#define XB_XGEN(j)  (2304 + 64 * (j))
#define XB_TOP      3328
#define XB_TOPGEN   3392
#define XCD_BAR_WORDS 3456
#define XB_CTR      3520
#define BAR_TOTAL_WORDS 3584
#define XB_SPIN_CAP (1u << 18)
__device__ __forceinline__ unsigned xb_ld(unsigned* p)              { return __hip_atomic_load(p, __ATOMIC_RELAXED, __HIP_MEMORY_SCOPE_AGENT); }
__device__ __forceinline__ unsigned xb_add(unsigned* p, unsigned v) { return __hip_atomic_fetch_add(p, v, __ATOMIC_RELAXED, __HIP_MEMORY_SCOPE_AGENT); }
__device__ __forceinline__ unsigned xb_xcc_id() { return (unsigned)__builtin_amdgcn_s_getreg((3 << 11) | 20) & 0xFu; }
#define XB_SPIN(cond, bar) do { unsigned _sp = 0; while (cond) { __builtin_amdgcn_s_sleep(1); \
    if ((++_sp & 255u) == 0u) { if (xb_ld(&(bar)[XB_TMO])) break; if (_sp > XB_SPIN_CAP) { atomicAdd(&(bar)[XB_TMO], 1u); break; } } } } while (0)
struct XcdBarrier { unsigned* bar; unsigned x; volatile LAS unsigned* st; };
__device__ __forceinline__ XcdBarrier xcd_barrier_post(unsigned* bar, volatile LAS unsigned* st) {
  XcdBarrier b; b.bar = bar; b.x = xb_xcc_id(); b.st = st;
  if (threadIdx.x == 0) (void)xb_add(&bar[XB_XCNT(b.x)], 1u);
  return b;
}
__device__ __forceinline__ void xcd_barrier_complete(unsigned* bar, unsigned x, unsigned& nloc, unsigned& nx) {
  const unsigned G = gridDim.x * gridDim.y * gridDim.z;
  unsigned sum, cnt, mine, sp = 0u;
  for (;;) {
    sum = 0u; cnt = 0u; mine = 0u;
#pragma unroll
    for (unsigned j = 0; j < 16; ++j) { const unsigned c = xb_ld(&bar[XB_XCNT(j)]); sum += c; cnt += (c > 0u) ? 1u : 0u; mine = (j == x) ? c : mine; }
    if (sum == G) break;
    __builtin_amdgcn_s_sleep(1);
    if ((++sp & 255u) == 0u) { if (xb_ld(&bar[XB_TMO])) break; if (sp > XB_SPIN_CAP) { atomicAdd(&bar[XB_TMO], 1u); break; } }
  }
  nloc = mine > 0u ? mine : 1u; nx = cnt > 0u ? cnt : 1u;
}
__device__ __forceinline__ void xcd_barrier(const XcdBarrier& b) {
  asm volatile("s_waitcnt vmcnt(0)" ::: "memory");
  __syncthreads();
  if (threadIdx.x == 0) {
    unsigned* bar = b.bar;
    __builtin_amdgcn_s_waitcnt(0);
    unsigned nloc = b.st[0], nx = b.st[1];
    if (nloc == 0u) { xcd_barrier_complete(bar, b.x, nloc, nx); b.st[0] = nloc; b.st[1] = nx; }
    const unsigned old = xb_add(&bar[XB_XSUB(b.x)], 1u);
    const unsigned gen = old / nloc;
    if (old + 1u == (gen + 1u) * nloc) {
      __builtin_amdgcn_fence(__ATOMIC_RELEASE, "agent");
      asm volatile("s_waitcnt vmcnt(0)" ::: "memory");
      const unsigned og = xb_add(&bar[XB_TOP], 1u);
      const unsigned tg = og / nx;
      if (og + 1u == (tg + 1u) * nx) xb_add(&bar[XB_TOPGEN], 1u);
      else XB_SPIN(xb_ld(&bar[XB_TOPGEN]) == tg, bar);
      __builtin_amdgcn_fence(__ATOMIC_ACQUIRE, "agent");
      xb_add(&bar[XB_XGEN(b.x)], 1u);
      asm volatile("s_waitcnt vmcnt(0)" ::: "memory");
    } else {
      XB_SPIN(xb_ld(&bar[XB_XGEN(b.x)]) == gen, bar);
      __builtin_amdgcn_fence(__ATOMIC_ACQUIRE, "agent");
      asm volatile("s_waitcnt vmcnt(0)" ::: "memory");
    }
  }
  __syncthreads();
}

constexpr int BM = 256, BK = 64, HALF = 128, HTB = HALF * BK * 2;
__device__ __forceinline__ int lds_byte(int r, int c) { const int st = (r >> 4) * 2 + (c >> 5), rr = r & 15, cc = c & 31, ob = rr * 64 + cc * 2; return st * 1024 + (ob ^ (((ob >> 9) & 1) << 5)); }
__device__ __forceinline__ void stage_rc(int b, int& R, int& C) { const int st = b / 1024, sb = b % 1024, swz = sb ^ (((sb >> 9) & 1) << 5); R = (st >> 1) * 16 + swz / 64; C = (st & 1) * 32 + (swz % 64) / 2; }
__device__ __forceinline__ int perm32(int rho) { const int n = rho >> 4, i = rho & 15; return 8 * (i >> 2) + 4 * n + (i & 3); }

struct GUnit { const char* A; const char* B; int pm, pn, aux; };

__device__ __forceinline__ bool tile_order(int L, int nM, int nN, int& pm, int& pn) {
  const int nwg = nM * nN; if (L >= nwg) return false;
  int wgid = L; { const int q = nwg / 8, r = nwg % 8, xcd = wgid % 8, off = wgid / 8; wgid = (xcd < r ? xcd * (q + 1) : r * (q + 1) + (xcd - r) * q) + off; }
  const int nig = 8 * nN, gid = wgid / nig, fm = gid * 8, gsz = (nM - fm) < 8 ? (nM - fm) : 8;
  pm = fm + ((wgid % nig) % gsz); pn = (wgid % nig) / gsz; return true;
}

template <class Sched, class Epi>
__device__ __forceinline__ void gemm_phase(LAS unsigned char* lds, const int lda, const int ldb, const int K, const Sched& S, const Epi& E) {
  const int tid = tid_opaque(), wid = __builtin_amdgcn_readfirstlane(tid >> 6), lane = tid & 63, wr = wid >> 2, wc = wid & 3, fr = lane & 15, fq = lane >> 4;
  const int nt = K / BK;
  unsigned voffA[2], voffB[2];
#pragma unroll
  for (int i = 0; i < 2; ++i) { int R, C; stage_rc(tid * 16 + i * 8192, R, C); const int Rb = (R & ~31) + perm32(R & 31);
    voffA[i] = (unsigned)(R * lda + C) * 2u; voffB[i] = (unsigned)(Rb * ldb + C) * 2u; }
  const size_t kstep = (size_t)(BK * 2);
  const size_t hstepA = (size_t)HALF * lda * 2, hstepB = (size_t)HALF * ldb * 2;
  const unsigned ldsw = (unsigned)wid * 1024u;
  const int aoff = lds_byte(wr * 64 + fr, fq * 8), boff = lds_byte(wc * 32 + fr, fq * 8);
#define PG8_SA(b, h) (((b) * 2 + (h)) * HTB)
#define PG8_SB(b, h) ((4 + (b) * 2 + (h)) * HTB)
#define PG8_STAGE(bufoff, gbase, voff) do { _Pragma("unroll") for (int _i = 0; _i < 2; ++_i) \
    __builtin_amdgcn_global_load_lds((const unsigned*)((const char*)(gbase) + (voff)[_i]), (LAS unsigned*)(lds + (bufoff) + ldsw + _i * 8192), 16, 0, 0); } while (0)
#define PG8_LDA(dst, b, h) do { _Pragma("unroll") for (int m = 0; m < 4; ++m) _Pragma("unroll") for (int k = 0; k < 2; ++k) dst[m][k] = *(const LAS bf16x8*)(lds + PG8_SA(b, h) + aoff + m * 2048 + k * 1024); } while (0)
#define PG8_LDB(dst, b, h) do { _Pragma("unroll") for (int n = 0; n < 2; ++n) _Pragma("unroll") for (int k = 0; k < 2; ++k) dst[n][k] = *(const LAS bf16x8*)(lds + PG8_SB(b, h) + boff + n * 2048 + k * 1024); } while (0)
#define PG8_MMA(ai, bj, At, Bt) do { __builtin_amdgcn_s_setprio(1); _Pragma("unroll") for (int m = 0; m < 4; ++m) _Pragma("unroll") for (int n = 0; n < 2; ++n) _Pragma("unroll") for (int k = 0; k < 2; ++k) \
    acc[ai][bj][m][n] = __builtin_amdgcn_mfma_f32_16x16x32_bf16(Bt[n][k], At[m][k], acc[ai][bj][m][n], 0, 0, 0); __builtin_amdgcn_s_setprio(0); } while (0)
#define PG8_WAIT_V(n) asm volatile("s_waitcnt vmcnt(" #n ")" ::: "memory")
#define PG8_WAIT_L(n) asm volatile("s_waitcnt lgkmcnt(" #n ")" ::: "memory")
#define PG8_BAR __builtin_amdgcn_s_barrier()
#define PG8_SCHED __builtin_amdgcn_sched_barrier(0)
  GUnit cur, nxt; int ui = 0;
  if (!S.next(0, cur)) return;
  f32x4 acc[2][2][4][2];
#pragma unroll
  for (int a = 0; a < 2; ++a)
#pragma unroll
    for (int b = 0; b < 2; ++b)
#pragma unroll
      for (int m = 0; m < 4; ++m)
#pragma unroll
        for (int n = 0; n < 2; ++n) acc[a][b][m][n] = (f32x4){0.f, 0.f, 0.f, 0.f};
  bf16x8 At[4][2], B0[2][2], B1[2][2];
  const char* cA = cur.A; const char* cB = cur.B;
  PG8_STAGE(PG8_SB(0, 0), cB, voffB); PG8_STAGE(PG8_SA(0, 0), cA, voffA); PG8_STAGE(PG8_SB(0, 1), cB + hstepB, voffB); PG8_STAGE(PG8_SA(0, 1), cA + hstepA, voffA);
  if (wr == 1) PG8_BAR;
  PG8_WAIT_V(4); PG8_BAR;
  PG8_STAGE(PG8_SB(1, 0), cB + kstep, voffB); PG8_STAGE(PG8_SA(1, 0), cA + kstep, voffA); PG8_STAGE(PG8_SB(1, 1), cB + hstepB + kstep, voffB);
  PG8_WAIT_V(6); PG8_BAR;
  for (;;) {
    const bool has_next = S.next(ui + 1, nxt);
    const char* nA = has_next ? nxt.A : cA; const char* nB = has_next ? nxt.B : cB;
    for (int t = 0; t < nt; t += 2) {
      const bool last = (t == nt - 2);
      const char* a1 = cA + (size_t)(t + 1) * kstep;
      const char* a2 = last ? nA : cA + (size_t)(t + 2) * kstep; const char* b2 = last ? nB : cB + (size_t)(t + 2) * kstep;
      const char* a3 = a2 + kstep; const char* b3 = b2 + kstep;
      PG8_LDB(B0, 0, 0); PG8_SCHED; PG8_LDA(At, 0, 0); PG8_STAGE(PG8_SA(1, 1), a1 + hstepA, voffA);
      PG8_WAIT_L(8); PG8_BAR; PG8_WAIT_L(0); PG8_MMA(0, 0, At, B0); PG8_BAR; PG8_SCHED;
      PG8_LDB(B1, 0, 1); PG8_STAGE(PG8_SB(0, 0), b2, voffB);
      PG8_BAR; PG8_WAIT_L(0); PG8_MMA(0, 1, At, B1); PG8_BAR;
      PG8_LDA(At, 0, 1); PG8_STAGE(PG8_SA(0, 0), a2, voffA);
      PG8_BAR; PG8_WAIT_L(0); PG8_MMA(1, 0, At, B0); PG8_BAR; PG8_SCHED;
      PG8_STAGE(PG8_SB(0, 1), b2 + hstepB, voffB);
      PG8_WAIT_V(6); PG8_BAR; PG8_MMA(1, 1, At, B1); PG8_BAR;
      PG8_LDB(B0, 1, 0); PG8_SCHED; PG8_LDA(At, 1, 0); PG8_STAGE(PG8_SA(0, 1), a2 + hstepA, voffA);
      PG8_WAIT_L(8); PG8_BAR; PG8_WAIT_L(0); PG8_MMA(0, 0, At, B0); PG8_BAR; PG8_SCHED;
      PG8_LDB(B1, 1, 1); PG8_STAGE(PG8_SB(1, 0), b3, voffB);
      PG8_BAR; PG8_WAIT_L(0); PG8_MMA(0, 1, At, B1); PG8_BAR;
      PG8_LDA(At, 1, 1); PG8_STAGE(PG8_SA(1, 0), a3, voffA);
      PG8_BAR; PG8_WAIT_L(0); PG8_MMA(1, 0, At, B0); PG8_BAR; PG8_SCHED;
      PG8_STAGE(PG8_SB(1, 1), b3 + hstepB, voffB);
      PG8_WAIT_V(6); PG8_BAR; PG8_MMA(1, 1, At, B1); PG8_BAR;
    }
    E(acc, cur, wr, wc, fr, fq);
    if (!has_next) break;
#pragma unroll
    for (int a = 0; a < 2; ++a)
#pragma unroll
      for (int b = 0; b < 2; ++b)
#pragma unroll
        for (int m = 0; m < 4; ++m)
#pragma unroll
          for (int n = 0; n < 2; ++n) acc[a][b][m][n] = (f32x4){0.f, 0.f, 0.f, 0.f};
    cur = nxt; cA = nA; cB = nB; ++ui;
  }
  PG8_WAIT_V(0);
  if (wr == 0) PG8_BAR;
  PG8_BAR;
#undef PG8_SA
#undef PG8_SB
#undef PG8_STAGE
#undef PG8_LDA
#undef PG8_LDB
#undef PG8_MMA
#undef PG8_WAIT_V
#undef PG8_WAIT_L
#undef PG8_BAR
#undef PG8_SCHED
}

struct TileSched {
  const u16* A; const u16* B; int lda, ldb, nM, nN, G, c;
  __device__ __forceinline__ bool next(int i, GUnit& u) const {
    int pm, pn; if (!tile_order(i * G + c, nM, nN, pm, pn)) return false;
    u.pm = pm; u.pn = pn; u.aux = 0; u.A = (const char*)(A + (size_t)pm * BM * lda); u.B = (const char*)(B + (size_t)pn * BM * ldb); return true;
  }
};
struct BranchSched {
  const u16* brin; const u16* wbr; int G, c;
  __device__ __forceinline__ bool next(int i, GUnit& u) const {
    int pm, pn; const int ti = i / 3, br = i - ti * 3; if (!tile_order(ti * G + c, 48, 4, pm, pn)) return false;
    u.pm = pm; u.pn = pn; u.aux = br; u.A = (const char*)(brin + (size_t)br * NTOK * 512 + (size_t)pm * BM * 512); u.B = (const char*)(wbr + (size_t)br * D * 512 + (size_t)pn * BM * 512); return true;
  }
};
struct OneSched { GUnit u; __device__ __forceinline__ bool next(int i, GUnit& o) const { if (i != 0) return false; o = u; return true; } };

__device__ __forceinline__ bf16x8 pack8(const f32x4& a, const f32x4& b) {
  u32x4 o; o[0] = cvt_pk_bf16(a[0], a[1]); o[1] = cvt_pk_bf16(a[2], a[3]); o[2] = cvt_pk_bf16(b[0], b[1]); o[3] = cvt_pk_bf16(b[2], b[3]); return __builtin_bit_cast(bf16x8, o);
}
__device__ __forceinline__ bf16x4 pack4(float a, float b, float c, float d) { u32x2 o; o[0] = cvt_pk_bf16(a, b); o[1] = cvt_pk_bf16(c, d); return __builtin_bit_cast(bf16x4, o); }

struct EpiSwiglu {
  u16* h;
  __device__ __forceinline__ void operator()(const f32x4 (&acc)[2][2][4][2], const GUnit& u, int wr, int wc, int fr, int fq) const {
    const int row0 = u.pm * BM + wr * 64 + fr, col0 = u.pn * 128 + wc * 32 + fq * 8;
#pragma unroll
    for (int ai = 0; ai < 2; ++ai)
#pragma unroll
      for (int m = 0; m < 4; ++m) {
        f32x4 r[2];
#pragma unroll
        for (int n = 0; n < 2; ++n)
#pragma unroll
          for (int j = 0; j < 4; ++j) { const float a = acc[ai][0][m][n][j], g = acc[ai][1][m][n][j]; r[n][j] = a * sigmoidf_(a) * g; }
        *(bf16x8*)(h + (size_t)(row0 + ai * HALF + m * 16) * DFF + col0) = pack8(r[0], r[1]);
      }
  }
};
struct EpiResid {
  float* x; const float* gatev; float coef;
  __device__ __forceinline__ void operator()(const f32x4 (&acc)[2][2][4][2], const GUnit& u, int wr, int wc, int fr, int fq) const {
    const int row0 = u.pm * BM + wr * 64 + fr, col0 = u.pn * BM + wc * 32 + fq * 8;
    const float* gp = gatev + cond_of(u.pm * BM) * 9216 + col0;
    f32x4 g[2][2];
#pragma unroll
    for (int bj = 0; bj < 2; ++bj)
#pragma unroll
      for (int n = 0; n < 2; ++n) g[bj][n] = coef * *(const f32x4*)(gp + bj * HALF + n * 4);
#pragma unroll
    for (int ai = 0; ai < 2; ++ai)
#pragma unroll
      for (int mp = 0; mp < 2; ++mp) {
        f32x4 xv[2][2][2];
#pragma unroll
        for (int mm = 0; mm < 2; ++mm)
#pragma unroll
          for (int bj = 0; bj < 2; ++bj)
#pragma unroll
            for (int n = 0; n < 2; ++n) xv[mm][bj][n] = *(const f32x4*)(x + (size_t)(row0 + ai * HALF + (mp * 2 + mm) * 16) * D + col0 + bj * HALF + n * 4);
#pragma unroll
        for (int mm = 0; mm < 2; ++mm)
#pragma unroll
          for (int bj = 0; bj < 2; ++bj)
#pragma unroll
            for (int n = 0; n < 2; ++n) *(f32x4*)(x + (size_t)(row0 + ai * HALF + (mp * 2 + mm) * 16) * D + col0 + bj * HALF + n * 4) = xv[mm][bj][n] + g[bj][n] * acc[ai][bj][mp * 2 + mm][n];
      }
  }
};
struct EpiBig {
  u16 *zA, *gb, *Yt; float* out; int l;
  __device__ __forceinline__ void operator()(const f32x4 (&acc)[2][2][4][2], const GUnit& u, int wr, int wc, int fr, int fq) const {
    const int row0 = u.pm * BM + wr * 64 + fr; const int pn = u.pn; const int colw = wc * 32 + fq * 8;
#pragma unroll
    for (int ai = 0; ai < 2; ++ai)
#pragma unroll
      for (int m = 0; m < 4; ++m) {
        const int row = row0 + ai * HALF + m * 16;
#pragma unroll
        for (int bj = 0; bj < 2; ++bj) {
          const int c = pn * BM + bj * HALF + colw;
          f32x4 v0 = acc[ai][bj][m][0], v1 = acc[ai][bj][m][1];
          if (pn < 6) {
            *(bf16x8*)(zA + (size_t)row * ZLD + c) = pack8(v0, v1);
            if (pn >= 2 && row < NCTX) {
              const int cc = (c - 512) & 511, hh = cc >> 7, d = cc & 127, b = row >> 8, t = row & 255;
              float* o = out + (pn < 4 ? O_CK : O_CV) + ((((size_t)(b * 2 + l) * 4 + hh) * 256 + t) * 128 + d);
              *(f32x4*)o = v0; *(f32x4*)(o + 4) = v1;
            }
          } else if (pn < 10) {
            const int cp = c - 1536, g = cp >> 8, j = cp & 255, cs = j >> 7, np = j & 127;
            u16* base;
            if (row < NCTX) { const int b = row >> 8, t = row & 255; base = Yt + (size_t)b * 512 * 512 + (size_t)(g * 128 + np) * 512 + cs * 256 + t;
#pragma unroll
              for (int q = 0; q < 4; ++q) { base[(size_t)q * 512] = f2bf(v0[q]); base[(size_t)(q + 4) * 512] = f2bf(v1[q]); }
            } else { const int rr = row - NCTX, b = rr >> 10, t = rr & 1023; base = Yt + (size_t)32 * 512 * 512 + (size_t)b * 512 * 2048 + (size_t)(g * 128 + np) * 2048 + cs * 1024 + t;
#pragma unroll
              for (int q = 0; q < 4; ++q) { base[(size_t)q * 2048] = f2bf(v0[q]); base[(size_t)(q + 4) * 2048] = f2bf(v1[q]); }
            }
          } else if (pn < 18) {
            if (pn == 12 || pn == 13) { v0 *= 0.08838834764831845f; v1 *= 0.08838834764831845f; }
            if (pn >= 16) {
#pragma unroll
              for (int q = 0; q < 4; ++q) { v0[q] = sigmoidf_(v0[q]); v1[q] = sigmoidf_(v1[q]); }
            }
            *(bf16x8*)(zA + (size_t)row * ZLD + (c - 1024)) = pack8(v0, v1);
          } else {
#pragma unroll
            for (int q = 0; q < 4; ++q) { v0[q] = sigmoidf_(v0[q]); v1[q] = sigmoidf_(v1[q]); }
            *(bf16x8*)(gb + (size_t)row * GBLD + (c - 4608)) = pack8(v0, v1);
          }
        }
      }
  }
};
struct EpiBranch {
  float* tmp; const u16* gb; u16* merged;
  __device__ __forceinline__ void operator()(const f32x4 (&acc)[2][2][4][2], const GUnit& u, int wr, int wc, int fr, int fq) const {
    const int row0 = u.pm * BM + wr * 64 + fr, col0 = u.pn * BM + wc * 32 + fq * 8; const int br = u.aux;
#pragma unroll
    for (int ai = 0; ai < 2; ++ai)
#pragma unroll
      for (int m = 0; m < 4; ++m) {
        const int row = row0 + ai * HALF + m * 16;
        bf16x8 g8[2]; f32x4 tv[2][2];
#pragma unroll
        for (int bj = 0; bj < 2; ++bj) { const int c = col0 + bj * HALF;
          g8[bj] = *(const bf16x8*)(gb + (size_t)row * GBLD + br * D + c);
          if (br > 0) { const float* tp = tmp + (size_t)row * D + c; tv[bj][0] = *(const f32x4*)tp; tv[bj][1] = *(const f32x4*)(tp + 4); } }
#pragma unroll
        for (int bj = 0; bj < 2; ++bj) { const int c = col0 + bj * HALF;
          f32x4 r0, r1;
#pragma unroll
          for (int q = 0; q < 4; ++q) { r0[q] = bf2f((u16)g8[bj][q]) * acc[ai][bj][m][0][q]; r1[q] = bf2f((u16)g8[bj][q + 4]) * acc[ai][bj][m][1][q]; }
          if (br > 0) { r0 += tv[bj][0]; r1 += tv[bj][1]; }
          float* tp = tmp + (size_t)row * D + c;
          if (br < 2) { *(f32x4*)tp = r0; *(f32x4*)(tp + 4) = r1; }
          else *(bf16x8*)(merged + (size_t)row * D + c) = pack8(r0, r1); }
      }
  }
};
struct EpiFour {
  u16* fo; float scale;
  __device__ __forceinline__ void operator()(const f32x4 (&acc)[2][2][4][2], const GUnit& u, int wr, int wc, int fr, int fq) const {
    const int row0 = u.pm + wr * 64 + fr, col0 = u.pn * BM + wc * 32 + fq * 8;
#pragma unroll
    for (int ai = 0; ai < 2; ++ai)
#pragma unroll
      for (int m = 0; m < 4; ++m)
#pragma unroll
        for (int bj = 0; bj < 2; ++bj)
          *(bf16x8*)(fo + (size_t)(row0 + ai * HALF + m * 16) * 512 + col0 + bj * HALF) = pack8(acc[ai][bj][m][0] * scale, acc[ai][bj][m][1] * scale);
  }
};

struct TrJob { const float* src; u16* dst; int lds_, ldd, k0, ns0, nd0, mode; };
__device__ __forceinline__ void tr_decode(const Params& p, int l, int j, TrJob& t) {
  t.mode = 0;
  if (j < 352 || (j >= 528 && j < 880)) { const bool second = j >= 528; const int q = second ? j - 528 : j; const int kt = q / 22, nb = q % 22;
    t.src = (second ? p.w_ffn2_in : p.w_ffn1_in) + (size_t)l * D * 2 * DFF; t.dst = second ? p.wt_ffn2_in : p.wt_ffn1_in; t.lds_ = 2 * DFF; t.ldd = D; t.k0 = kt * 64; t.ns0 = nb * 256; t.nd0 = 0; t.mode = 1; }
  else if (j < 528 || (j >= 880 && j < 1056)) { const bool second = j >= 880; const int q = second ? j - 880 : j - 352; const int kt = q >> 2, nb = q & 3;
    t.src = (second ? p.w_ffn2_out : p.w_ffn1_out) + (size_t)l * DFF * D; t.dst = second ? p.wt_ffn2_out : p.wt_ffn1_out; t.lds_ = D; t.ldd = DFF; t.k0 = kt * 64; t.ns0 = nb * 256; t.nd0 = t.ns0; }
  else if (j < 1280) { const int q = j - 1056, kt = q / 14, nb = q % 14; t.src = p.w_in + (size_t)l * D * PIN; t.dst = p.wt_big; t.lds_ = PIN; t.ldd = D; t.k0 = kt * 64;
    if (nb < 6) { t.ns0 = nb * 256; t.nd0 = t.ns0; } else { t.ns0 = 2048 + (nb - 6) * 256; t.nd0 = t.ns0 + 512; } }
  else if (j < 1472) { const int q = j - 1280, kt = q / 12, nb = q % 12; t.src = p.w_branch_gate + (size_t)l * D * 3 * D; t.dst = p.wt_big; t.lds_ = 3 * D; t.ldd = D; t.k0 = kt * 64; t.ns0 = nb * 256; t.nd0 = 4608 + t.ns0; }
  else if (j < 1568) { const int q = j - 1472, br = q >> 5, jj = q & 31, kt = jj >> 2, nb = jj & 3;
    t.src = (br == 0 ? p.w_br_attn : br == 1 ? p.w_br_four : p.w_br_mlstm) + (size_t)l * 512 * D; t.dst = p.wt_br + (size_t)br * D * 512; t.lds_ = D; t.ldd = 512; t.k0 = kt * 64; t.ns0 = nb * 256; t.nd0 = t.ns0; }
  else { const int q = j - 1568, kt = q >> 2, nb = q & 3; t.src = p.w_out + (size_t)l * D * D; t.dst = p.wt_out; t.lds_ = D; t.ldd = D; t.k0 = kt * 64; t.ns0 = nb * 256; t.nd0 = t.ns0; }
}
__device__ __forceinline__ void tr_load(const TrJob& t, int tid, f32x4 (&r)[8]) {
#pragma unroll
  for (int i = 0; i < 8; ++i) { const int idx = tid + i * 512, kk = idx >> 6, c4 = idx & 63; r[i] = *(const f32x4*)(t.src + (size_t)(t.k0 + kk) * t.lds_ + t.ns0 + c4 * 4); }
}

__device__ void wf_job(const Params& p, int l, int job, LAS float* sm) {
  const int tid = tid_opaque();
  const int g = job >> 5, kb = (job >> 1) & 15, jh = job & 1; LAS float* W = sm; LAS float* ct = sm + 64 * 129;
  __syncthreads();
  for (int i = tid; i < 64 * 32; i += 512) { const int kk = i >> 5, c4 = i & 31;
    const float4 v = *(const float4*)(p.w_in + ((size_t)l * D + kb * 64 + kk) * PIN + 1536 + g * 128 + c4 * 4);
    LAS float* s = W + kk * 129 + c4 * 4; s[0] = v.x; s[1] = v.y; s[2] = v.z; s[3] = v.w; }
  if (tid < 128) ct[tid] = cospif((float)tid / 64.f);
  __syncthreads();
  const int kk = tid & 63, jg = tid >> 6; float a[16];
#pragma unroll
  for (int q = 0; q < 16; ++q) a[q] = 0.f;
  const int jbase = jh * 128 + jg * 16;
  for (int c = 0; c < 128; ++c) { const float w = W[kk * 129 + c];
#pragma unroll
    for (int q = 0; q < 16; ++q) { const int j = jbase + q; const int idx = jh ? ((c * (j - 128) - 32) & 127) : ((c * j) & 127); a[q] += w * ct[idx]; } }
#pragma unroll
  for (int q = 0; q < 16; ++q) p.wt_big[(size_t)(1536 + g * 256 + jbase + q) * D + kb * 64 + kk] = f2bf(a[q]);
}

__device__ void mods_job(const Params& p, int job, LAS float* sm) {
  const int tid = tid_opaque();
  const int l = job / 72, cb = job % 72; LAS float* sc = sm; LAS float* part = sm + 5 * 1024;
  __syncthreads();
  for (int i = tid; i < 5 * 1024; i += 512) { const int ci = i >> 10, k = i & 1023; const float v = ci == 0 ? p.c_ctx[k] : p.c[(ci - 1) * D + k]; sc[i] = v * sigmoidf_(v); }
  __syncthreads();
  const int cg4 = tid & 31, kp = tid >> 5; f32x4 a[5];
#pragma unroll
  for (int ci = 0; ci < 5; ++ci) a[ci] = (f32x4){0.f, 0.f, 0.f, 0.f};
  const float* wp = p.w_ada + ((size_t)l * D + kp * 64) * 9216 + cb * 128 + cg4 * 4;
#pragma unroll 8
  for (int k = 0; k < 64; ++k) { const f32x4 w = *(const f32x4*)(wp + (size_t)k * 9216);
#pragma unroll
    for (int ci = 0; ci < 5; ++ci) a[ci] += sc[ci * 1024 + kp * 64 + k] * w; }
#pragma unroll
  for (int ci = 0; ci < 5; ++ci)
#pragma unroll
    for (int q = 0; q < 4; ++q) part[(kp * 5 + ci) * 128 + cg4 * 4 + q] = a[ci][q];
  __syncthreads();
  for (int o = tid; o < 640; o += 512) { const int ci = o >> 7, cc = o & 127; float s = p.b_ada[(size_t)l * 9216 + cb * 128 + cc];
    for (int q = 0; q < 16; ++q) s += part[(q * 5 + ci) * 128 + cc];
    p.mods[((size_t)l * 5 + ci) * 9216 + cb * 128 + cc] = s; }
}

__device__ void prep_seg(const Params& p, int l, int seg, LAS unsigned char* lds) {
  const int tid = tid_opaque(); LAS float* sm = (LAS float*)lds; LAS int* s_job = (LAS int*)(lds + 131072 - 16);
  const int qi = 8 + l * 2 + seg;
  const int npre = seg ? 128 : (l == 0 ? 144 : 0), trofs = seg ? 528 : 0, ntr = seg ? 1104 : 528;
  const int trbase = npre, njobs = npre + ntr;
  int job;
  for (;;) {
    __syncthreads();
    if (tid == 0) *s_job = (int)atomicAdd(p.ctr + XB_CTR + qi, 1u);
    __syncthreads();
    job = *s_job;
    if (job >= trbase) break;
    if (seg) wf_job(p, l, job, sm); else mods_job(p, job, sm);
  }
  if (job >= njobs) return;
  f32x4 r[8]; TrJob t;
  tr_decode(p, l, job - trbase + trofs, t); tr_load(t, tid, r);
  for (;;) {
    __syncthreads();
#pragma unroll
    for (int i = 0; i < 8; ++i) { const int idx = tid + i * 512, kk = idx >> 6, c4 = idx & 63; LAS float* s = sm + kk * 257 + c4 * 4; s[0] = r[i][0]; s[1] = r[i][1]; s[2] = r[i][2]; s[3] = r[i][3]; }
    if (tid == 0) *s_job = (int)atomicAdd(p.ctr + XB_CTR + qi, 1u);
    __syncthreads();
    const int nextjob = *s_job; const TrJob cur = t;
    if (nextjob < njobs) { tr_decode(p, l, nextjob - trbase + trofs, t); tr_load(t, tid, r); }
#pragma unroll
    for (int i = 0; i < 4; ++i) { const int unit = tid + i * 512, nn = unit >> 3, ch = unit & 7; bf16x8 o;
#pragma unroll
      for (int q = 0; q < 8; ++q) o[q] = (short)f2bf(sm[(ch * 8 + q) * 257 + nn]);
      int drow;
      if (cur.mode == 1) { const int col = cur.ns0 + nn, isg = col >= DFF, hid = col - isg * DFF; drow = (hid >> 7) * 256 + isg * 128 + (hid & 127); } else drow = cur.nd0 + nn;
      *(bf16x8*)(cur.dst + (size_t)drow * cur.ldd + cur.k0 + ch * 8) = o; }
    if (nextjob >= njobs) break;
  }
}

__device__ void phase0(const Params& p, LAS unsigned char* lds) {
  const int tid = tid_opaque(); const int G = gridDim.x;
  if (blockIdx.x == 0 && tid >= 64 && tid < 66) { const int l = tid - 64; const float* lp = p.attn_lambda + l * 256; float s1 = 0.f, s2 = 0.f;
    for (int i = 0; i < 64; ++i) { s1 += lp[i] * lp[64 + i]; s2 += lp[128 + i] * lp[192 + i]; }
    p.lam[l] = expf(s1) - expf(s2) + lam_init_of(l); }
  const int gtid = blockIdx.x * 512 + tid, gn = G * 512;
  for (int i = gtid; i < 1024 * 2048; i += gn) { const int tp = i >> 11, col = i & 2047, t = col & 1023, s = col >> 10; const int r = (t * tp) & 1023; const float x = (float)r / 512.f;
    p.cs1024[i] = f2bf(s ? -sinpif(x) : cospif(x)); }
  for (int i = gtid; i < 256 * 512; i += gn) { const int tp = i >> 9, col = i & 511, t = col & 255, s = col >> 8; const int r = (t * tp) & 255; const float x = (float)r / 128.f;
    p.cs256[i] = f2bf(s ? -sinpif(x) : cospif(x)); }
  for (int i = gtid; i < 1024 * 32; i += gn) { const int t = i >> 5, pp = i & 31; const float pos = pp < 16 ? (float)(t >> 6) : (float)(t & 63);
    const float inv = powf(10000.f, -(float)(pp & 15) / 16.f); float s, c; sincosf(pos * inv, &s, &c); p.rope[2 * i] = c; p.rope[2 * i + 1] = s; }
  for (int i = gtid; i < NTOK * D / 4; i += gn) { const float4 v = (i < NCTX * D / 4) ? ((const float4*)p.x_prompt)[i] : ((const float4*)p.x_sample)[i - NCTX * D / 4]; ((float4*)p.out)[i] = v; }
}

__device__ __forceinline__ float wave_sum(float v) {
#pragma unroll
  for (int o = 32; o >= 1; o >>= 1) v += __shfl_xor(v, o);
  return v;
}
__device__ void norm_phase(const Params& p, int l, int which, LAS unsigned char* lds) {
  const int tid = tid_opaque(), wid = tid >> 6, lane = tid & 63; const bool gates = which == 1;
  LAS float* Wg = (LAS float*)lds; LAS float* ur = Wg + 16384 + wid * 1024;
  if (gates) { __syncthreads();
    for (int i = tid; i < 4096; i += 512) { const int k = i >> 2, q = i & 3; const float4 v = *(const float4*)(p.w_in + ((size_t)l * D + k) * PIN + 4096 + q * 4);
      LAS float* s = Wg + k * 16 + q * 4; s[0] = v.x; s[1] = v.y; s[2] = v.z; s[3] = v.w; }
    __syncthreads(); }
  float* X = p.out;
  f32x4 v[4], vn[4];
  { const int rg0 = blockIdx.x; if (rg0 < NTOK / 8) { const float* xr = X + (size_t)(rg0 * 8 + wid) * D;
#pragma unroll
      for (int i = 0; i < 4; ++i) v[i] = *(const f32x4*)(xr + i * 256 + lane * 4); } }
  for (int rg = blockIdx.x; rg < NTOK / 8; rg += gridDim.x) {
    const int row = rg * 8 + wid; float* xr = X + (size_t)row * D;
    const int rgn = rg + gridDim.x;
    if (rgn < NTOK / 8) { const float* xn = X + (size_t)(rgn * 8 + wid) * D;
#pragma unroll
      for (int i = 0; i < 4; ++i) vn[i] = *(const f32x4*)(xn + i * 256 + lane * 4); }
    float ss = 0.f;
#pragma unroll
    for (int i = 0; i < 4; ++i) ss += v[i][0] * v[i][0] + v[i][1] * v[i][1] + v[i][2] * v[i][2] + v[i][3] * v[i][3];
    ss = wave_sum(ss); const float rstd = rsqrtf(ss * (1.f / 1024.f) + EPS);
    if (which == 3) {
#pragma unroll
      for (int i = 0; i < 4; ++i) { const f32x4 g = *(const f32x4*)(p.g_final + i * 256 + lane * 4); *(f32x4*)(xr + i * 256 + lane * 4) = v[i] * rstd * g; }
    } else {
      const float* md = p.mods + ((size_t)l * 5 + cond_of(row)) * 9216 + which * 3 * 1024; const float* gn = p.g_norm + ((size_t)l * 3 + which) * D;
#pragma unroll
      for (int i = 0; i < 4; ++i) { const int c = i * 256 + lane * 4; const f32x4 g = *(const f32x4*)(gn + c), sh = *(const f32x4*)(md + c), sc = *(const f32x4*)(md + 1024 + c);
        v[i] = v[i] * rstd * g * (1.f + sc) + sh;
        *(bf16x4*)(p.u + (size_t)row * D + c) = pack4(v[i][0], v[i][1], v[i][2], v[i][3]); }
      if (gates) {
        __syncthreads();
#pragma unroll
        for (int i = 0; i < 4; ++i) { LAS float* s = ur + i * 256 + lane * 4; s[0] = v[i][0]; s[1] = v[i][1]; s[2] = v[i][2]; s[3] = v[i][3]; }
        __syncthreads();
        const int j = lane & 15, kp = lane >> 4; float a = 0.f;
#pragma unroll 8
        for (int kk = 0; kk < 256; ++kk) a += ur[kk * 4 + kp] * Wg[(kk * 4 + kp) * 16 + j];
        a += __shfl_xor(a, 16); a += __shfl_xor(a, 32);
        if (lane < 16) { a += p.b_mgate[l * 16 + j]; if ((j >> 2) & 1) a = fminf(a, 0.f) - log1pf(__expf(-fabsf(a))); p.gate[(size_t)row * 16 + j] = a; }
      }
    }
#pragma unroll
    for (int i = 0; i < 4; ++i) v[i] = vn[i];
  }
}

__device__ void attn_item(const Params& p, int l, int item, LAS unsigned char* lds) {
  const int tid = tid_opaque(), wid = tid >> 6, lane = tid & 63, fr = lane & 15, fq = lane >> 4;
  const bool lat = item < 128; int b, h, qb, seqbase, nkt;
  if (lat) { b = item >> 5; h = (item >> 3) & 3; qb = item & 7; seqbase = NCTX + b * 1024; nkt = 20; }
  else { const int i2 = item - 128; b = i2 >> 3; h = (i2 >> 1) & 3; qb = i2 & 1; seqbase = b * 256; nkt = 4; }
  LAS unsigned char* Ks = lds; LAS unsigned char* VT = lds + 64 * 272;
  const float2* rope = (const float2*)p.rope;
  const int qtok = qb * 128 + wid * 16 + fr;
  bf16x8 Qf[2][2];
  { const u16* qp = p.zA + (size_t)(seqbase + qtok) * ZLD + h * 128;
#pragma unroll
    for (int i = 0; i < 2; ++i)
#pragma unroll
      for (int kk = 0; kk < 2; ++kk) Qf[i][kk] = *(const bf16x8*)(qp + i * 64 + kk * 32 + fq * 8);
    if (lat) {
#pragma unroll
      for (int j = 0; j < 8; ++j) { const float2 cs = rope[qtok * 32 + fq * 8 + j];
#pragma unroll
        for (int i = 0; i < 2; ++i) { const float x1 = bf2f((u16)Qf[i][0][j]), x2 = bf2f((u16)Qf[i][1][j]);
          Qf[i][0][j] = (short)f2bf(x1 * cs.x - x2 * cs.y); Qf[i][1][j] = (short)f2bf(x1 * cs.y + x2 * cs.x); } }
    }
  }
  f32x4 O[2][8];
#pragma unroll
  for (int i = 0; i < 2; ++i)
#pragma unroll
    for (int d = 0; d < 8; ++d) O[i][d] = (f32x4){0.f, 0.f, 0.f, 0.f};
  float mrun[2] = {-1e30f, -1e30f}, lrun[2] = {0.f, 0.f};
  const float sc = 0.125f * 1.4426950408889634f;
  const int skey = tid >> 3, ssub = tid & 7, smap = ssub >> 2, spg = ssub & 3, sd1 = smap * 64 + spg * 8;
  f32x4 kraw[4], vraw[4]; float2 rcs[8];
#define ATT_ISSUE(kt_) do { const int kt__ = (kt_); const int gk = kt__ * 64 + skey, gkv = kt__ * 64 + lane; \
    if (lat && kt__ < 4) { const float* kp = p.cache_k + ((((size_t)(b * 2 + l) * 4 + h) * 256 + gk) * 128) + sd1; \
      kraw[0] = *(const f32x4*)kp; kraw[1] = *(const f32x4*)(kp + 4); kraw[2] = *(const f32x4*)(kp + 32); kraw[3] = *(const f32x4*)(kp + 36); \
      const float* vp = p.cache_v + ((((size_t)(b * 2 + l) * 4 + h) * 256 + gkv) * 128) + wid * 16; \
      vraw[0] = *(const f32x4*)vp; vraw[1] = *(const f32x4*)(vp + 4); vraw[2] = *(const f32x4*)(vp + 8); vraw[3] = *(const f32x4*)(vp + 12); \
    } else { const int tok = lat ? gk - 256 : gk, tokv = lat ? gkv - 256 : gkv; const u16* kp = p.zA + (size_t)(seqbase + tok) * ZLD + 512 + h * 128 + sd1; \
      kraw[0] = *(const f32x4*)kp; kraw[1] = *(const f32x4*)(kp + 32); \
      const u16* vp = p.zA + (size_t)(seqbase + tokv) * ZLD + 1024 + h * 128 + wid * 16; vraw[0] = *(const f32x4*)vp; vraw[1] = *(const f32x4*)(vp + 8); \
      if (lat) { _Pragma("unroll") for (int j = 0; j < 8; ++j) rcs[j] = rope[tok * 32 + spg * 8 + j]; } } } while (0)
  ATT_ISSUE(0);
  for (int kt = 0; kt < nkt; ++kt) {
    __syncthreads();
    { float x1[8], x2[8];
      if (lat && kt < 4) {
#pragma unroll
        for (int j = 0; j < 4; ++j) { x1[j] = kraw[0][j]; x1[j + 4] = kraw[1][j]; x2[j] = kraw[2][j]; x2[j + 4] = kraw[3][j]; }
      } else { const bf16x8 a = __builtin_bit_cast(bf16x8, kraw[0]), bb = __builtin_bit_cast(bf16x8, kraw[1]);
#pragma unroll
        for (int j = 0; j < 8; ++j) { x1[j] = bf2f((u16)a[j]); x2[j] = bf2f((u16)bb[j]); }
        if (lat) {
#pragma unroll
          for (int j = 0; j < 8; ++j) { const float2 cs = rcs[j]; const float o1 = x1[j] * cs.x - x2[j] * cs.y, o2 = x1[j] * cs.y + x2[j] * cs.x; x1[j] = o1; x2[j] = o2; }
        }
      }
      bf16x8 o1, o2;
      { u32x4 t1, t2;
#pragma unroll
        for (int j = 0; j < 4; ++j) { t1[j] = cvt_pk_bf16(x1[2 * j], x1[2 * j + 1]); t2[j] = cvt_pk_bf16(x2[2 * j], x2[2 * j + 1]); }
        o1 = __builtin_bit_cast(bf16x8, t1); o2 = __builtin_bit_cast(bf16x8, t2); }
      *(LAS bf16x8*)(Ks + skey * 272 + sd1 * 2) = o1; *(LAS bf16x8*)(Ks + skey * 272 + (sd1 + 32) * 2) = o2;
    }
    { const int key = lane, d0 = wid * 16; u16 xv[16];
      if (lat && kt < 4) {
#pragma unroll
        for (int q = 0; q < 4; ++q)
#pragma unroll
          for (int j = 0; j < 4; ++j) xv[q * 4 + j] = f2bf(vraw[q][j]);
      } else { const bf16x8 a = __builtin_bit_cast(bf16x8, vraw[0]), bb = __builtin_bit_cast(bf16x8, vraw[1]);
#pragma unroll
        for (int j = 0; j < 8; ++j) { xv[j] = (u16)a[j]; xv[j + 8] = (u16)bb[j]; } }
      const int pos = (key & 32) | (((key >> 2) & 3) << 3) | (((key >> 4) & 1) << 2) | (key & 3);
#pragma unroll
      for (int i = 0; i < 16; ++i) *(LAS u16*)(VT + (d0 + i) * 144 + pos * 2) = xv[i];
    }
    if (kt + 1 < nkt) ATT_ISSUE(kt + 1);
    __syncthreads();
    bf16x8 Pf[2][2];
#pragma unroll
    for (int i = 0; i < 2; ++i) {
      f32x4 S[4];
#pragma unroll
      for (int st = 0; st < 4; ++st) { S[st] = (f32x4){0.f, 0.f, 0.f, 0.f};
#pragma unroll
        for (int kk = 0; kk < 2; ++kk) { const bf16x8 Kf = *(const LAS bf16x8*)(Ks + (st * 16 + fr) * 272 + (i * 64 + kk * 32 + fq * 8) * 2);
          S[st] = __builtin_amdgcn_mfma_f32_16x16x32_bf16(Kf, Qf[i][kk], S[st], 0, 0, 0); } }
      float mx = -1e30f;
#pragma unroll
      for (int st = 0; st < 4; ++st)
#pragma unroll
        for (int j = 0; j < 4; ++j) mx = fmaxf(mx, S[st][j]);
      mx = fmaxf(mx, __shfl_xor(mx, 16)); mx = fmaxf(mx, __shfl_xor(mx, 32));
      const float mnew = fmaxf(mrun[i], mx), alpha = __builtin_amdgcn_exp2f((mrun[i] - mnew) * sc); mrun[i] = mnew;
      float ls = 0.f;
#pragma unroll
      for (int st = 0; st < 4; ++st)
#pragma unroll
        for (int j = 0; j < 4; ++j) { const float pv = __builtin_amdgcn_exp2f((S[st][j] - mnew) * sc); ls += pv; S[st][j] = pv; }
      lrun[i] = lrun[i] * alpha + ls;
#pragma unroll
      for (int d = 0; d < 8; ++d) O[i][d] *= alpha;
#pragma unroll
      for (int ks = 0; ks < 2; ++ks)
#pragma unroll
        for (int j = 0; j < 1; ++j) Pf[i][ks] = pack8(S[2 * ks], S[2 * ks + 1]);
    }
#pragma unroll
    for (int d = 0; d < 8; ++d)
#pragma unroll
      for (int ks = 0; ks < 2; ++ks) { const bf16x8 Vf = *(const LAS bf16x8*)(VT + (d * 16 + fr) * 144 + (ks * 32 + fq * 8) * 2);
        O[0][d] = __builtin_amdgcn_mfma_f32_16x16x32_bf16(Vf, Pf[0][ks], O[0][d], 0, 0, 0);
        O[1][d] = __builtin_amdgcn_mfma_f32_16x16x32_bf16(Vf, Pf[1][ks], O[1][d], 0, 0, 0); }
  }
#undef ATT_ISSUE
  float inv[2];
#pragma unroll
  for (int i = 0; i < 2; ++i) { float lt = lrun[i]; lt += __shfl_xor(lt, 16); lt += __shfl_xor(lt, 32); inv[i] = 1.f / lt; }
  const float lam = p.lam[l], li = lam_init_of(l); const float i0 = inv[0], i1 = inv[1] * lam;
  float ss = 0.f;
#pragma unroll
  for (int d = 0; d < 8; ++d)
#pragma unroll
    for (int j = 0; j < 4; ++j) { const float o = O[0][d][j] * i0 - O[1][d][j] * i1; O[0][d][j] = o; ss += o * o; }
  ss += __shfl_xor(ss, 16); ss += __shfl_xor(ss, 32);
  const float rstd = rsqrtf(ss * (1.f / 128.f) + EPS) * (1.f - li);
  u16* op = p.brin + (size_t)(seqbase + qtok) * 512 + h * 128 + fq * 4; const float* gs = p.g_attn_sub + l * 128 + fq * 4;
#pragma unroll
  for (int d = 0; d < 8; ++d) { const f32x4 g = *(const f32x4*)(gs + d * 16);
    *(bf16x4*)(op + d * 16) = pack4(O[0][d][0] * rstd * g[0], O[0][d][1] * rstd * g[1], O[0][d][2] * rstd * g[2], O[0][d][3] * rstd * g[3]); }
}

__device__ void mlstm_item(const Params& p, int l, int item, LAS unsigned char* lds) {
  const int tid = tid_opaque(), wid = tid >> 6, lane = tid & 63, fr = lane & 15, fq = lane >> 4;
  const bool lat = item < 32; int b, h, dir, seqbase, T;
  if (lat) { b = item >> 3; h = (item >> 1) & 3; dir = item & 1; seqbase = NCTX + b * 1024; T = 1024; }
  else { const int i2 = item - 32; b = i2 >> 3; h = (i2 >> 1) & 3; dir = i2 & 1; seqbase = b * 256; T = 256; }
  const int nch = T >> 6;
  LAS unsigned char* Qs = lds; LAS unsigned char* Ks = lds + 17408; LAS unsigned char* KTs = lds + 34816; LAS unsigned char* VTs = lds + 53248;
  LAS unsigned char* Cs = lds + 71680; LAS unsigned char* Ss = lds + 106496; LAS float* fl = (LAS float*)(lds + 115712);
  LAS float* a_s = fl; LAS float* g_s = fl + 64; LAS float* sp_s = fl + 128; LAS float* wl_s = fl + 192; LAS float* em_s = fl + 256; LAS float* nq_s = fl + 320;
  LAS float* denp = fl + 384; LAS float* nvec = fl + 512; LAS float* scal = fl + 640;
  const size_t sidx = ((size_t)(b * 2 + l) * 2 + dir) * 4 + h;
  f32x4 accC[8];
  __syncthreads();
  if (lat) { const float* cp = p.state_C + sidx * 16384 + (size_t)(wid * 16 + fr) * 128 + fq * 4;
#pragma unroll
    for (int kt = 0; kt < 8; ++kt) accC[kt] = *(const f32x4*)(cp + kt * 16);
    if (tid < 128) nvec[tid] = p.state_n[sidx * 128 + tid];
  } else {
#pragma unroll
    for (int kt = 0; kt < 8; ++kt) accC[kt] = (f32x4){0.f, 0.f, 0.f, 0.f};
    if (tid < 128) nvec[tid] = 0.f;
  }
#pragma unroll
  for (int kt = 0; kt < 8; ++kt) *(LAS bf16x4*)(Cs + (wid * 16 + fr) * 272 + (kt * 16 + fq * 4) * 2) = pack4(accC[kt][0], accC[kt][1], accC[kt][2], accC[kt][3]);
  float mst = lat ? p.state_m[sidx] : 0.f;
  f32x4 qraw[2], kraw[2], vraw[2]; float igr = 0.f, lfr = 0.f;
#define ML_ISSUE(ch_) do { const int ch__ = (ch_); { const int pos = tid >> 3, c16 = (tid & 7) * 16; const int gp_ = ch__ * 64 + pos, tok = dir ? T - 1 - gp_ : gp_; \
      const u16* zp = p.zA + (size_t)(seqbase + tok) * ZLD + h * 128 + c16; \
      qraw[0] = *(const f32x4*)(zp + 1536); qraw[1] = *(const f32x4*)(zp + 1536 + 8); kraw[0] = *(const f32x4*)(zp + 2048); kraw[1] = *(const f32x4*)(zp + 2048 + 8); } \
    { const int gp_ = ch__ * 64 + lane, tok = dir ? T - 1 - gp_ : gp_; const u16* vp = p.zA + (size_t)(seqbase + tok) * ZLD + 2560 + h * 128 + wid * 16; \
      vraw[0] = *(const f32x4*)vp; vraw[1] = *(const f32x4*)(vp + 8); \
      if (wid == 0) { const float* gp = p.gate + (size_t)(seqbase + tok) * 16 + dir * 8 + h; igr = gp[0]; lfr = gp[4]; } } } while (0)
  ML_ISSUE(0);
  for (int ch = 0; ch < nch; ++ch) {
    if (wid == 0) {
      const float ig = igr, lf = lfr; float bs = lf;
#pragma unroll
      for (int o = 1; o < 64; o <<= 1) { const float t = __shfl_up(bs, o); if (lane >= o) bs += t; }
      const float a = ig - bs; float gm = a;
#pragma unroll
      for (int o = 1; o < 64; o <<= 1) { const float t = __shfl_up(gm, o); if (lane >= o) gm = fmaxf(gm, t); }
      gm = fmaxf(gm, mst);
      const float g63 = __shfl(gm, 63), b63 = __shfl(bs, 63);
      a_s[lane] = a; g_s[lane] = gm; sp_s[lane] = __expf(mst - gm); wl_s[lane] = __expf(a - g63); em_s[lane] = __expf(-(bs + gm));
      if (lane == 0) { scal[0] = __expf(mst - g63); scal[1] = b63 + g63; } }
    { const int pos = tid >> 3, c16 = (tid & 7) * 16;
      *(LAS f32x4*)(Qs + pos * 272 + c16 * 2) = qraw[0]; *(LAS f32x4*)(Qs + pos * 272 + c16 * 2 + 16) = qraw[1];
      *(LAS f32x4*)(Ks + pos * 272 + c16 * 2) = kraw[0]; *(LAS f32x4*)(Ks + pos * 272 + c16 * 2 + 16) = kraw[1]; }
    { const bf16x8 v0 = __builtin_bit_cast(bf16x8, vraw[0]), v1 = __builtin_bit_cast(bf16x8, vraw[1]);
#pragma unroll
      for (int i = 0; i < 8; ++i) { *(LAS u16*)(VTs + (wid * 16 + i) * 144 + lane * 2) = (u16)v0[i]; *(LAS u16*)(VTs + (wid * 16 + 8 + i) * 144 + lane * 2) = (u16)v1[i]; } }
    if (ch + 1 < nch) ML_ISSUE(ch + 1);
    __syncthreads();
    { const float wl = wl_s[lane]; const bf16x8 k0 = *(const LAS bf16x8*)(Ks + lane * 272 + wid * 32), k1 = *(const LAS bf16x8*)(Ks + lane * 272 + wid * 32 + 16);
#pragma unroll
      for (int i = 0; i < 8; ++i) { *(LAS u16*)(KTs + (wid * 16 + i) * 144 + lane * 2) = f2bf(bf2f((u16)k0[i]) * wl); *(LAS u16*)(KTs + (wid * 16 + 8 + i) * 144 + lane * 2) = f2bf(bf2f((u16)k1[i]) * wl); } }
    { const int tt = wid & 3, spq = wid >> 2; const int t = tt * 16 + fr; const float gt = g_s[t]; float dsum = 0.f;
      bf16x8 Qf[4];
#pragma unroll
      for (int kk = 0; kk < 4; ++kk) Qf[kk] = *(const LAS bf16x8*)(Qs + t * 272 + (kk * 32 + fq * 8) * 2);
#pragma unroll
      for (int s2 = 0; s2 < 2; ++s2) { const int st = spq * 2 + s2; f32x4 acc = (f32x4){0.f, 0.f, 0.f, 0.f};
        if (st <= tt) {
#pragma unroll
          for (int kk = 0; kk < 4; ++kk) { const bf16x8 Kf = *(const LAS bf16x8*)(Ks + (st * 16 + fr) * 272 + (kk * 32 + fq * 8) * 2); acc = __builtin_amdgcn_mfma_f32_16x16x32_bf16(Kf, Qf[kk], acc, 0, 0, 0); }
        }
        float vv[4];
#pragma unroll
        for (int j = 0; j < 4; ++j) { const int s = st * 16 + fq * 4 + j; const float w = (s <= t) ? __expf(a_s[s] - gt) : 0.f; vv[j] = acc[j] * w; dsum += vv[j]; }
        *(LAS bf16x4*)(Ss + t * 144 + (st * 16 + fq * 4) * 2) = pack4(vv[0], vv[1], vv[2], vv[3]); }
      dsum += __shfl_xor(dsum, 16); dsum += __shfl_xor(dsum, 32);
      if (fq == 0) denp[spq * 64 + t] = dsum; }
    { const int t = tid >> 3, part = tid & 7; const bf16x8 q0 = *(const LAS bf16x8*)(Qs + t * 272 + part * 32), q1 = *(const LAS bf16x8*)(Qs + t * 272 + part * 32 + 16); float s = 0.f;
#pragma unroll
      for (int i = 0; i < 8; ++i) s += nvec[part * 16 + i] * bf2f((u16)q0[i]) + nvec[part * 16 + 8 + i] * bf2f((u16)q1[i]);
      s += __shfl_xor(s, 1); s += __shfl_xor(s, 2); s += __shfl_xor(s, 4);
      if (part == 0) nq_s[t] = s; }
    __syncthreads();
    const float decay = scal[0];
    { const int tt = wid & 3, vh = wid >> 2; const int t = tt * 16 + fr; const float spt = sp_s[t]; const float den = spt * nq_s[t] + denp[t] + denp[64 + t];
      const float rdn = 1.f / fmaxf(fabsf(den), em_s[t]);
      bf16x8 Qf[4], Sf[2];
#pragma unroll
      for (int kk = 0; kk < 4; ++kk) Qf[kk] = *(const LAS bf16x8*)(Qs + t * 272 + (kk * 32 + fq * 8) * 2);
#pragma unroll
      for (int ks = 0; ks < 2; ++ks) Sf[ks] = *(const LAS bf16x8*)(Ss + t * 144 + (ks * 32 + fq * 8) * 2);
      const int gp_ = ch * 64 + t, tok = dir ? T - 1 - gp_ : gp_; u16* hp = p.hdir + ((size_t)dir * NTOK + seqbase + tok) * 512 + h * 128 + fq * 4;
#pragma unroll
      for (int v4 = 0; v4 < 4; ++v4) { const int vt = vh * 4 + v4; f32x4 aS = (f32x4){0.f, 0.f, 0.f, 0.f}, aI = (f32x4){0.f, 0.f, 0.f, 0.f};
#pragma unroll
        for (int kk = 0; kk < 4; ++kk) { const bf16x8 Cf = *(const LAS bf16x8*)(Cs + (vt * 16 + fr) * 272 + (kk * 32 + fq * 8) * 2); aS = __builtin_amdgcn_mfma_f32_16x16x32_bf16(Cf, Qf[kk], aS, 0, 0, 0); }
#pragma unroll
        for (int ks = 0; ks < 2; ++ks) { const bf16x8 Vf = *(const LAS bf16x8*)(VTs + (vt * 16 + fr) * 144 + (ks * 32 + fq * 8) * 2); aI = __builtin_amdgcn_mfma_f32_16x16x32_bf16(Vf, Sf[ks], aI, 0, 0, 0); }
        *(bf16x4*)(hp + vt * 16) = pack4((spt * aS[0] + aI[0]) * rdn, (spt * aS[1] + aI[1]) * rdn, (spt * aS[2] + aI[2]) * rdn, (spt * aS[3] + aI[3]) * rdn); } }
    float nsum = 0.f;
    { bf16x8 Vf[2];
#pragma unroll
      for (int ks = 0; ks < 2; ++ks) Vf[ks] = *(const LAS bf16x8*)(VTs + (wid * 16 + fr) * 144 + (ks * 32 + fq * 8) * 2);
#pragma unroll
      for (int kt = 0; kt < 8; ++kt) { accC[kt] *= decay;
#pragma unroll
        for (int ks = 0; ks < 2; ++ks) { const bf16x8 Kf = *(const LAS bf16x8*)(KTs + (kt * 16 + fr) * 144 + (ks * 32 + fq * 8) * 2); accC[kt] = __builtin_amdgcn_mfma_f32_16x16x32_bf16(Kf, Vf[ks], accC[kt], 0, 0, 0); } }
      if (tid < 128) {
#pragma unroll
        for (int q = 0; q < 8; ++q) { const bf16x8 kv = *(const LAS bf16x8*)(KTs + tid * 144 + q * 16);
#pragma unroll
          for (int i = 0; i < 8; ++i) nsum += bf2f((u16)kv[i]); } } }
    mst = scal[1];
    __syncthreads();
#pragma unroll
    for (int kt = 0; kt < 8; ++kt) *(LAS bf16x4*)(Cs + (wid * 16 + fr) * 272 + (kt * 16 + fq * 4) * 2) = pack4(accC[kt][0], accC[kt][1], accC[kt][2], accC[kt][3]);
    if (tid < 128) nvec[tid] = decay * nvec[tid] + nsum;
  }
#undef ML_ISSUE
  if (!lat) {
    float* cpb = p.out + O_SC + sidx * 16384; const unsigned coff = (unsigned)((wid * 16 + fr) * 128 + fq * 4);
#pragma unroll
    for (int kt = 0; kt < 8; ++kt) *(f32x4*)(cpb + (coff + kt * 16)) = accC[kt];
    __syncthreads();
    if (tid < 128) p.out[O_SN + sidx * 128 + tid] = nvec[tid];
    if (tid == 0) p.out[O_SM + sidx] = mst;
  }
}

__device__ void mixers_phase(const Params& p, int ci, int l, LAS unsigned char* lds, int mask = 7) {
  __shared__ int s_item;
  const int tid = tid_opaque();
  for (;;) {
    __syncthreads();
    if (tid == 0) s_item = (int)atomicAdd(p.ctr + XB_CTR + ci, 1u);
    __syncthreads();
    const int item = s_item;
    if (item >= 768) break;
    const int ty = (item < 32 || (item >= 192 && item < 256)) ? 4 : ((item < 64 || (item >= 256 && item < 512)) ? 1 : 2);
    if (!(mask & ty)) continue;
    if (ty == 4) {
      OneSched S; int ld; float scale;
      if (item < 32) { const int b = item >> 3, mt = (item >> 1) & 3, nt = item & 1; ld = 2048; scale = 1.f / sqrtf(1024.f * 128.f);
        S.u.A = (const char*)(p.cs1024 + (size_t)mt * 256 * 2048); S.u.B = (const char*)(p.Yt + (size_t)32 * 512 * 512 + (size_t)b * 512 * 2048 + (size_t)nt * 256 * 2048);
        S.u.pm = NCTX + b * 1024 + mt * 256; S.u.pn = nt; S.u.aux = 0; }
      else { const int i2 = item - 192, b = i2 >> 1, nt = i2 & 1; ld = 512; scale = 1.f / sqrtf(256.f * 128.f);
        S.u.A = (const char*)p.cs256; S.u.B = (const char*)(p.Yt + (size_t)b * 512 * 512 + (size_t)nt * 256 * 512);
        S.u.pm = b * 256; S.u.pn = nt; S.u.aux = 0; }
      EpiFour E{p.brin + (size_t)NTOK * 512, scale};
      gemm_phase(lds, ld, ld, ld, S, E);
    } else if (ty == 1) mlstm_item(p, l, item < 64 ? item - 32 : 32 + (item - 256), lds);
    else attn_item(p, l, item < 192 ? item - 64 : 128 + (item - 512), lds);
  }
}

__device__ void mpost_phase(const Params& p, int l) {
  const int tid = tid_opaque(), wid = tid >> 6, lane = tid & 63;
  for (int row = blockIdx.x * 8 + wid; row < NTOK; row += gridDim.x * 8) {
    const bf16x8 hf = *(const bf16x8*)(p.hdir + (size_t)row * 512 + lane * 8), hb = *(const bf16x8*)(p.hdir + ((size_t)NTOK + row) * 512 + lane * 8);
    const bf16x8 mo = *(const bf16x8*)(p.zA + (size_t)row * ZLD + 3072 + lane * 8);
    float s[8], ss = 0.f;
#pragma unroll
    for (int i = 0; i < 8; ++i) { s[i] = bf2f((u16)hf[i]) + bf2f((u16)hb[i]); ss += s[i] * s[i]; }
    ss += __shfl_xor(ss, 1); ss += __shfl_xor(ss, 2); ss += __shfl_xor(ss, 4); ss += __shfl_xor(ss, 8);
    const float rstd = rsqrtf(ss * (1.f / 128.f) + EPS); const float* g = p.g_mlstm + l * 128 + (lane & 15) * 8; bf16x8 o;
#pragma unroll
    for (int i = 0; i < 8; ++i) o[i] = (short)f2bf(s[i] * rstd * g[i] * bf2f((u16)mo[i]));
    *(bf16x8*)(p.brin + ((size_t)2 * NTOK + row) * 512 + lane * 8) = o;
  }
}

__global__ void __launch_bounds__(512) fwd_megakernel(Params p_) {
  const Params& p = *(const Params*)(const __attribute__((address_space(4))) void*)__builtin_amdgcn_kernarg_segment_ptr();
  extern __shared__ __attribute__((aligned(16))) unsigned char shm_[];
  LAS unsigned char* lds = (LAS unsigned char*)shm_;
  cg::grid_group grid = cg::this_grid();
  const int G = gridDim.x, c = blockIdx.x;
  __shared__ uint4 xb_words;
  if (threadIdx.x == 0) xb_words = make_uint4(0u, 0u, 0u, 0u);
  __syncthreads();
  const XcdBarrier xb = xcd_barrier_post(p.ctr, (volatile LAS unsigned*)&xb_words);
#define GSYNC() xcd_barrier(xb)
  if (p.out == nullptr) grid.sync();
  for (int ph = 0; ph < 25; ++ph) {
    const int l = ph == 0 ? 0 : (ph - 1) / 12, kind = ph == 0 ? -1 : (ph - 1) - l * 12;
    const float* md = p.mods + (size_t)l * 5 * 9216;
    int hl = -1, hs = 0;
    if (kind == -1) { phase0(p, lds); hl = 0; hs = 0; }
    else if (kind == 0 || kind == 3 || kind == 9) {
      const int k = kind == 0 ? 0 : (kind == 3 ? 1 : 2);
      norm_phase(p, l, k, lds);
      if (kind == 0 && l == 1) { hl = 1; hs = 0; }
      if (kind == 3) { hl = l; hs = 1; }
    } else if (kind == 1 || kind == 10) {
      TileSched S{p.u, kind == 1 ? p.wt_ffn1_in : p.wt_ffn2_in, D, D, 48, 22, G, c}; EpiSwiglu E{p.zA}; gemm_phase(lds, D, D, D, S, E);
      if (kind == 1) { hl = l; hs = 1; } else if (l == 0) { hl = 1; hs = 0; }
    } else if (kind == 2 || kind == 11 || kind == 8) {
      const bool isout = kind == 8; const int Kd = isout ? D : DFF;
      TileSched S{isout ? p.u : p.zA, isout ? p.wt_out : (kind == 2 ? p.wt_ffn1_out : p.wt_ffn2_out), Kd, Kd, 48, 4, G, c};
      EpiResid E{p.out, md + (isout ? 5 : (kind == 2 ? 2 : 8)) * 1024, isout ? 1.0f : 0.5f}; gemm_phase(lds, Kd, Kd, Kd, S, E);
      if (kind == 2) { hl = l; hs = 1; } else if (l == 0) { hl = 1; hs = 0; }
    } else if (kind == 4) { TileSched S{p.u, p.wt_big, D, D, 48, 30, G, c}; EpiBig E{p.zA, p.gb, p.Yt, p.out, l}; gemm_phase(lds, D, D, D, S, E); }
    else if (kind == 5) mixers_phase(p, l, l, lds);
    else if (kind == 6) mpost_phase(p, l);
    else { BranchSched S{p.brin, p.wt_br, G, c}; EpiBranch E{(float*)p.zA, p.gb, p.u}; gemm_phase(lds, 512, 512, 512, S, E); if (l == 0) { hl = 1; hs = 0; } }
    if (hl >= 0) prep_seg(p, hl, hs, lds);
    GSYNC();
  }
  norm_phase(p, 0, 3, lds);
}

extern "C" void kernel_launch(void* const* d_in, const int* in_sizes, int n_in, void* d_out, int out_size, void* d_ws, size_t ws_size, hipStream_t stream) {
  static int grid_blocks = 0;
  if (!grid_blocks) {
    int dev = 0, cus = 0, per_cu = 0;
    hipGetDevice(&dev);
    hipDeviceGetAttribute(&cus, hipDeviceAttributeMultiprocessorCount, dev);
    hipFuncSetAttribute((const void*)fwd_megakernel, hipFuncAttributeMaxDynamicSharedMemorySize, LDS_BYTES);
    hipOccupancyMaxActiveBlocksPerMultiprocessor(&per_cu, (const void*)fwd_megakernel, 512, LDS_BYTES);
    if (per_cu < 1) per_cu = 1;
    grid_blocks = cus * 1;
    (void)hipGetLastError();
  }
  Params p{};
  const float** ip = (const float**)&p;
  for (int i = 0; i < 27; ++i) ip[i] = (const float*)d_in[i];
  p.out = (float*)d_out;
  char* w = (char*)d_ws; size_t off = 0;
  auto take = [&](size_t bytes) { char* r = w + off; off += (bytes + 255) & ~(size_t)255; return r; };
  p.wt_ffn1_in = (u16*)take((size_t)2 * DFF * D * 2); p.wt_ffn1_out = (u16*)take((size_t)D * DFF * 2);
  p.wt_ffn2_in = (u16*)take((size_t)2 * DFF * D * 2); p.wt_ffn2_out = (u16*)take((size_t)D * DFF * 2);
  p.wt_big = (u16*)take((size_t)NBIG * D * 2); p.wt_br = (u16*)take((size_t)3 * D * 512 * 2); p.wt_out = (u16*)take((size_t)D * D * 2);
  p.u = (u16*)take((size_t)NTOK * D * 2);
  p.zA = (u16*)take((size_t)NTOK * ZLD * 2); p.gb = (u16*)take((size_t)NTOK * GBLD * 2);
  p.Yt = (u16*)take((size_t)NTOK * 1024 * 2); p.brin = (u16*)take((size_t)3 * NTOK * 512 * 2); p.hdir = (u16*)take((size_t)2 * NTOK * 512 * 2);
  p.cs1024 = (u16*)take((size_t)1024 * 2048 * 2); p.cs256 = (u16*)take((size_t)256 * 512 * 2);
  p.mods = (float*)take((size_t)2 * 5 * 9216 * 4); p.gate = (float*)take((size_t)NTOK * 16 * 4); p.rope = (float*)take((size_t)1024 * 32 * 2 * 4);
  p.lam = (float*)take(256); p.ctr = (unsigned*)take(BAR_TOTAL_WORDS * 4);
  if (off > ws_size) { fprintf(stderr, "kernel_launch: workspace too small: need %zu have %zu\n", off, ws_size); return; }
  if (hipMemsetAsync(p.ctr, 0, BAR_TOTAL_WORDS * 4, stream) != hipSuccess) { fprintf(stderr, "memset failed\n"); return; }
  void* args[] = {&p};
  hipError_t e = hipLaunchCooperativeKernel((const void*)fwd_megakernel, dim3(grid_blocks), dim3(512), args, LDS_BYTES, stream);
  if (e != hipSuccess) fprintf(stderr, "cooperative launch failed: %s (grid %d)\n", hipGetErrorString(e), grid_blocks);
}
```

```cpp
#include <hip/hip_runtime.h>
#include <hip/hip_cooperative_groups.h>
#include <cstdio>
namespace cg = cooperative_groups;

typedef unsigned short u16;
typedef short bf16x8 __attribute__((ext_vector_type(8)));
typedef short bf16x4 __attribute__((ext_vector_type(4)));
typedef float f32x4 __attribute__((ext_vector_type(4)));
#define LAS __attribute__((address_space(3)))

constexpr int D = 1024, NTOK = 12288, NCTX = 8192, DFF = 2816, PIN = 4112, NBIG = 7936, ZLD = 3584, GBLD = 3072;
constexpr int LDS_BYTES = 131072;
#ifndef PROBE
#define PROBE 0
#endif
constexpr float EPS = 1e-6f;
constexpr size_t O_Y = 0, O_CK = 12582912, O_CV = 20971520, O_SC = 29360128, O_SN = 37748736, O_SM = 37814272;

struct Params {
  const float *x_prompt, *x_sample, *cache_k, *cache_v, *state_C, *state_n, *state_m, *c, *c_ctx, *w_ada, *b_ada, *g_norm,
      *w_ffn1_in, *w_ffn1_out, *w_ffn2_in, *w_ffn2_out, *w_in, *b_mgate, *attn_lambda, *g_attn_sub, *g_mlstm, *w_branch_gate,
      *w_br_attn, *w_br_four, *w_br_mlstm, *w_out, *g_final;
  float* out;
  u16 *wt_ffn1_in, *wt_ffn1_out, *wt_ffn2_in, *wt_ffn2_out, *wt_big, *wt_br, *wt_out;
  u16 *u, *zA, *gb, *Yt, *brin, *hdir, *cs1024, *cs256;
  float *mods, *gate, *rope, *lam, *part;
  unsigned* ctr;
};

typedef float f32x2_ __attribute__((ext_vector_type(2)));
typedef __bf16 bf16v2_ __attribute__((ext_vector_type(2)));
__device__ __forceinline__ unsigned cvt_pk_bf16(float lo, float hi) { f32x2_ v = {lo, hi}; bf16v2_ r = __builtin_convertvector(v, bf16v2_); return __builtin_bit_cast(unsigned, r); }
__device__ __forceinline__ u16 f2bf(float f) { return (u16)cvt_pk_bf16(f, 0.f); }
typedef unsigned u32x4 __attribute__((ext_vector_type(4)));
typedef unsigned u32x2 __attribute__((ext_vector_type(2)));
__device__ __forceinline__ float bf2f(u16 h) { return __uint_as_float(((unsigned)h) << 16); }
__device__ __forceinline__ int tid_opaque() { int t = threadIdx.x; asm volatile("" : "+v"(t)); return t; }
__device__ __forceinline__ float sigmoidf_(float x) { return __builtin_amdgcn_rcpf(1.f + __builtin_amdgcn_exp2f(-1.4426950408889634f * x)); }
__device__ __forceinline__ int cond_of(int row) { return row < NCTX ? 0 : 1 + ((row - NCTX) >> 10); }
__device__ __forceinline__ float lam_init_of(int l) { return l == 0 ? 0.2f : (0.8f - 0.6f * 0.74081822068f); }


#define XB_TMO      128
#define XB_XCNT(j)  (256  + 64 * (j))
#define XB_XSUB(j)  (1280 + 64 * (j))
#define XB_XGEN(j)  (2304 + 64 * (j))
#define XB_TOP      3328
#define XB_TOPGEN   3392
#define XCD_BAR_WORDS 3456
#define XB_CTR      3520
#define XB_PCNT     3584
#define BAR_TOTAL_WORDS 4096
#define XB_SPIN_CAP (1u << 18)
__device__ __forceinline__ unsigned xb_ld(unsigned* p)              { return __hip_atomic_load(p, __ATOMIC_RELAXED, __HIP_MEMORY_SCOPE_AGENT); }
__device__ __forceinline__ unsigned xb_add(unsigned* p, unsigned v) { return __hip_atomic_fetch_add(p, v, __ATOMIC_RELAXED, __HIP_MEMORY_SCOPE_AGENT); }
__device__ __forceinline__ unsigned xb_xcc_id() { return (unsigned)__builtin_amdgcn_s_getreg((3 << 11) | 20) & 0xFu; }
#define XB_SPIN(cond, bar) do { unsigned _sp = 0; while (cond) { __builtin_amdgcn_s_sleep(1); \
    if ((++_sp & 255u) == 0u) { if (xb_ld(&(bar)[XB_TMO])) break; if (_sp > XB_SPIN_CAP) { atomicAdd(&(bar)[XB_TMO], 1u); break; } } } } while (0)
struct XcdBarrier { unsigned* bar; unsigned x; volatile LAS unsigned* st; };
__device__ __forceinline__ XcdBarrier xcd_barrier_post(unsigned* bar, volatile LAS unsigned* st) {
  XcdBarrier b; b.bar = bar; b.x = xb_xcc_id(); b.st = st;
  if (threadIdx.x == 0) (void)xb_add(&bar[XB_XCNT(b.x)], 1u);
  return b;
}
__device__ __forceinline__ void xcd_barrier_complete(unsigned* bar, unsigned x, unsigned& nloc, unsigned& nx) {
  const unsigned G = gridDim.x * gridDim.y * gridDim.z;
  unsigned sum, cnt, mine, sp = 0u;
  for (;;) {
    sum = 0u; cnt = 0u; mine = 0u;
#pragma unroll
    for (unsigned j = 0; j < 16; ++j) { const unsigned c = xb_ld(&bar[XB_XCNT(j)]); sum += c; cnt += (c > 0u) ? 1u : 0u; mine = (j == x) ? c : mine; }
    if (sum == G) break;
    __builtin_amdgcn_s_sleep(1);
    if ((++sp & 255u) == 0u) { if (xb_ld(&bar[XB_TMO])) break; if (sp > XB_SPIN_CAP) { atomicAdd(&bar[XB_TMO], 1u); break; } }
  }
  nloc = mine > 0u ? mine : 1u; nx = cnt > 0u ? cnt : 1u;
}
__device__ __forceinline__ void xcd_barrier(const XcdBarrier& b) {
  asm volatile("s_waitcnt vmcnt(0)" ::: "memory");
  __syncthreads();
  if (threadIdx.x == 0) {
    unsigned* bar = b.bar;
    __builtin_amdgcn_s_waitcnt(0);
    unsigned nloc = b.st[0], nx = b.st[1];
    if (nloc == 0u) { xcd_barrier_complete(bar, b.x, nloc, nx); b.st[0] = nloc; b.st[1] = nx; }
    const unsigned old = xb_add(&bar[XB_XSUB(b.x)], 1u);
    const unsigned gen = old / nloc;
    if (old + 1u == (gen + 1u) * nloc) {
      __builtin_amdgcn_fence(__ATOMIC_RELEASE, "agent");
      asm volatile("s_waitcnt vmcnt(0)" ::: "memory");
      const unsigned og = xb_add(&bar[XB_TOP], 1u);
      const unsigned tg = og / nx;
      if (og + 1u == (tg + 1u) * nx) xb_add(&bar[XB_TOPGEN], 1u);
      else XB_SPIN(xb_ld(&bar[XB_TOPGEN]) == tg, bar);
      __builtin_amdgcn_fence(__ATOMIC_ACQUIRE, "agent");
      xb_add(&bar[XB_XGEN(b.x)], 1u);
      asm volatile("s_waitcnt vmcnt(0)" ::: "memory");
    } else {
      XB_SPIN(xb_ld(&bar[XB_XGEN(b.x)]) == gen, bar);
      __builtin_amdgcn_fence(__ATOMIC_ACQUIRE, "agent");
      asm volatile("s_waitcnt vmcnt(0)" ::: "memory");
    }
  }
  __syncthreads();
}

constexpr int BM = 256, BK = 64, HALF = 128, HTB = HALF * BK * 2;
__device__ __forceinline__ int lds_byte(int r, int c) { const int st = (r >> 4) * 2 + (c >> 5), rr = r & 15, cc = c & 31, ob = rr * 64 + cc * 2; return st * 1024 + (ob ^ (((ob >> 9) & 1) << 5)); }
__device__ __forceinline__ void stage_rc(int b, int& R, int& C) { const int st = b / 1024, sb = b % 1024, swz = sb ^ (((sb >> 9) & 1) << 5); R = (st >> 1) * 16 + swz / 64; C = (st & 1) * 32 + (swz % 64) / 2; }
__device__ __forceinline__ int perm32(int rho) { const int n = rho >> 4, i = rho & 15; return 8 * (i >> 2) + 4 * n + (i & 3); }

struct GUnit { const char* A; const char* B; int pm, pn, aux; };

__device__ __forceinline__ bool tile_order(int L, int nM, int nN, int& pm, int& pn) {
  const int nwg = nM * nN; if (L >= nwg) return false;
  int wgid = L; { const int q = nwg / 8, r = nwg % 8, xcd = wgid % 8, off = wgid / 8; wgid = (xcd < r ? xcd * (q + 1) : r * (q + 1) + (xcd - r) * q) + off; }
  const int nig = 8 * nN, gid = wgid / nig, fm = gid * 8, gsz = (nM - fm) < 8 ? (nM - fm) : 8;
  pm = fm + ((wgid % nig) % gsz); pn = (wgid % nig) / gsz; return true;
}

template <class Sched, class Epi>
__device__ __forceinline__ void gemm_phase(LAS unsigned char* lds, const int lda, const int ldb, const int K, const Sched& S, const Epi& E) {
  const int tid = tid_opaque(), wid = __builtin_amdgcn_readfirstlane(tid >> 6), lane = tid & 63, wr = wid >> 2, wc = wid & 3, fr = lane & 15, fq = lane >> 4;
  const int nt = K / BK;
  unsigned voffA[2], voffB[2];
#pragma unroll
  for (int i = 0; i < 2; ++i) { int R, C; stage_rc(tid * 16 + i * 8192, R, C); const int Rb = (R & ~31) + perm32(R & 31);
    voffA[i] = (unsigned)(R * lda + C) * 2u; voffB[i] = (unsigned)(Rb * ldb + C) * 2u; }
  const size_t kstep = (size_t)(BK * 2);
  const size_t hstepA = (size_t)HALF * lda * 2, hstepB = (size_t)HALF * ldb * 2;
  const unsigned ldsw = (unsigned)wid * 1024u;
  const int aoff = lds_byte(wr * 64 + fr, fq * 8), boff = lds_byte(wc * 32 + fr, fq * 8);
#define PG8_SA(b, h) (((b) * 2 + (h)) * HTB)
#define PG8_SB(b, h) ((4 + (b) * 2 + (h)) * HTB)
#define PG8_STAGE(bufoff, gbase, voff) do { _Pragma("unroll") for (int _i = 0; _i < 2; ++_i) \
    __builtin_amdgcn_global_load_lds((const unsigned*)((const char*)(gbase) + (voff)[_i]), (LAS unsigned*)(lds + (bufoff) + ldsw + _i * 8192), 16, 0, 0); } while (0)
#define PG8_LDA(dst, b, h) do { _Pragma("unroll") for (int m = 0; m < 4; ++m) _Pragma("unroll") for (int k = 0; k < 2; ++k) dst[m][k] = *(const LAS bf16x8*)(lds + PG8_SA(b, h) + aoff + m * 2048 + k * 1024); } while (0)
#define PG8_LDB(dst, b, h) do { _Pragma("unroll") for (int n = 0; n < 2; ++n) _Pragma("unroll") for (int k = 0; k < 2; ++k) dst[n][k] = *(const LAS bf16x8*)(lds + PG8_SB(b, h) + boff + n * 2048 + k * 1024); } while (0)
#define PG8_MMA(ai, bj, At, Bt) do { __builtin_amdgcn_s_setprio(1); _Pragma("unroll") for (int m = 0; m < 4; ++m) _Pragma("unroll") for (int n = 0; n < 2; ++n) _Pragma("unroll") for (int k = 0; k < 2; ++k) \
    acc[ai][bj][m][n] = __builtin_amdgcn_mfma_f32_16x16x32_bf16(Bt[n][k], At[m][k], acc[ai][bj][m][n], 0, 0, 0); __builtin_amdgcn_s_setprio(0); } while (0)
#define PG8_WAIT_V(n) asm volatile("s_waitcnt vmcnt(" #n ")" ::: "memory")
#define PG8_WAIT_L(n) asm volatile("s_waitcnt lgkmcnt(" #n ")" ::: "memory")
#define PG8_BAR __builtin_amdgcn_s_barrier()
#define PG8_SCHED __builtin_amdgcn_sched_barrier(0)
  GUnit cur, nxt; int ui = 0;
  if (!S.next(0, cur)) return;
  f32x4 acc[2][2][4][2];
#pragma unroll
  for (int a = 0; a < 2; ++a)
#pragma unroll
    for (int b = 0; b < 2; ++b)
#pragma unroll
      for (int m = 0; m < 4; ++m)
#pragma unroll
        for (int n = 0; n < 2; ++n) acc[a][b][m][n] = (f32x4){0.f, 0.f, 0.f, 0.f};
  bf16x8 At[4][2], B0[2][2], B1[2][2];
  const char* cA = cur.A; const char* cB = cur.B;
  PG8_STAGE(PG8_SB(0, 0), cB, voffB); PG8_STAGE(PG8_SA(0, 0), cA, voffA); PG8_STAGE(PG8_SB(0, 1), cB + hstepB, voffB); PG8_STAGE(PG8_SA(0, 1), cA + hstepA, voffA);
  if (wr == 1) PG8_BAR;
  PG8_WAIT_V(4); PG8_BAR;
  PG8_STAGE(PG8_SB(1, 0), cB + kstep, voffB); PG8_STAGE(PG8_SA(1, 0), cA + kstep, voffA); PG8_STAGE(PG8_SB(1, 1), cB + hstepB + kstep, voffB);
  PG8_WAIT_V(6); PG8_BAR;
  for (;;) {
    const bool has_next = S.next(ui + 1, nxt);
    const char* nA = has_next ? nxt.A : cA; const char* nB = has_next ? nxt.B : cB;
    for (int t = 0; t < nt; t += 2) {
      const bool last = (t == nt - 2);
      const char* a1 = cA + (size_t)(t + 1) * kstep;
      const char* a2 = last ? nA : cA + (size_t)(t + 2) * kstep; const char* b2 = last ? nB : cB + (size_t)(t + 2) * kstep;
      const char* a3 = a2 + kstep; const char* b3 = b2 + kstep;
      PG8_LDB(B0, 0, 0); PG8_SCHED; PG8_LDA(At, 0, 0); PG8_STAGE(PG8_SA(1, 1), a1 + hstepA, voffA);
      PG8_WAIT_L(8); PG8_BAR; PG8_WAIT_L(0); PG8_MMA(0, 0, At, B0); PG8_BAR; PG8_SCHED;
      PG8_LDB(B1, 0, 1); PG8_STAGE(PG8_SB(0, 0), b2, voffB);
      PG8_BAR; PG8_WAIT_L(0); PG8_MMA(0, 1, At, B1); PG8_BAR;
      PG8_LDA(At, 0, 1); PG8_STAGE(PG8_SA(0, 0), a2, voffA);
      PG8_BAR; PG8_WAIT_L(0); PG8_MMA(1, 0, At, B0); PG8_BAR; PG8_SCHED;
      PG8_STAGE(PG8_SB(0, 1), b2 + hstepB, voffB);
      PG8_WAIT_V(6); PG8_BAR; PG8_MMA(1, 1, At, B1); PG8_BAR;
      PG8_LDB(B0, 1, 0); PG8_SCHED; PG8_LDA(At, 1, 0); PG8_STAGE(PG8_SA(0, 1), a2 + hstepA, voffA);
      PG8_WAIT_L(8); PG8_BAR; PG8_WAIT_L(0); PG8_MMA(0, 0, At, B0); PG8_BAR; PG8_SCHED;
      PG8_LDB(B1, 1, 1); PG8_STAGE(PG8_SB(1, 0), b3, voffB);
      PG8_BAR; PG8_WAIT_L(0); PG8_MMA(0, 1, At, B1); PG8_BAR;
      PG8_LDA(At, 1, 1); PG8_STAGE(PG8_SA(1, 0), a3, voffA);
      PG8_BAR; PG8_WAIT_L(0); PG8_MMA(1, 0, At, B0); PG8_BAR; PG8_SCHED;
      PG8_STAGE(PG8_SB(1, 1), b3 + hstepB, voffB);
      PG8_WAIT_V(6); PG8_BAR; PG8_MMA(1, 1, At, B1); PG8_BAR;
    }
    if constexpr (!Epi::AFTER_DRAIN) E(acc, cur, wr, wc, fr, fq);
    if (!has_next) break;
#pragma unroll
    for (int a = 0; a < 2; ++a)
#pragma unroll
      for (int b = 0; b < 2; ++b)
#pragma unroll
        for (int m = 0; m < 4; ++m)
#pragma unroll
          for (int n = 0; n < 2; ++n) acc[a][b][m][n] = (f32x4){0.f, 0.f, 0.f, 0.f};
    cur = nxt; cA = nA; cB = nB; ++ui;
  }
  PG8_WAIT_V(0);
  if (wr == 0) PG8_BAR;
  PG8_BAR;
  if constexpr (Epi::AFTER_DRAIN) E.fused(acc, cur, wr, wc, fr, fq, lds);
#undef PG8_SA
#undef PG8_SB
#undef PG8_STAGE
#undef PG8_LDA
#undef PG8_LDB
#undef PG8_MMA
#undef PG8_WAIT_V
#undef PG8_WAIT_L
#undef PG8_BAR
#undef PG8_SCHED
}

struct TileSched {
  const u16* A; const u16* B; int lda, ldb, nM, nN, G, c;
  __device__ __forceinline__ bool next(int i, GUnit& u) const {
    int pm, pn; if (!tile_order(i * G + c, nM, nN, pm, pn)) return false;
    u.pm = pm; u.pn = pn; u.aux = 0; u.A = (const char*)(A + (size_t)pm * BM * lda); u.B = (const char*)(B + (size_t)pn * BM * ldb); return true;
  }
};
struct BranchSched {
  const u16* brin; const u16* wbr; int G, c;
  __device__ __forceinline__ bool next(int i, GUnit& u) const {
    int pm, pn; const int ti = i / 3, br = i - ti * 3; if (!tile_order(ti * G + c, 48, 4, pm, pn)) return false;
    u.pm = pm; u.pn = pn; u.aux = br; u.A = (const char*)(brin + (size_t)br * NTOK * 512 + (size_t)pm * BM * 512); u.B = (const char*)(wbr + (size_t)br * D * 512 + (size_t)pn * BM * 512); return true;
  }
};
struct OneSched { GUnit u; __device__ __forceinline__ bool next(int i, GUnit& o) const { if (i != 0) return false; o = u; return true; } };

__device__ __forceinline__ bf16x8 pack8(const f32x4& a, const f32x4& b) {
  u32x4 o; o[0] = cvt_pk_bf16(a[0], a[1]); o[1] = cvt_pk_bf16(a[2], a[3]); o[2] = cvt_pk_bf16(b[0], b[1]); o[3] = cvt_pk_bf16(b[2], b[3]); return __builtin_bit_cast(bf16x8, o);
}
__device__ __forceinline__ bf16x4 pack4(float a, float b, float c, float d) { u32x2 o; o[0] = cvt_pk_bf16(a, b); o[1] = cvt_pk_bf16(c, d); return __builtin_bit_cast(bf16x4, o); }

struct EpiSwiglu {
  static constexpr bool AFTER_DRAIN = false;
  u16* h;
  __device__ __forceinline__ void operator()(const f32x4 (&acc)[2][2][4][2], const GUnit& u, int wr, int wc, int fr, int fq) const {
    const int row0 = u.pm * BM + wr * 64 + fr, col0 = u.pn * 128 + wc * 32 + fq * 8;
#pragma unroll
    for (int ai = 0; ai < 2; ++ai)
#pragma unroll
      for (int m = 0; m < 4; ++m) {
        f32x4 r[2];
#pragma unroll
        for (int n = 0; n < 2; ++n)
#pragma unroll
          for (int j = 0; j < 4; ++j) { const float a = acc[ai][0][m][n][j], g = acc[ai][1][m][n][j]; r[n][j] = a * sigmoidf_(a) * g; }
        *(bf16x8*)(h + (size_t)(row0 + ai * HALF + m * 16) * DFF + col0) = pack8(r[0], r[1]);
      }
  }
};
struct EpiResidNorm {
  static constexpr bool AFTER_DRAIN = true;
  const Params& p; int l, kind;
  __device__ __forceinline__ void fused(f32x4 (&acc)[2][2][4][2], const GUnit& un, int wr, int wc, int fr, int fq, LAS unsigned char* lds) const {
    const bool isout = kind == 8, fin = (kind == 11 && l == 1), firstres = (l == 0 && kind == 2);
    const int use = l * 3 + (kind == 2 ? 0 : (isout ? 1 : 2)), nk = kind == 2 ? 1 : (isout ? 2 : 0), nl = kind == 11 ? l + 1 : l;
    float* x = p.out; const float* xc = firstres ? p.x_prompt : p.out; const float* xl = firstres ? p.x_sample : p.out + (size_t)NCTX * D;
    const float* gatev = p.mods + (size_t)l * 5 * 9216 + (isout ? 5 : (kind == 2 ? 2 : 8)) * 1024; const float coef = isout ? 1.0f : 0.5f;
    u16* u = p.u; const float* gn = fin ? p.g_final : p.g_norm + ((size_t)nl * 3 + nk) * D; const float* mdn = fin ? p.mods : p.mods + (size_t)nl * 5 * 9216 + nk * 3 * 1024;
    float* part = p.part + (size_t)use * 48 * 4 * 256; unsigned* cnt = p.ctr + XB_PCNT + use * 48;
    const int tid = tid_opaque();
    const int row0 = un.pm * BM + wr * 64 + fr, col0 = un.pn * BM + wc * 32 + fq * 8;
    const int cond = cond_of(un.pm * BM);
    const float* gp = gatev + cond * 9216 + col0;
    const float* xs = (un.pm < 32) ? xc : xl - (size_t)NCTX * D;
    LAS float* rp = (LAS float*)lds; LAS float* rs = rp + 1024;
    f32x4 g[2][2];
#pragma unroll
    for (int bj = 0; bj < 2; ++bj)
#pragma unroll
      for (int n = 0; n < 2; ++n) g[bj][n] = coef * *(const f32x4*)(gp + bj * HALF + n * 4);
#pragma unroll
    for (int ai = 0; ai < 2; ++ai)
#pragma unroll
      for (int m = 0; m < 4; ++m) {
        f32x4 xv[2][2];
#pragma unroll
        for (int bj = 0; bj < 2; ++bj)
#pragma unroll
          for (int n = 0; n < 2; ++n) xv[bj][n] = *(const f32x4*)(xs + (size_t)(row0 + ai * HALF + m * 16) * D + col0 + bj * HALF + n * 4);
        float s = 0.f;
#pragma unroll
        for (int bj = 0; bj < 2; ++bj)
#pragma unroll
          for (int n = 0; n < 2; ++n) { const f32x4 xn = xv[bj][n] + g[bj][n] * acc[ai][bj][m][n]; acc[ai][bj][m][n] = xn;
            s += xn[0] * xn[0] + xn[1] * xn[1] + xn[2] * xn[2] + xn[3] * xn[3];
            if (!fin) *(f32x4*)(x + (size_t)(row0 + ai * HALF + m * 16) * D + col0 + bj * HALF + n * 4) = xn; }
        s += __shfl_xor(s, 16); s += __shfl_xor(s, 32);
        if (fq == 0) rp[(ai * HALF + wr * 64 + m * 16 + fr) * 4 + wc] = s;
      }
    __syncthreads();
    float* slot = part + (size_t)(un.pm * 4) * 256;
    if (tid < 256) { const float t = (rp[tid * 4] + rp[tid * 4 + 1]) + (rp[tid * 4 + 2] + rp[tid * 4 + 3]);
      __hip_atomic_store(slot + un.pn * 256 + tid, t, __ATOMIC_RELAXED, __HIP_MEMORY_SCOPE_AGENT); }
    asm volatile("s_waitcnt vmcnt(0)" ::: "memory");
    __syncthreads();
    if (tid == 0) {
      __hip_atomic_fetch_add(cnt + un.pm, 1u, __ATOMIC_RELAXED, __HIP_MEMORY_SCOPE_AGENT);
      unsigned sp = 0;
      while (__hip_atomic_load(cnt + un.pm, __ATOMIC_RELAXED, __HIP_MEMORY_SCOPE_AGENT) < 4u) { __builtin_amdgcn_s_sleep(1); if (++sp > (1u << 22)) break; }
    }
    __syncthreads();
    if (tid < 256) { float t = 0.f;
#pragma unroll
      for (int q = 0; q < 4; ++q) t += __hip_atomic_load(slot + q * 256 + tid, __ATOMIC_RELAXED, __HIP_MEMORY_SCOPE_AGENT);
      rs[tid] = rsqrtf(t * (1.f / 1024.f) + EPS); }
    __syncthreads();
    const float* md = mdn + cond * 9216 + col0; const float* gnp = gn + col0;
    f32x4 gw[2][2], sh[2][2];
#pragma unroll
    for (int bj = 0; bj < 2; ++bj)
#pragma unroll
      for (int n = 0; n < 2; ++n) { gw[bj][n] = *(const f32x4*)(gnp + bj * HALF + n * 4);
        if (!fin) { gw[bj][n] *= (1.f + *(const f32x4*)(md + 1024 + bj * HALF + n * 4)); sh[bj][n] = *(const f32x4*)(md + bj * HALF + n * 4); } }
#pragma unroll
    for (int ai = 0; ai < 2; ++ai)
#pragma unroll
      for (int m = 0; m < 4; ++m) { const int rl = ai * HALF + wr * 64 + m * 16 + fr; const float rstd = rs[rl]; const unsigned eo = (unsigned)((un.pm * BM + rl) * D + col0);
#pragma unroll
        for (int bj = 0; bj < 2; ++bj) {
          if (fin) { *(f32x4*)(x + (eo + bj * HALF)) = acc[ai][bj][m][0] * rstd * gw[bj][0]; *(f32x4*)(x + (eo + bj * HALF + 4)) = acc[ai][bj][m][1] * rstd * gw[bj][1]; }
          else *(bf16x8*)(u + (eo + bj * HALF)) = pack8(acc[ai][bj][m][0] * rstd * gw[bj][0] + sh[bj][0], acc[ai][bj][m][1] * rstd * gw[bj][1] + sh[bj][1]); } }
  }
};
struct EpiBig {
  static constexpr bool AFTER_DRAIN = false;
  u16 *zA, *gb, *Yt; float* out; int l; float* gate; const float* bmg;
  __device__ __forceinline__ void operator()(const f32x4 (&acc)[2][2][4][2], const GUnit& u, int wr, int wc, int fr, int fq) const {
    const int row0 = u.pm * BM + wr * 64 + fr; const int pn = u.pn; const int colw = wc * 32 + fq * 8;
#pragma unroll
    for (int ai = 0; ai < 2; ++ai)
#pragma unroll
      for (int m = 0; m < 4; ++m) {
        const int row = row0 + ai * HALF + m * 16;
#pragma unroll
        for (int bj = 0; bj < 2; ++bj) {
          const int c = pn * BM + bj * HALF + colw;
          f32x4 v0 = acc[ai][bj][m][0], v1 = acc[ai][bj][m][1];
          if (pn < 6) {
            *(bf16x8*)(zA + (size_t)row * ZLD + c) = pack8(v0, v1);
            if (pn >= 2 && row < NCTX) {
              const int cc = (c - 512) & 511, hh = cc >> 7, d = cc & 127, b = row >> 8, t = row & 255;
              float* o = out + (pn < 4 ? O_CK : O_CV) + ((((size_t)(b * 2 + l) * 4 + hh) * 256 + t) * 128 + d);
              *(f32x4*)o = v0; *(f32x4*)(o + 4) = v1;
            }
          } else if (pn < 10) {
            const int cp = c - 1536, g = cp >> 8, j = cp & 255, cs = j >> 7, np = j & 127;
            u16* base;
            if (row < NCTX) { const int b = row >> 8, t = row & 255; base = Yt + (size_t)b * 512 * 512 + (size_t)(g * 128 + np) * 512 + cs * 256 + t;
#pragma unroll
              for (int q = 0; q < 4; ++q) { base[(size_t)q * 512] = f2bf(v0[q]); base[(size_t)(q + 4) * 512] = f2bf(v1[q]); }
            } else { const int rr = row - NCTX, b = rr >> 10, t = rr & 1023; base = Yt + (size_t)32 * 512 * 512 + (size_t)b * 512 * 2048 + (size_t)(g * 128 + np) * 2048 + cs * 1024 + t;
#pragma unroll
              for (int q = 0; q < 4; ++q) { base[(size_t)q * 2048] = f2bf(v0[q]); base[(size_t)(q + 4) * 2048] = f2bf(v1[q]); }
            }
          } else if (pn < 18) {
            if (pn == 12 || pn == 13) { v0 *= 0.08838834764831845f; v1 *= 0.08838834764831845f; }
            if (pn >= 16) {
#pragma unroll
              for (int q = 0; q < 4; ++q) { v0[q] = sigmoidf_(v0[q]); v1[q] = sigmoidf_(v1[q]); }
            }
            *(bf16x8*)(zA + (size_t)row * ZLD + (c - 1024)) = pack8(v0, v1);
          } else if (pn < 30) {
#pragma unroll
            for (int q = 0; q < 4; ++q) { v0[q] = sigmoidf_(v0[q]); v1[q] = sigmoidf_(v1[q]); }
            *(bf16x8*)(gb + (size_t)row * GBLD + (c - 4608)) = pack8(v0, v1);
          } else if (bj == 0 && wc == 0 && fq < 2) {
#pragma unroll
            for (int q = 0; q < 8; ++q) { const int j = fq * 8 + q; float a = (q < 4 ? v0[q] : v1[q - 4]) + bmg[l * 16 + j];
              if ((j >> 2) & 1) a = fminf(a, 0.f) - log1pf(__expf(-fabsf(a)));
              gate[(size_t)row * 16 + j] = a; }
          }
        }
      }
  }
};
struct EpiBranch {
  static constexpr bool AFTER_DRAIN = false;
  float* tmp; const u16* gb; u16* merged;
  __device__ __forceinline__ void operator()(const f32x4 (&acc)[2][2][4][2], const GUnit& u, int wr, int wc, int fr, int fq) const {
    const int row0 = u.pm * BM + wr * 64 + fr, col0 = u.pn * BM + wc * 32 + fq * 8; const int br = u.aux;
#pragma unroll
    for (int ai = 0; ai < 2; ++ai)
#pragma unroll
      for (int mp = 0; mp < 2; ++mp) {
        bf16x8 g8[2][2]; f32x4 tv[2][2][2];
#pragma unroll
        for (int mm = 0; mm < 2; ++mm)
#pragma unroll
          for (int bj = 0; bj < 2; ++bj) { const int row = row0 + ai * HALF + (mp * 2 + mm) * 16, c = col0 + bj * HALF;
            g8[mm][bj] = *(const bf16x8*)(gb + (size_t)row * GBLD + br * D + c);
            if (br > 0) { const float* tp = tmp + (size_t)row * D + c; tv[mm][bj][0] = *(const f32x4*)tp; tv[mm][bj][1] = *(const f32x4*)(tp + 4); } }
#pragma unroll
        for (int mm = 0; mm < 2; ++mm)
#pragma unroll
          for (int bj = 0; bj < 2; ++bj) { const int row = row0 + ai * HALF + (mp * 2 + mm) * 16, c = col0 + bj * HALF; const int m = mp * 2 + mm;
            f32x4 r0, r1;
#pragma unroll
            for (int q = 0; q < 4; ++q) { r0[q] = bf2f((u16)g8[mm][bj][q]) * acc[ai][bj][m][0][q]; r1[q] = bf2f((u16)g8[mm][bj][q + 4]) * acc[ai][bj][m][1][q]; }
            if (br > 0) { r0 += tv[mm][bj][0]; r1 += tv[mm][bj][1]; }
            float* tp = tmp + (size_t)row * D + c;
            if (br < 2) { *(f32x4*)tp = r0; *(f32x4*)(tp + 4) = r1; }
            else *(bf16x8*)(merged + (size_t)row * D + c) = pack8(r0, r1); }
      }
  }
};
struct EpiFour {
  static constexpr bool AFTER_DRAIN = false;
  u16* fo; float scale;
  __device__ __forceinline__ void operator()(const f32x4 (&acc)[2][2][4][2], const GUnit& u, int wr, int wc, int fr, int fq) const {
    const int row0 = u.pm + wr * 64 + fr, col0 = u.pn * BM + wc * 32 + fq * 8;
#pragma unroll
    for (int ai = 0; ai < 2; ++ai)
#pragma unroll
      for (int m = 0; m < 4; ++m)
#pragma unroll
        for (int bj = 0; bj < 2; ++bj)
          *(bf16x8*)(fo + (size_t)(row0 + ai * HALF + m * 16) * 512 + col0 + bj * HALF) = pack8(acc[ai][bj][m][0] * scale, acc[ai][bj][m][1] * scale);
  }
};

struct TrJob { const float* src; u16* dst; int lds_, ldd, k0, ns0, nd0, mode; };
__device__ __forceinline__ void tr_decode(const Params& p, int l, int j, TrJob& t) {
  t.mode = 0;
  if (j < 352 || (j >= 528 && j < 880)) { const bool second = j >= 528; const int q = second ? j - 528 : j; const int kt = q / 22, nb = q % 22;
    t.src = (second ? p.w_ffn2_in : p.w_ffn1_in) + (size_t)l * D * 2 * DFF; t.dst = second ? p.wt_ffn2_in : p.wt_ffn1_in; t.lds_ = 2 * DFF; t.ldd = D; t.k0 = kt * 64; t.ns0 = nb * 256; t.nd0 = 0; t.mode = 1; }
  else if (j < 528 || (j >= 880 && j < 1056)) { const bool second = j >= 880; const int q = second ? j - 880 : j - 352; const int kt = q >> 2, nb = q & 3;
    t.src = (second ? p.w_ffn2_out : p.w_ffn1_out) + (size_t)l * DFF * D; t.dst = second ? p.wt_ffn2_out : p.wt_ffn1_out; t.lds_ = D; t.ldd = DFF; t.k0 = kt * 64; t.ns0 = nb * 256; t.nd0 = t.ns0; }
  else if (j < 1280) { const int q = j - 1056, kt = q / 14, nb = q % 14; t.src = p.w_in + (size_t)l * D * PIN; t.dst = p.wt_big; t.lds_ = PIN; t.ldd = D; t.k0 = kt * 64;
    if (nb < 6) { t.ns0 = nb * 256; t.nd0 = t.ns0; } else { t.ns0 = 2048 + (nb - 6) * 256; t.nd0 = t.ns0 + 512; } }
  else if (j < 1472) { const int q = j - 1280, kt = q / 12, nb = q % 12; t.src = p.w_branch_gate + (size_t)l * D * 3 * D; t.dst = p.wt_big; t.lds_ = 3 * D; t.ldd = D; t.k0 = kt * 64; t.ns0 = nb * 256; t.nd0 = 4608 + t.ns0; }
  else if (j < 1568) { const int q = j - 1472, br = q >> 5, jj = q & 31, kt = jj >> 2, nb = jj & 3;
    t.src = (br == 0 ? p.w_br_attn : br == 1 ? p.w_br_four : p.w_br_mlstm) + (size_t)l * 512 * D; t.dst = p.wt_br + (size_t)br * D * 512; t.lds_ = D; t.ldd = 512; t.k0 = kt * 64; t.ns0 = nb * 256; t.nd0 = t.ns0; }
  else { const int q = j - 1568, kt = q >> 2, nb = q & 3; t.src = p.w_out + (size_t)l * D * D; t.dst = p.wt_out; t.lds_ = D; t.ldd = D; t.k0 = kt * 64; t.ns0 = nb * 256; t.nd0 = t.ns0; }
}
__device__ __forceinline__ void tr_load(const TrJob& t, int tid, f32x4 (&r)[8]) {
#pragma unroll
  for (int i = 0; i < 8; ++i) { const int idx = tid + i * 512, kk = idx >> 6, c4 = idx & 63; r[i] = *(const f32x4*)(t.src + (size_t)(t.k0 + kk) * t.lds_ + t.ns0 + c4 * 4); }
}

__device__ void wf_job(const Params& p, int l, int job, LAS float* sm) {
  const int tid = tid_opaque();
  const int g = job >> 5, kb = (job >> 1) & 15, jh = job & 1; LAS float* W = sm; LAS float* ct = sm + 64 * 129;
  __syncthreads();
  for (int i = tid; i < 64 * 32; i += 512) { const int kk = i >> 5, c4 = i & 31;
    const float4 v = *(const float4*)(p.w_in + ((size_t)l * D + kb * 64 + kk) * PIN + 1536 + g * 128 + c4 * 4);
    LAS float* s = W + kk * 129 + c4 * 4; s[0] = v.x; s[1] = v.y; s[2] = v.z; s[3] = v.w; }
  if (tid < 128) ct[tid] = cospif((float)tid / 64.f);
  __syncthreads();
  const int kk = tid & 63, jg = tid >> 6; float a[16];
#pragma unroll
  for (int q = 0; q < 16; ++q) a[q] = 0.f;
  const int jbase = jh * 128 + jg * 16;
  for (int c = 0; c < 128; ++c) { const float w = W[kk * 129 + c];
#pragma unroll
    for (int q = 0; q < 16; ++q) { const int j = jbase + q; const int idx = jh ? ((c * (j - 128) - 32) & 127) : ((c * j) & 127); a[q] += w * ct[idx]; } }
#pragma unroll
  for (int q = 0; q < 16; ++q) p.wt_big[(size_t)(1536 + g * 256 + jbase + q) * D + kb * 64 + kk] = f2bf(a[q]);
}

__device__ void mods_job(const Params& p, int job, LAS float* sm) {
  const int tid = tid_opaque();
  const int l = job / 72, cb = job % 72; LAS float* sc = sm; LAS float* part = sm + 5 * 1024;
  __syncthreads();
  for (int i = tid; i < 5 * 1024; i += 512) { const int ci = i >> 10, k = i & 1023; const float v = ci == 0 ? p.c_ctx[k] : p.c[(ci - 1) * D + k]; sc[i] = v * sigmoidf_(v); }
  __syncthreads();
  const int cg4 = tid & 31, kp = tid >> 5; f32x4 a[5];
#pragma unroll
  for (int ci = 0; ci < 5; ++ci) a[ci] = (f32x4){0.f, 0.f, 0.f, 0.f};
  const float* wp = p.w_ada + ((size_t)l * D + kp * 64) * 9216 + cb * 128 + cg4 * 4;
#pragma unroll 8
  for (int k = 0; k < 64; ++k) { const f32x4 w = *(const f32x4*)(wp + (size_t)k * 9216);
#pragma unroll
    for (int ci = 0; ci < 5; ++ci) a[ci] += sc[ci * 1024 + kp * 64 + k] * w; }
#pragma unroll
  for (int ci = 0; ci < 5; ++ci)
#pragma unroll
    for (int q = 0; q < 4; ++q) part[(kp * 5 + ci) * 128 + cg4 * 4 + q] = a[ci][q];
  __syncthreads();
  for (int o = tid; o < 640; o += 512) { const int ci = o >> 7, cc = o & 127; float s = p.b_ada[(size_t)l * 9216 + cb * 128 + cc];
    for (int q = 0; q < 16; ++q) s += part[(q * 5 + ci) * 128 + cc];
    p.mods[((size_t)l * 5 + ci) * 9216 + cb * 128 + cc] = s; }
}

__device__ void prep_seg(const Params& p, int l, int seg, LAS unsigned char* lds, volatile LAS int* segdone) {
  if (segdone[l * 2 + seg]) return;
  const int tid = tid_opaque(); LAS float* sm = (LAS float*)lds; LAS int* s_job = (LAS int*)(lds + 131072 - 16);
  const int qi = 8 + l * 2 + seg;
  const int npre = seg ? 129 : (l == 0 ? 144 : 0), trofs = seg ? 528 : 0, ntr = seg ? 1104 : 528;
  const int trbase = npre, njobs = npre + ntr;
  int job;
  for (;;) {
    __syncthreads();
    if (tid == 0) *s_job = (int)atomicAdd(p.ctr + XB_CTR + qi, 1u);
    __syncthreads();
    job = *s_job;
    if (job >= njobs && tid == 0) segdone[l * 2 + seg] = 1;
    if (job >= trbase) break;
    if (seg && job == 128) { for (int i = tid; i < 16 * 1024; i += 512) { const int j = i >> 10, k = i & 1023; p.wt_big[(size_t)(7680 + j) * D + k] = f2bf(p.w_in[((size_t)l * D + k) * PIN + 4096 + j]); } }
    else if (seg) wf_job(p, l, job, sm); else mods_job(p, job, sm);
  }
  if (job >= njobs) return;
  f32x4 r[8]; TrJob t;
  tr_decode(p, l, job - trbase + trofs, t); tr_load(t, tid, r);
  for (;;) {
    __syncthreads();
#pragma unroll
    for (int i = 0; i < 8; ++i) { const int idx = tid + i * 512, kk = idx >> 6, c4 = idx & 63; LAS float* s = sm + kk * 257 + c4 * 4; s[0] = r[i][0]; s[1] = r[i][1]; s[2] = r[i][2]; s[3] = r[i][3]; }
    if (tid == 0) *s_job = (int)atomicAdd(p.ctr + XB_CTR + qi, 1u);
    __syncthreads();
    const int nextjob = *s_job; const TrJob cur = t;
    if (nextjob >= njobs && tid == 0) segdone[l * 2 + seg] = 1;
    if (nextjob < njobs) { tr_decode(p, l, nextjob - trbase + trofs, t); tr_load(t, tid, r); }
#pragma unroll
    for (int i = 0; i < 4; ++i) { const int unit = tid + i * 512, nn = unit >> 3, ch = unit & 7; bf16x8 o;
#pragma unroll
      for (int q = 0; q < 8; ++q) o[q] = (short)f2bf(sm[(ch * 8 + q) * 257 + nn]);
      int drow;
      if (cur.mode == 1) { const int col = cur.ns0 + nn, isg = col >= DFF, hid = col - isg * DFF; drow = (hid >> 7) * 256 + isg * 128 + (hid & 127); } else drow = cur.nd0 + nn;
      *(bf16x8*)(cur.dst + (size_t)drow * cur.ldd + cur.k0 + ch * 8) = o; }
    if (nextjob >= njobs) break;
  }
}

__device__ void phase0(const Params& p, LAS unsigned char* lds) {
  const int tid = tid_opaque(); const int G = gridDim.x;
  if (blockIdx.x == 0 && tid >= 64 && tid < 66) { const int l = tid - 64; const float* lp = p.attn_lambda + l * 256; float s1 = 0.f, s2 = 0.f;
    for (int i = 0; i < 64; ++i) { s1 += lp[i] * lp[64 + i]; s2 += lp[128 + i] * lp[192 + i]; }
    p.lam[l] = expf(s1) - expf(s2) + lam_init_of(l); }
  const int gtid = blockIdx.x * 512 + tid, gn = G * 512;
  for (int i = gtid; i < 1024 * 2048; i += gn) { const int tp = i >> 11, col = i & 2047, t = col & 1023, s = col >> 10; const int r = (t * tp) & 1023; const float x = (float)r / 512.f;
    p.cs1024[i] = f2bf(s ? -sinpif(x) : cospif(x)); }
  for (int i = gtid; i < 256 * 512; i += gn) { const int tp = i >> 9, col = i & 511, t = col & 255, s = col >> 8; const int r = (t * tp) & 255; const float x = (float)r / 128.f;
    p.cs256[i] = f2bf(s ? -sinpif(x) : cospif(x)); }
  for (int i = gtid; i < 1024 * 32; i += gn) { const int t = i >> 5, pp = i & 31; const float pos = pp < 16 ? (float)(t >> 6) : (float)(t & 63);
    const float inv = powf(10000.f, -(float)(pp & 15) / 16.f); float s, c; sincosf(pos * inv, &s, &c); p.rope[2 * i] = c; p.rope[2 * i + 1] = s; }
}

__device__ __forceinline__ float wave_sum(float v) {
#pragma unroll
  for (int o = 32; o >= 1; o >>= 1) v += __shfl_xor(v, o);
  return v;
}
__device__ void norm_phase(const Params& p, int l, int which, LAS unsigned char* lds) {
  const int tid = tid_opaque(), wid = tid >> 6, lane = tid & 63; const bool gates = which == 1;
  LAS float* Wg = (LAS float*)lds; LAS float* ur = Wg + 16384 + wid * 1024;
  if (gates) { __syncthreads();
    for (int i = tid; i < 4096; i += 512) { const int k = i >> 2, q = i & 3; const float4 v = *(const float4*)(p.w_in + ((size_t)l * D + k) * PIN + 4096 + q * 4);
      LAS float* s = Wg + k * 16 + q * 4; s[0] = v.x; s[1] = v.y; s[2] = v.z; s[3] = v.w; }
    __syncthreads(); }
  float* X = p.out; const bool first = (l == 0 && which == 0);
  const float* Xc = first ? p.x_prompt : X; const float* Xl = first ? p.x_sample : X + (size_t)NCTX * D;
#define XROW(r) ((r) < NCTX ? Xc + (size_t)(r) * D : Xl + (size_t)((r) - NCTX) * D)
  f32x4 v[4], vn[4];
  { const int rg0 = blockIdx.x; if (rg0 < NTOK / 8) { const float* xr = XROW(rg0 * 8 + wid);
#pragma unroll
      for (int i = 0; i < 4; ++i) v[i] = *(const f32x4*)(xr + i * 256 + lane * 4); } }
  for (int rg = blockIdx.x; rg < NTOK / 8; rg += gridDim.x) {
    const int row = rg * 8 + wid; float* xr = X + (size_t)row * D;
    const int rgn = rg + gridDim.x;
    if (rgn < NTOK / 8) { const float* xn = XROW(rgn * 8 + wid);
#pragma unroll
      for (int i = 0; i < 4; ++i) vn[i] = *(const f32x4*)(xn + i * 256 + lane * 4); }
    float ss = 0.f;
#pragma unroll
    for (int i = 0; i < 4; ++i) ss += v[i][0] * v[i][0] + v[i][1] * v[i][1] + v[i][2] * v[i][2] + v[i][3] * v[i][3];
    ss = wave_sum(ss); const float rstd = rsqrtf(ss * (1.f / 1024.f) + EPS);
    if (which == 3) {
#pragma unroll
      for (int i = 0; i < 4; ++i) { const f32x4 g = *(const f32x4*)(p.g_final + i * 256 + lane * 4); *(f32x4*)(xr + i * 256 + lane * 4) = v[i] * rstd * g; }
    } else {
      const float* md = p.mods + ((size_t)l * 5 + cond_of(row)) * 9216 + which * 3 * 1024; const float* gn = p.g_norm + ((size_t)l * 3 + which) * D;
#pragma unroll
      for (int i = 0; i < 4; ++i) { const int c = i * 256 + lane * 4; const f32x4 g = *(const f32x4*)(gn + c), sh = *(const f32x4*)(md + c), sc = *(const f32x4*)(md + 1024 + c);
        v[i] = v[i] * rstd * g * (1.f + sc) + sh;
        *(bf16x4*)(p.u + (size_t)row * D + c) = pack4(v[i][0], v[i][1], v[i][2], v[i][3]); }
      if (gates) {
        __syncthreads();
#pragma unroll
        for (int i = 0; i < 4; ++i) { LAS float* s = ur + i * 256 + lane * 4; s[0] = v[i][0]; s[1] = v[i][1]; s[2] = v[i][2]; s[3] = v[i][3]; }
        __syncthreads();
        const int j = lane & 15, kp = lane >> 4; float a = 0.f;
#pragma unroll 8
        for (int kk = 0; kk < 256; ++kk) a += ur[kk * 4 + kp] * Wg[(kk * 4 + kp) * 16 + j];
        a += __shfl_xor(a, 16); a += __shfl_xor(a, 32);
        if (lane < 16) { a += p.b_mgate[l * 16 + j]; if ((j >> 2) & 1) a = fminf(a, 0.f) - log1pf(__expf(-fabsf(a))); p.gate[(size_t)row * 16 + j] = a; }
      }
    }
#pragma unroll
    for (int i = 0; i < 4; ++i) v[i] = vn[i];
  }
}

__device__ void attn_item(const Params& p, int l, int item, LAS unsigned char* lds) {
  const int tid = tid_opaque(), wid = tid >> 6, lane = tid & 63, fr = lane & 15, fq = lane >> 4;
  const bool lat = item < 128; int b, h, qb, seqbase, nkt;
  if (lat) { b = item >> 5; h = (item >> 3) & 3; qb = item & 7; seqbase = NCTX + b * 1024; nkt = 20; }
  else { const int i2 = item - 128; b = i2 >> 3; h = (i2 >> 1) & 3; qb = i2 & 1; seqbase = b * 256; nkt = 4; }
  LAS unsigned char* Ks = lds; LAS unsigned char* VT = lds + 64 * 272;
  const float2* rope = (const float2*)p.rope;
  const int qtok = qb * 128 + wid * 16 + fr;
  bf16x8 Qf[2][2];
  { const u16* qp = p.zA + (size_t)(seqbase + qtok) * ZLD + h * 128;
#pragma unroll
    for (int i = 0; i < 2; ++i)
#pragma unroll
      for (int kk = 0; kk < 2; ++kk) Qf[i][kk] = *(const bf16x8*)(qp + i * 64 + kk * 32 + fq * 8);
    if (lat) {
#pragma unroll
      for (int j = 0; j < 8; ++j) { const float2 cs = rope[qtok * 32 + fq * 8 + j];
#pragma unroll
        for (int i = 0; i < 2; ++i) { const float x1 = bf2f((u16)Qf[i][0][j]), x2 = bf2f((u16)Qf[i][1][j]);
          Qf[i][0][j] = (short)f2bf(x1 * cs.x - x2 * cs.y); Qf[i][1][j] = (short)f2bf(x1 * cs.y + x2 * cs.x); } }
    }
  }
  f32x4 O[2][8];
#pragma unroll
  for (int i = 0; i < 2; ++i)
#pragma unroll
    for (int d = 0; d < 8; ++d) O[i][d] = (f32x4){0.f, 0.f, 0.f, 0.f};
  float mrun[2] = {-1e30f, -1e30f}, lrun[2] = {0.f, 0.f};
  const float sc = 0.125f * 1.4426950408889634f;
  const int skey = tid >> 3, ssub = tid & 7, smap = ssub >> 2, spg = ssub & 3, sd1 = smap * 64 + spg * 8;
  f32x4 kraw[4], vraw[4]; float2 rcs[8];
#define ATT_ISSUE(kt_) do { const int kt__ = (kt_); const int gk = kt__ * 64 + skey, gkv = kt__ * 64 + lane; \
    if (lat && kt__ < 4) { const float* kp = p.cache_k + ((((size_t)(b * 2 + l) * 4 + h) * 256 + gk) * 128) + sd1; \
      kraw[0] = *(const f32x4*)kp; kraw[1] = *(const f32x4*)(kp + 4); kraw[2] = *(const f32x4*)(kp + 32); kraw[3] = *(const f32x4*)(kp + 36); \
      const float* vp = p.cache_v + ((((size_t)(b * 2 + l) * 4 + h) * 256 + gkv) * 128) + wid * 16; \
      vraw[0] = *(const f32x4*)vp; vraw[1] = *(const f32x4*)(vp + 4); vraw[2] = *(const f32x4*)(vp + 8); vraw[3] = *(const f32x4*)(vp + 12); \
    } else { const int tok = lat ? gk - 256 : gk, tokv = lat ? gkv - 256 : gkv; const u16* kp = p.zA + (size_t)(seqbase + tok) * ZLD + 512 + h * 128 + sd1; \
      kraw[0] = *(const f32x4*)kp; kraw[1] = *(const f32x4*)(kp + 32); \
      const u16* vp = p.zA + (size_t)(seqbase + tokv) * ZLD + 1024 + h * 128 + wid * 16; vraw[0] = *(const f32x4*)vp; vraw[1] = *(const f32x4*)(vp + 8); \
      if (lat) { _Pragma("unroll") for (int j = 0; j < 8; ++j) rcs[j] = rope[tok * 32 + spg * 8 + j]; } } } while (0)
  ATT_ISSUE(0);
  for (int kt = 0; kt < nkt; ++kt) {
    __syncthreads();
    { float x1[8], x2[8];
      if (lat && kt < 4) {
#pragma unroll
        for (int j = 0; j < 4; ++j) { x1[j] = kraw[0][j]; x1[j + 4] = kraw[1][j]; x2[j] = kraw[2][j]; x2[j + 4] = kraw[3][j]; }
      } else { const bf16x8 a = __builtin_bit_cast(bf16x8, kraw[0]), bb = __builtin_bit_cast(bf16x8, kraw[1]);
#pragma unroll
        for (int j = 0; j < 8; ++j) { x1[j] = bf2f((u16)a[j]); x2[j] = bf2f((u16)bb[j]); }
        if (lat) {
#pragma unroll
          for (int j = 0; j < 8; ++j) { const float2 cs = rcs[j]; const float o1 = x1[j] * cs.x - x2[j] * cs.y, o2 = x1[j] * cs.y + x2[j] * cs.x; x1[j] = o1; x2[j] = o2; }
        }
      }
      bf16x8 o1, o2;
      { u32x4 t1, t2;
#pragma unroll
        for (int j = 0; j < 4; ++j) { t1[j] = cvt_pk_bf16(x1[2 * j], x1[2 * j + 1]); t2[j] = cvt_pk_bf16(x2[2 * j], x2[2 * j + 1]); }
        o1 = __builtin_bit_cast(bf16x8, t1); o2 = __builtin_bit_cast(bf16x8, t2); }
      *(LAS bf16x8*)(Ks + skey * 272 + sd1 * 2) = o1; *(LAS bf16x8*)(Ks + skey * 272 + (sd1 + 32) * 2) = o2;
    }
    { const int key = lane, d0 = wid * 16; u16 xv[16];
      if (lat && kt < 4) {
#pragma unroll
        for (int q = 0; q < 4; ++q)
#pragma unroll
          for (int j = 0; j < 4; ++j) xv[q * 4 + j] = f2bf(vraw[q][j]);
      } else { const bf16x8 a = __builtin_bit_cast(bf16x8, vraw[0]), bb = __builtin_bit_cast(bf16x8, vraw[1]);
#pragma unroll
        for (int j = 0; j < 8; ++j) { xv[j] = (u16)a[j]; xv[j + 8] = (u16)bb[j]; } }
      const int pos = (key & 32) | (((key >> 2) & 3) << 3) | (((key >> 4) & 1) << 2) | (key & 3);
#pragma unroll
      for (int i = 0; i < 16; ++i) *(LAS u16*)(VT + (d0 + i) * 144 + pos * 2) = xv[i];
    }
    if (kt + 1 < nkt) ATT_ISSUE(kt + 1);
    __syncthreads();
    bf16x8 Pf[2][2];
#pragma unroll
    for (int i = 0; i < 2; ++i) {
      f32x4 S[4];
#pragma unroll
      for (int st = 0; st < 4; ++st) { S[st] = (f32x4){0.f, 0.f, 0.f, 0.f};
#pragma unroll
        for (int kk = 0; kk < 2; ++kk) { const bf16x8 Kf = *(const LAS bf16x8*)(Ks + (st * 16 + fr) * 272 + (i * 64 + kk * 32 + fq * 8) * 2);
          S[st] = __builtin_amdgcn_mfma_f32_16x16x32_bf16(Kf, Qf[i][kk], S[st], 0, 0, 0); } }
      float mx = -1e30f;
#pragma unroll
      for (int st = 0; st < 4; ++st)
#pragma unroll
        for (int j = 0; j < 4; ++j) mx = fmaxf(mx, S[st][j]);
      mx = fmaxf(mx, __shfl_xor(mx, 16)); mx = fmaxf(mx, __shfl_xor(mx, 32));
      const float mnew = fmaxf(mrun[i], mx), alpha = __builtin_amdgcn_exp2f((mrun[i] - mnew) * sc); mrun[i] = mnew;
      float ls = 0.f;
#pragma unroll
      for (int st = 0; st < 4; ++st)
#pragma unroll
        for (int j = 0; j < 4; ++j) { const float pv = __builtin_amdgcn_exp2f((S[st][j] - mnew) * sc); ls += pv; S[st][j] = pv; }
      lrun[i] = lrun[i] * alpha + ls;
#pragma unroll
      for (int d = 0; d < 8; ++d) O[i][d] *= alpha;
#pragma unroll
      for (int ks = 0; ks < 2; ++ks)
#pragma unroll
        for (int j = 0; j < 1; ++j) Pf[i][ks] = pack8(S[2 * ks], S[2 * ks + 1]);
    }
#pragma unroll
    for (int d = 0; d < 8; ++d)
#pragma unroll
      for (int ks = 0; ks < 2; ++ks) { const bf16x8 Vf = *(const LAS bf16x8*)(VT + (d * 16 + fr) * 144 + (ks * 32 + fq * 8) * 2);
        O[0][d] = __builtin_amdgcn_mfma_f32_16x16x32_bf16(Vf, Pf[0][ks], O[0][d], 0, 0, 0);
        O[1][d] = __builtin_amdgcn_mfma_f32_16x16x32_bf16(Vf, Pf[1][ks], O[1][d], 0, 0, 0); }
  }
#undef ATT_ISSUE
  float inv[2];
#pragma unroll
  for (int i = 0; i < 2; ++i) { float lt = lrun[i]; lt += __shfl_xor(lt, 16); lt += __shfl_xor(lt, 32); inv[i] = 1.f / lt; }
  const float lam = p.lam[l], li = lam_init_of(l); const float i0 = inv[0], i1 = inv[1] * lam;
  float ss = 0.f;
#pragma unroll
  for (int d = 0; d < 8; ++d)
#pragma unroll
    for (int j = 0; j < 4; ++j) { const float o = O[0][d][j] * i0 - O[1][d][j] * i1; O[0][d][j] = o; ss += o * o; }
  ss += __shfl_xor(ss, 16); ss += __shfl_xor(ss, 32);
  const float rstd = rsqrtf(ss * (1.f / 128.f) + EPS) * (1.f - li);
  u16* op = p.brin + (size_t)(seqbase + qtok) * 512 + h * 128 + fq * 4; const float* gs = p.g_attn_sub + l * 128 + fq * 4;
#pragma unroll
  for (int d = 0; d < 8; ++d) { const f32x4 g = *(const f32x4*)(gs + d * 16);
    *(bf16x4*)(op + d * 16) = pack4(O[0][d][0] * rstd * g[0], O[0][d][1] * rstd * g[1], O[0][d][2] * rstd * g[2], O[0][d][3] * rstd * g[3]); }
}

__device__ void mlstm_item(const Params& p, int l, int item, LAS unsigned char* lds) {
  const int tid = tid_opaque(), wid = tid >> 6, lane = tid & 63, fr = lane & 15, fq = lane >> 4;
  const bool lat = item < 32; int b, h, dir, seqbase, T;
  if (lat) { b = item >> 3; h = (item >> 1) & 3; dir = item & 1; seqbase = NCTX + b * 1024; T = 1024; }
  else { const int i2 = item - 32; b = i2 >> 3; h = (i2 >> 1) & 3; dir = i2 & 1; seqbase = b * 256; T = 256; }
  const int nch = T >> 6;
  LAS unsigned char* Qs = lds; LAS unsigned char* Ks = lds + 17408; LAS unsigned char* KTs = lds + 34816; LAS unsigned char* VTs = lds + 53248;
  LAS unsigned char* Cs = lds + 71680; LAS unsigned char* Ss = lds + 106496; LAS float* fl = (LAS float*)(lds + 115712);
  LAS float* a_s = fl; LAS float* g_s = fl + 64; LAS float* sp_s = fl + 128; LAS float* wl_s = fl + 192; LAS float* em_s = fl + 256; LAS float* nq_s = fl + 320;
  LAS float* denp = fl + 384; LAS float* nvec = fl + 512; LAS float* scal = fl + 640;
  const size_t sidx = ((size_t)(b * 2 + l) * 2 + dir) * 4 + h;
  f32x4 accC[8];
  __syncthreads();
  if (lat) { const float* cp = p.state_C + sidx * 16384 + (size_t)(wid * 16 + fr) * 128 + fq * 4;
#pragma unroll
    for (int kt = 0; kt < 8; ++kt) accC[kt] = *(const f32x4*)(cp + kt * 16);
    if (tid < 128) nvec[tid] = p.state_n[sidx * 128 + tid];
  } else {
#pragma unroll
    for (int kt = 0; kt < 8; ++kt) accC[kt] = (f32x4){0.f, 0.f, 0.f, 0.f};
    if (tid < 128) nvec[tid] = 0.f;
  }
#pragma unroll
  for (int kt = 0; kt < 8; ++kt) *(LAS bf16x4*)(Cs + (wid * 16 + fr) * 272 + (kt * 16 + fq * 4) * 2) = pack4(accC[kt][0], accC[kt][1], accC[kt][2], accC[kt][3]);
  float mst = lat ? p.state_m[sidx] : 0.f;
  f32x4 qraw[2], kraw[2], vraw[2]; float igr = 0.f, lfr = 0.f;
#define ML_ISSUE(ch_) do { const int ch__ = (ch_); { const int pos = tid >> 3, c16 = (tid & 7) * 16; const int gp_ = ch__ * 64 + pos, tok = dir ? T - 1 - gp_ : gp_; \
      const u16* zp = p.zA + (size_t)(seqbase + tok) * ZLD + h * 128 + c16; \
      qraw[0] = *(const f32x4*)(zp + 1536); qraw[1] = *(const f32x4*)(zp + 1536 + 8); kraw[0] = *(const f32x4*)(zp + 2048); kraw[1] = *(const f32x4*)(zp + 2048 + 8); } \
    { const int gp_ = ch__ * 64 + lane, tok = dir ? T - 1 - gp_ : gp_; const u16* vp = p.zA + (size_t)(seqbase + tok) * ZLD + 2560 + h * 128 + wid * 16; \
      vraw[0] = *(const f32x4*)vp; vraw[1] = *(const f32x4*)(vp + 8); \
      if (wid == 0) { const float* gp = p.gate + (size_t)(seqbase + tok) * 16 + dir * 8 + h; igr = gp[0]; lfr = gp[4]; } } } while (0)
  ML_ISSUE(0);
  for (int ch = 0; ch < nch; ++ch) {
    if (wid == 0) {
      const float ig = igr, lf = lfr; float bs = lf;
#pragma unroll
      for (int o = 1; o < 64; o <<= 1) { const float t = __shfl_up(bs, o); if (lane >= o) bs += t; }
      const float a = ig - bs; float gm = a;
#pragma unroll
      for (int o = 1; o < 64; o <<= 1) { const float t = __shfl_up(gm, o); if (lane >= o) gm = fmaxf(gm, t); }
      gm = fmaxf(gm, mst);
      const float g63 = __shfl(gm, 63), b63 = __shfl(bs, 63);
      a_s[lane] = a; g_s[lane] = gm; sp_s[lane] = __expf(mst - gm); wl_s[lane] = __expf(a - g63); em_s[lane] = __expf(-(bs + gm));
      if (lane == 0) { scal[0] = __expf(mst - g63); scal[1] = b63 + g63; } }
    { const int pos = tid >> 3, c16 = (tid & 7) * 16;
      *(LAS f32x4*)(Qs + pos * 272 + c16 * 2) = qraw[0]; *(LAS f32x4*)(Qs + pos * 272 + c16 * 2 + 16) = qraw[1];
      *(LAS f32x4*)(Ks + pos * 272 + c16 * 2) = kraw[0]; *(LAS f32x4*)(Ks + pos * 272 + c16 * 2 + 16) = kraw[1]; }
    { const bf16x8 v0 = __builtin_bit_cast(bf16x8, vraw[0]), v1 = __builtin_bit_cast(bf16x8, vraw[1]);
#pragma unroll
      for (int i = 0; i < 8; ++i) { *(LAS u16*)(VTs + (wid * 16 + i) * 144 + lane * 2) = (u16)v0[i]; *(LAS u16*)(VTs + (wid * 16 + 8 + i) * 144 + lane * 2) = (u16)v1[i]; } }
    if (ch + 1 < nch) ML_ISSUE(ch + 1);
    __syncthreads();
    { const float wl = wl_s[lane]; const bf16x8 k0 = *(const LAS bf16x8*)(Ks + lane * 272 + wid * 32), k1 = *(const LAS bf16x8*)(Ks + lane * 272 + wid * 32 + 16);
#pragma unroll
      for (int i = 0; i < 8; ++i) { *(LAS u16*)(KTs + (wid * 16 + i) * 144 + lane * 2) = f2bf(bf2f((u16)k0[i]) * wl); *(LAS u16*)(KTs + (wid * 16 + 8 + i) * 144 + lane * 2) = f2bf(bf2f((u16)k1[i]) * wl); } }
    { const int tt = wid & 3, spq = wid >> 2; const int t = tt * 16 + fr; const float gt = g_s[t]; float dsum = 0.f;
      bf16x8 Qf[4];
#pragma unroll
      for (int kk = 0; kk < 4; ++kk) Qf[kk] = *(const LAS bf16x8*)(Qs + t * 272 + (kk * 32 + fq * 8) * 2);
#pragma unroll
      for (int s2 = 0; s2 < 2; ++s2) { const int st = spq * 2 + s2; f32x4 acc = (f32x4){0.f, 0.f, 0.f, 0.f};
        if (st <= tt) {
#pragma unroll
          for (int kk = 0; kk < 4; ++kk) { const bf16x8 Kf = *(const LAS bf16x8*)(Ks + (st * 16 + fr) * 272 + (kk * 32 + fq * 8) * 2); acc = __builtin_amdgcn_mfma_f32_16x16x32_bf16(Kf, Qf[kk], acc, 0, 0, 0); }
        }
        float vv[4];
#pragma unroll
        for (int j = 0; j < 4; ++j) { const int s = st * 16 + fq * 4 + j; const float w = (s <= t) ? __expf(a_s[s] - gt) : 0.f; vv[j] = acc[j] * w; dsum += vv[j]; }
        *(LAS bf16x4*)(Ss + t * 144 + (st * 16 + fq * 4) * 2) = pack4(vv[0], vv[1], vv[2], vv[3]); }
      dsum += __shfl_xor(dsum, 16); dsum += __shfl_xor(dsum, 32);
      if (fq == 0) denp[spq * 64 + t] = dsum; }
    { const int t = tid >> 3, part = tid & 7; const bf16x8 q0 = *(const LAS bf16x8*)(Qs + t * 272 + part * 32), q1 = *(const LAS bf16x8*)(Qs + t * 272 + part * 32 + 16); float s = 0.f;
#pragma unroll
      for (int i = 0; i < 8; ++i) s += nvec[part * 16 + i] * bf2f((u16)q0[i]) + nvec[part * 16 + 8 + i] * bf2f((u16)q1[i]);
      s += __shfl_xor(s, 1); s += __shfl_xor(s, 2); s += __shfl_xor(s, 4);
      if (part == 0) nq_s[t] = s; }
    __syncthreads();
    const float decay = scal[0];
    { const int tt = wid & 3, vh = wid >> 2; const int t = tt * 16 + fr; const float spt = sp_s[t]; const float den = spt * nq_s[t] + denp[t] + denp[64 + t];
      const float rdn = 1.f / fmaxf(fabsf(den), em_s[t]);
      bf16x8 Qf[4], Sf[2];
#pragma unroll
      for (int kk = 0; kk < 4; ++kk) Qf[kk] = *(const LAS bf16x8*)(Qs + t * 272 + (kk * 32 + fq * 8) * 2);
#pragma unroll
      for (int ks = 0; ks < 2; ++ks) Sf[ks] = *(const LAS bf16x8*)(Ss + t * 144 + (ks * 32 + fq * 8) * 2);
      const int gp_ = ch * 64 + t, tok = dir ? T - 1 - gp_ : gp_; u16* hp = p.hdir + ((size_t)dir * NTOK + seqbase + tok) * 512 + h * 128 + fq * 4;
#pragma unroll
      for (int v4 = 0; v4 < 4; ++v4) { const int vt = vh * 4 + v4; f32x4 aS = (f32x4){0.f, 0.f, 0.f, 0.f}, aI = (f32x4){0.f, 0.f, 0.f, 0.f};
#pragma unroll
        for (int kk = 0; kk < 4; ++kk) { const bf16x8 Cf = *(const LAS bf16x8*)(Cs + (vt * 16 + fr) * 272 + (kk * 32 + fq * 8) * 2); aS = __builtin_amdgcn_mfma_f32_16x16x32_bf16(Cf, Qf[kk], aS, 0, 0, 0); }
#pragma unroll
        for (int ks = 0; ks < 2; ++ks) { const bf16x8 Vf = *(const LAS bf16x8*)(VTs + (vt * 16 + fr) * 144 + (ks * 32 + fq * 8) * 2); aI = __builtin_amdgcn_mfma_f32_16x16x32_bf16(Vf, Sf[ks], aI, 0, 0, 0); }
        *(bf16x4*)(hp + vt * 16) = pack4((spt * aS[0] + aI[0]) * rdn, (spt * aS[1] + aI[1]) * rdn, (spt * aS[2] + aI[2]) * rdn, (spt * aS[3] + aI[3]) * rdn); } }
    float nsum = 0.f;
    { bf16x8 Vf[2];
#pragma unroll
      for (int ks = 0; ks < 2; ++ks) Vf[ks] = *(const LAS bf16x8*)(VTs + (wid * 16 + fr) * 144 + (ks * 32 + fq * 8) * 2);
#pragma unroll
      for (int kt = 0; kt < 8; ++kt) { accC[kt] *= decay;
#pragma unroll
        for (int ks = 0; ks < 2; ++ks) { const bf16x8 Kf = *(const LAS bf16x8*)(KTs + (kt * 16 + fr) * 144 + (ks * 32 + fq * 8) * 2); accC[kt] = __builtin_amdgcn_mfma_f32_16x16x32_bf16(Kf, Vf[ks], accC[kt], 0, 0, 0); } }
      if (tid < 128) {
#pragma unroll
        for (int q = 0; q < 8; ++q) { const bf16x8 kv = *(const LAS bf16x8*)(KTs + tid * 144 + q * 16);
#pragma unroll
          for (int i = 0; i < 8; ++i) nsum += bf2f((u16)kv[i]); } } }
    mst = scal[1];
    __syncthreads();
#pragma unroll
    for (int kt = 0; kt < 8; ++kt) *(LAS bf16x4*)(Cs + (wid * 16 + fr) * 272 + (kt * 16 + fq * 4) * 2) = pack4(accC[kt][0], accC[kt][1], accC[kt][2], accC[kt][3]);
    if (tid < 128) nvec[tid] = decay * nvec[tid] + nsum;
  }
#undef ML_ISSUE
  if (!lat) {
    float* cpb = p.out + O_SC + sidx * 16384; const unsigned coff = (unsigned)((wid * 16 + fr) * 128 + fq * 4);
#pragma unroll
    for (int kt = 0; kt < 8; ++kt) *(f32x4*)(cpb + (coff + kt * 16)) = accC[kt];
    __syncthreads();
    if (tid < 128) p.out[O_SN + sidx * 128 + tid] = nvec[tid];
    if (tid == 0) p.out[O_SM + sidx] = mst;
  }
}

__device__ void mixers_phase(const Params& p, int ci, int l, LAS unsigned char* lds, int mask = 7) {
  __shared__ int s_item;
  const int tid = tid_opaque();
  for (;;) {
    __syncthreads();
    if (tid == 0) s_item = (int)atomicAdd(p.ctr + XB_CTR + ci, 1u);
    __syncthreads();
    const int item = s_item;
    if (item >= 768) break;
    const int ty = (item < 32 || (item >= 192 && item < 256)) ? 4 : ((item < 64 || (item >= 256 && item < 512)) ? 1 : 2);
    if (!(mask & ty)) continue;
    if (ty == 4) {
      OneSched S; int ld; float scale;
      if (item < 32) { const int b = item >> 3, mt = (item >> 1) & 3, nt = item & 1; ld = 2048; scale = 1.f / sqrtf(1024.f * 128.f);
        S.u.A = (const char*)(p.cs1024 + (size_t)mt * 256 * 2048); S.u.B = (const char*)(p.Yt + (size_t)32 * 512 * 512 + (size_t)b * 512 * 2048 + (size_t)nt * 256 * 2048);
        S.u.pm = NCTX + b * 1024 + mt * 256; S.u.pn = nt; S.u.aux = 0; }
      else { const int i2 = item - 192, b = i2 >> 1, nt = i2 & 1; ld = 512; scale = 1.f / sqrtf(256.f * 128.f);
        S.u.A = (const char*)p.cs256; S.u.B = (const char*)(p.Yt + (size_t)b * 512 * 512 + (size_t)nt * 256 * 512);
        S.u.pm = b * 256; S.u.pn = nt; S.u.aux = 0; }
      EpiFour E{p.brin + (size_t)NTOK * 512, scale};
      gemm_phase(lds, ld, ld, ld, S, E);
    } else if (ty == 1) mlstm_item(p, l, item < 64 ? item - 32 : 32 + (item - 256), lds);
    else attn_item(p, l, item < 192 ? item - 64 : 128 + (item - 512), lds);
  }
}

__device__ void mpost_phase(const Params& p, int l) {
  const int tid = tid_opaque(), wid = tid >> 6, lane = tid & 63;
  for (int row = blockIdx.x * 8 + wid; row < NTOK; row += gridDim.x * 8) {
    const bf16x8 hf = *(const bf16x8*)(p.hdir + (size_t)row * 512 + lane * 8), hb = *(const bf16x8*)(p.hdir + ((size_t)NTOK + row) * 512 + lane * 8);
    const bf16x8 mo = *(const bf16x8*)(p.zA + (size_t)row * ZLD + 3072 + lane * 8);
    float s[8], ss = 0.f;
#pragma unroll
    for (int i = 0; i < 8; ++i) { s[i] = bf2f((u16)hf[i]) + bf2f((u16)hb[i]); ss += s[i] * s[i]; }
    ss += __shfl_xor(ss, 1); ss += __shfl_xor(ss, 2); ss += __shfl_xor(ss, 4); ss += __shfl_xor(ss, 8);
    const float rstd = rsqrtf(ss * (1.f / 128.f) + EPS); const float* g = p.g_mlstm + l * 128 + (lane & 15) * 8; bf16x8 o;
#pragma unroll
    for (int i = 0; i < 8; ++i) o[i] = (short)f2bf(s[i] * rstd * g[i] * bf2f((u16)mo[i]));
    *(bf16x8*)(p.brin + ((size_t)2 * NTOK + row) * 512 + lane * 8) = o;
  }
}

__global__ void __launch_bounds__(512) fwd_megakernel(Params p_) {
  const Params& p = *(const Params*)(const __attribute__((address_space(4))) void*)__builtin_amdgcn_kernarg_segment_ptr();
  extern __shared__ __attribute__((aligned(16))) unsigned char shm_[];
  LAS unsigned char* lds = (LAS unsigned char*)shm_;
  cg::grid_group grid = cg::this_grid();
  const int G = gridDim.x, c = blockIdx.x;
  __shared__ uint4 xb_words; __shared__ int s_segdone[4];
  if (threadIdx.x == 0) xb_words = make_uint4(0u, 0u, 0u, 0u);
  if (threadIdx.x < 4) s_segdone[threadIdx.x] = 0;
  __syncthreads();
  const XcdBarrier xb = xcd_barrier_post(p.ctr, (volatile LAS unsigned*)&xb_words);
#define GSYNC() xcd_barrier(xb)
  if (p.out == nullptr) grid.sync();
  for (int ph = 0; ph < 25; ++ph) {
    const int l = ph == 0 ? 0 : (ph - 1) / 12, kind = ph == 0 ? -1 : (ph - 1) - l * 12;
    if (kind == 3 || kind == 9 || (kind == 0 && l == 1)) continue;
    const float* md = p.mods + (size_t)l * 5 * 9216;
    int hl = -1, hs = 0;
    if (kind == -1) { phase0(p, lds); hl = 0; hs = 0; }
    else if (kind == 0) norm_phase(p, 0, 0, lds);
    else if (kind == 1 || kind == 10) {
      TileSched S{p.u, kind == 1 ? p.wt_ffn1_in : p.wt_ffn2_in, D, D, 48, 22, G, c}; EpiSwiglu E{p.zA}; gemm_phase(lds, D, D, D, S, E);
      if (kind == 1) { hl = l; hs = 1; } else if (l == 0) { hl = 1; hs = 0; }
    } else if (kind == 2 || kind == 11 || kind == 8) {
      const bool isout = kind == 8; const int Kd = isout ? D : DFF;
      TileSched S{isout ? p.hdir : p.zA, isout ? p.wt_out : (kind == 2 ? p.wt_ffn1_out : p.wt_ffn2_out), Kd, Kd, 48, 4, G, c};
      EpiResidNorm E{p, l, kind};
      gemm_phase(lds, Kd, Kd, Kd, S, E);
      if (kind == 2) { hl = l; hs = 1; } else if (l == 0) { hl = 1; hs = 0; }
    } else if (kind == 4) { TileSched S{p.u, p.wt_big, D, D, 48, 31, G, c}; EpiBig E{p.zA, p.gb, p.Yt, p.out, l, p.gate, p.b_mgate}; gemm_phase(lds, D, D, D, S, E); }
    else if (kind == 5) mixers_phase(p, l, l, lds);
    else if (kind == 6) mpost_phase(p, l);
    else { BranchSched S{p.brin, p.wt_br, G, c}; EpiBranch E{(float*)p.zA, p.gb, p.hdir}; gemm_phase(lds, 512, 512, 512, S, E); if (l == 0) { hl = 1; hs = 0; } }
    if (hl >= 0) prep_seg(p, hl, hs, lds, (volatile LAS int*)s_segdone);
    GSYNC();
  }
}


extern "C" void kernel_launch(void* const* d_in, const int* in_sizes, int n_in, void* d_out, int out_size, void* d_ws, size_t ws_size, hipStream_t stream) {
  static int grid_blocks = 0;
  if (!grid_blocks) {
    int dev = 0, cus = 0, per_cu = 0;
    hipGetDevice(&dev);
    hipDeviceGetAttribute(&cus, hipDeviceAttributeMultiprocessorCount, dev);
    hipFuncSetAttribute((const void*)fwd_megakernel, hipFuncAttributeMaxDynamicSharedMemorySize, LDS_BYTES);
    hipOccupancyMaxActiveBlocksPerMultiprocessor(&per_cu, (const void*)fwd_megakernel, 512, LDS_BYTES);
    if (per_cu < 1) per_cu = 1;
    grid_blocks = cus * 1;
    (void)hipGetLastError();
  }
  Params p{};
  const float** ip = (const float**)&p;
  for (int i = 0; i < 27; ++i) ip[i] = (const float*)d_in[i];
  p.out = (float*)d_out;
  char* w = (char*)d_ws; size_t off = 0;
  auto take = [&](size_t bytes) { char* r = w + off; off += (bytes + 255) & ~(size_t)255; return r; };
  p.wt_ffn1_in = (u16*)take((size_t)2 * DFF * D * 2); p.wt_ffn1_out = (u16*)take((size_t)D * DFF * 2);
  p.wt_ffn2_in = (u16*)take((size_t)2 * DFF * D * 2); p.wt_ffn2_out = (u16*)take((size_t)D * DFF * 2);
  p.wt_big = (u16*)take((size_t)NBIG * D * 2); p.wt_br = (u16*)take((size_t)3 * D * 512 * 2); p.wt_out = (u16*)take((size_t)D * D * 2);
  p.u = (u16*)take((size_t)NTOK * D * 2);
  p.zA = (u16*)take((size_t)NTOK * ZLD * 2); p.gb = (u16*)take((size_t)NTOK * GBLD * 2);
  p.Yt = (u16*)take((size_t)NTOK * 1024 * 2); p.brin = (u16*)take((size_t)3 * NTOK * 512 * 2); p.hdir = (u16*)take((size_t)2 * NTOK * 512 * 2);
  p.cs1024 = (u16*)take((size_t)1024 * 2048 * 2); p.cs256 = (u16*)take((size_t)256 * 512 * 2);
  p.mods = (float*)take((size_t)2 * 5 * 9216 * 4); p.gate = (float*)take((size_t)NTOK * 16 * 4); p.rope = (float*)take((size_t)1024 * 32 * 2 * 4);
  p.lam = (float*)take(256); p.part = (float*)take((size_t)6 * 48 * 4 * 256 * 4); p.ctr = (unsigned*)take(BAR_TOTAL_WORDS * 4);
  if (off > ws_size) { fprintf(stderr, "kernel_launch: workspace too small: need %zu have %zu\n", off, ws_size); return; }
  if (hipMemsetAsync(p.ctr, 0, BAR_TOTAL_WORDS * 4, stream) != hipSuccess) { fprintf(stderr, "memset failed\n"); return; }
  void* args[] = {&p};
  hipError_t e = hipLaunchCooperativeKernel((const void*)fwd_megakernel, dim3(grid_blocks), dim3(512), args, LDS_BYTES, stream);
  if (e != hipSuccess) fprintf(stderr, "cooperative launch failed: %s (grid %d)\n", hipGetErrorString(e), grid_blocks);
}
```

```cpp
#include <hip/hip_runtime.h>
#include <hip/hip_cooperative_groups.h>
#include <cstdio>
namespace cg = cooperative_groups;

typedef unsigned short u16;
typedef short bf16x8 __attribute__((ext_vector_type(8)));
typedef short bf16x4 __attribute__((ext_vector_type(4)));
typedef float f32x4 __attribute__((ext_vector_type(4)));
#define LAS __attribute__((address_space(3)))

constexpr int D = 1024, NTOK = 12288, NCTX = 8192, DFF = 2816, PIN = 4112, NBIG = 7936, ZLD = 3584, GBLD = 3072;
constexpr int LDS_BYTES = 131072;
#ifndef PROBE
#define PROBE 0
#endif
constexpr float EPS = 1e-6f;
constexpr size_t O_Y = 0, O_CK = 12582912, O_CV = 20971520, O_SC = 29360128, O_SN = 37748736, O_SM = 37814272;

struct Params {
  const float *x_prompt, *x_sample, *cache_k, *cache_v, *state_C, *state_n, *state_m, *c, *c_ctx, *w_ada, *b_ada, *g_norm,
      *w_ffn1_in, *w_ffn1_out, *w_ffn2_in, *w_ffn2_out, *w_in, *b_mgate, *attn_lambda, *g_attn_sub, *g_mlstm, *w_branch_gate,
      *w_br_attn, *w_br_four, *w_br_mlstm, *w_out, *g_final;
  float* out;
  u16 *wt_ffn1_in, *wt_ffn1_out, *wt_ffn2_in, *wt_ffn2_out, *wt_big, *wt_br, *wt_out;
  u16 *u, *zA, *gb, *Yt, *brin, *hdir, *cs1024, *cs256;
  float *mods, *gate, *rope, *lam, *part;
  unsigned* ctr;
};

typedef float f32x2_ __attribute__((ext_vector_type(2)));
typedef __bf16 bf16v2_ __attribute__((ext_vector_type(2)));
__device__ __forceinline__ unsigned cvt_pk_bf16(float lo, float hi) { f32x2_ v = {lo, hi}; bf16v2_ r = __builtin_convertvector(v, bf16v2_); return __builtin_bit_cast(unsigned, r); }
__device__ __forceinline__ u16 f2bf(float f) { return (u16)cvt_pk_bf16(f, 0.f); }
typedef unsigned u32x4 __attribute__((ext_vector_type(4)));
typedef unsigned u32x2 __attribute__((ext_vector_type(2)));
__device__ __forceinline__ float bf2f(u16 h) { return __uint_as_float(((unsigned)h) << 16); }
__device__ __forceinline__ int tid_opaque() { int t = threadIdx.x; asm volatile("" : "+v"(t)); return t; }
__device__ __forceinline__ float sigmoidf_(float x) { return __builtin_amdgcn_rcpf(1.f + __builtin_amdgcn_exp2f(-1.4426950408889634f * x)); }
__device__ __forceinline__ int cond_of(int row) { return row < NCTX ? 0 : 1 + ((row - NCTX) >> 10); }
__device__ __forceinline__ float lam_init_of(int l) { return l == 0 ? 0.2f : (0.8f - 0.6f * 0.74081822068f); }


#define XB_TMO      128
#define XB_XCNT(j)  (256  + 64 * (j))
#define XB_XSUB(j)  (1280 + 64 * (j))
#define XB_XGEN(j)  (2304 + 64 * (j))
#define XB_TOP      3328
#define XB_TOPGEN   3392
#define XCD_BAR_WORDS 3456
#define XB_CTR      3520
#define XB_PCNT     3584
#define XB_MCNT     3904
#define BAR_TOTAL_WORDS 4352
#define XB_SPIN_CAP (1u << 18)
__device__ __forceinline__ unsigned xb_ld(unsigned* p)              { return __hip_atomic_load(p, __ATOMIC_RELAXED, __HIP_MEMORY_SCOPE_AGENT); }
__device__ __forceinline__ unsigned xb_add(unsigned* p, unsigned v) { return __hip_atomic_fetch_add(p, v, __ATOMIC_RELAXED, __HIP_MEMORY_SCOPE_AGENT); }
__device__ __forceinline__ unsigned xb_xcc_id() { return (unsigned)__builtin_amdgcn_s_getreg((3 << 11) | 20) & 0xFu; }
#define XB_SPIN(cond, bar) do { unsigned _sp = 0; while (cond) { __builtin_amdgcn_s_sleep(1); \
    if ((++_sp & 255u) == 0u) { if (xb_ld(&(bar)[XB_TMO])) break; if (_sp > XB_SPIN_CAP) { atomicAdd(&(bar)[XB_TMO], 1u); break; } } } } while (0)
struct XcdBarrier { unsigned* bar; unsigned x; volatile LAS unsigned* st; };
__device__ __forceinline__ XcdBarrier xcd_barrier_post(unsigned* bar, volatile LAS unsigned* st) {
  XcdBarrier b; b.bar = bar; b.x = xb_xcc_id(); b.st = st;
  if (threadIdx.x == 0) (void)xb_add(&bar[XB_XCNT(b.x)], 1u);
  return b;
}
__device__ __forceinline__ void xcd_barrier_complete(unsigned* bar, unsigned x, unsigned& nloc, unsigned& nx) {
  const unsigned G = gridDim.x * gridDim.y * gridDim.z;
  unsigned sum, cnt, mine, sp = 0u;
  for (;;) {
    sum = 0u; cnt = 0u; mine = 0u;
#pragma unroll
    for (unsigned j = 0; j < 16; ++j) { const unsigned c = xb_ld(&bar[XB_XCNT(j)]); sum += c; cnt += (c > 0u) ? 1u : 0u; mine = (j == x) ? c : mine; }
    if (sum == G) break;
    __builtin_amdgcn_s_sleep(1);
    if ((++sp & 255u) == 0u) { if (xb_ld(&bar[XB_TMO])) break; if (sp > XB_SPIN_CAP) { atomicAdd(&bar[XB_TMO], 1u); break; } }
  }
  nloc = mine > 0u ? mine : 1u; nx = cnt > 0u ? cnt : 1u;
}
__device__ __forceinline__ void xcd_barrier(const XcdBarrier& b) {
  asm volatile("s_waitcnt vmcnt(0)" ::: "memory");
  __syncthreads();
  if (threadIdx.x == 0) {
    unsigned* bar = b.bar;
    __builtin_amdgcn_s_waitcnt(0);
    unsigned nloc = b.st[0], nx = b.st[1];
    if (nloc == 0u) { xcd_barrier_complete(bar, b.x, nloc, nx); b.st[0] = nloc; b.st[1] = nx; }
    const unsigned old = xb_add(&bar[XB_XSUB(b.x)], 1u);
    const unsigned gen = old / nloc;
    if (old + 1u == (gen + 1u) * nloc) {
      __builtin_amdgcn_fence(__ATOMIC_RELEASE, "agent");
      asm volatile("s_waitcnt vmcnt(0)" ::: "memory");
      const unsigned og = xb_add(&bar[XB_TOP], 1u);
      const unsigned tg = og / nx;
      if (og + 1u == (tg + 1u) * nx) xb_add(&bar[XB_TOPGEN], 1u);
      else XB_SPIN(xb_ld(&bar[XB_TOPGEN]) == tg, bar);
      __builtin_amdgcn_fence(__ATOMIC_ACQUIRE, "agent");
      xb_add(&bar[XB_XGEN(b.x)], 1u);
      asm volatile("s_waitcnt vmcnt(0)" ::: "memory");
    } else {
      XB_SPIN(xb_ld(&bar[XB_XGEN(b.x)]) == gen, bar);
      __builtin_amdgcn_fence(__ATOMIC_ACQUIRE, "agent");
      asm volatile("s_waitcnt vmcnt(0)" ::: "memory");
    }
  }
  __syncthreads();
}

constexpr int BM = 256, BK = 64, HALF = 128, HTB = HALF * BK * 2;
__device__ __forceinline__ int lds_byte(int r, int c) { const int st = (r >> 4) * 2 + (c >> 5), rr = r & 15, cc = c & 31, ob = rr * 64 + cc * 2; return st * 1024 + (ob ^ (((ob >> 9) & 1) << 5)); }
__device__ __forceinline__ void stage_rc(int b, int& R, int& C) { const int st = b / 1024, sb = b % 1024, swz = sb ^ (((sb >> 9) & 1) << 5); R = (st >> 1) * 16 + swz / 64; C = (st & 1) * 32 + (swz % 64) / 2; }
__device__ __forceinline__ int perm32(int rho) { const int n = rho >> 4, i = rho & 15; return 8 * (i >> 2) + 4 * n + (i & 3); }

struct GUnit { const char* A; const char* B; int pm, pn, aux; };

__device__ __forceinline__ bool tile_order(int L, int nM, int nN, int& pm, int& pn) {
  const int nwg = nM * nN; if (L >= nwg) return false;
  int wgid = L; { const int q = nwg / 8, r = nwg % 8, xcd = wgid % 8, off = wgid / 8; wgid = (xcd < r ? xcd * (q + 1) : r * (q + 1) + (xcd - r) * q) + off; }
  const int nig = 8 * nN, gid = wgid / nig, fm = gid * 8, gsz = (nM - fm) < 8 ? (nM - fm) : 8;
  pm = fm + ((wgid % nig) % gsz); pn = (wgid % nig) / gsz; return true;
}

template <class Sched, class Epi>
__device__ __forceinline__ void gemm_phase(LAS unsigned char* lds, const int lda, const int ldb, const int K, const Sched& S, const Epi& E) {
  const int tid = tid_opaque(), wid = __builtin_amdgcn_readfirstlane(tid >> 6), lane = tid & 63, wr = wid >> 2, wc = wid & 3, fr = lane & 15, fq = lane >> 4;
  const int nt = K / BK;
  unsigned voffA[2], voffB[2];
#pragma unroll
  for (int i = 0; i < 2; ++i) { int R, C; stage_rc(tid * 16 + i * 8192, R, C); const int Rb = (R & ~31) + perm32(R & 31);
    voffA[i] = (unsigned)(R * lda + C) * 2u; voffB[i] = (unsigned)(Rb * ldb + C) * 2u; }
  const size_t kstep = (size_t)(BK * 2);
  const size_t hstepA = (size_t)HALF * lda * 2, hstepB = (size_t)HALF * ldb * 2;
  const unsigned ldsw = (unsigned)wid * 1024u;
  const int aoff = lds_byte(wr * 64 + fr, fq * 8), boff = lds_byte(wc * 32 + fr, fq * 8);
#define PG8_SA(b, h) (((b) * 2 + (h)) * HTB)
#define PG8_SB(b, h) ((4 + (b) * 2 + (h)) * HTB)
#define PG8_STAGE(bufoff, gbase, voff) do { _Pragma("unroll") for (int _i = 0; _i < 2; ++_i) \
    __builtin_amdgcn_global_load_lds((const unsigned*)((const char*)(gbase) + (voff)[_i]), (LAS unsigned*)(lds + (bufoff) + ldsw + _i * 8192), 16, 0, 0); } while (0)
#define PG8_LDA(dst, b, h) do { _Pragma("unroll") for (int m = 0; m < 4; ++m) _Pragma("unroll") for (int k = 0; k < 2; ++k) dst[m][k] = *(const LAS bf16x8*)(lds + PG8_SA(b, h) + aoff + m * 2048 + k * 1024); } while (0)
#define PG8_LDB(dst, b, h) do { _Pragma("unroll") for (int n = 0; n < 2; ++n) _Pragma("unroll") for (int k = 0; k < 2; ++k) dst[n][k] = *(const LAS bf16x8*)(lds + PG8_SB(b, h) + boff + n * 2048 + k * 1024); } while (0)
#define PG8_MMA(ai, bj, At, Bt) do { __builtin_amdgcn_s_setprio(1); _Pragma("unroll") for (int m = 0; m < 4; ++m) _Pragma("unroll") for (int n = 0; n < 2; ++n) _Pragma("unroll") for (int k = 0; k < 2; ++k) \
    acc[ai][bj][m][n] = __builtin_amdgcn_mfma_f32_16x16x32_bf16(Bt[n][k], At[m][k], acc[ai][bj][m][n], 0, 0, 0); __builtin_amdgcn_s_setprio(0); } while (0)
#define PG8_WAIT_V(n) asm volatile("s_waitcnt vmcnt(" #n ")" ::: "memory")
#define PG8_WAIT_L(n) asm volatile("s_waitcnt lgkmcnt(" #n ")" ::: "memory")
#define PG8_BAR __builtin_amdgcn_s_barrier()
#define PG8_SCHED __builtin_amdgcn_sched_barrier(0)
  GUnit cur, nxt; int ui = 0;
  if (!S.next(0, cur)) return;
  f32x4 acc[2][2][4][2];
#pragma unroll
  for (int a = 0; a < 2; ++a)
#pragma unroll
    for (int b = 0; b < 2; ++b)
#pragma unroll
      for (int m = 0; m < 4; ++m)
#pragma unroll
        for (int n = 0; n < 2; ++n) acc[a][b][m][n] = (f32x4){0.f, 0.f, 0.f, 0.f};
  bf16x8 At[4][2], B0[2][2], B1[2][2];
  const char* cA = cur.A; const char* cB = cur.B;
  PG8_STAGE(PG8_SB(0, 0), cB, voffB); PG8_STAGE(PG8_SA(0, 0), cA, voffA); PG8_STAGE(PG8_SB(0, 1), cB + hstepB, voffB); PG8_STAGE(PG8_SA(0, 1), cA + hstepA, voffA);
  if (wr == 1) PG8_BAR;
  PG8_WAIT_V(4); PG8_BAR;
  PG8_STAGE(PG8_SB(1, 0), cB + kstep, voffB); PG8_STAGE(PG8_SA(1, 0), cA + kstep, voffA); PG8_STAGE(PG8_SB(1, 1), cB + hstepB + kstep, voffB);
  PG8_WAIT_V(6); PG8_BAR;
  for (;;) {
    const bool has_next = S.next(ui + 1, nxt);
    const char* nA = has_next ? nxt.A : cA; const char* nB = has_next ? nxt.B : cB;
    for (int t = 0; t < nt; t += 2) {
      const bool last = (t == nt - 2);
      const char* a1 = cA + (size_t)(t + 1) * kstep;
      const char* a2 = last ? nA : cA + (size_t)(t + 2) * kstep; const char* b2 = last ? nB : cB + (size_t)(t + 2) * kstep;
      const char* a3 = a2 + kstep; const char* b3 = b2 + kstep;
      PG8_LDB(B0, 0, 0); PG8_SCHED; PG8_LDA(At, 0, 0); PG8_STAGE(PG8_SA(1, 1), a1 + hstepA, voffA);
      PG8_WAIT_L(8); PG8_BAR; PG8_WAIT_L(0); PG8_MMA(0, 0, At, B0); PG8_BAR; PG8_SCHED;
      PG8_LDB(B1, 0, 1); PG8_STAGE(PG8_SB(0, 0), b2, voffB);
      PG8_BAR; PG8_WAIT_L(0); PG8_MMA(0, 1, At, B1); PG8_BAR;
      PG8_LDA(At, 0, 1); PG8_STAGE(PG8_SA(0, 0), a2, voffA);
      PG8_BAR; PG8_WAIT_L(0); PG8_MMA(1, 0, At, B0); PG8_BAR; PG8_SCHED;
      PG8_STAGE(PG8_SB(0, 1), b2 + hstepB, voffB);
      PG8_WAIT_V(6); PG8_BAR; PG8_MMA(1, 1, At, B1); PG8_BAR;
      PG8_LDB(B0, 1, 0); PG8_SCHED; PG8_LDA(At, 1, 0); PG8_STAGE(PG8_SA(0, 1), a2 + hstepA, voffA);
      PG8_WAIT_L(8); PG8_BAR; PG8_WAIT_L(0); PG8_MMA(0, 0, At, B0); PG8_BAR; PG8_SCHED;
      PG8_LDB(B1, 1, 1); PG8_STAGE(PG8_SB(1, 0), b3, voffB);
      PG8_BAR; PG8_WAIT_L(0); PG8_MMA(0, 1, At, B1); PG8_BAR;
      PG8_LDA(At, 1, 1); PG8_STAGE(PG8_SA(1, 0), a3, voffA);
      PG8_BAR; PG8_WAIT_L(0); PG8_MMA(1, 0, At, B0); PG8_BAR; PG8_SCHED;
      PG8_STAGE(PG8_SB(1, 1), b3 + hstepB, voffB);
      PG8_WAIT_V(6); PG8_BAR; PG8_MMA(1, 1, At, B1); PG8_BAR;
    }
    if constexpr (!Epi::AFTER_DRAIN) E(acc, cur, wr, wc, fr, fq);
    if (!has_next) break;
#pragma unroll
    for (int a = 0; a < 2; ++a)
#pragma unroll
      for (int b = 0; b < 2; ++b)
#pragma unroll
        for (int m = 0; m < 4; ++m)
#pragma unroll
          for (int n = 0; n < 2; ++n) acc[a][b][m][n] = (f32x4){0.f, 0.f, 0.f, 0.f};
    cur = nxt; cA = nA; cB = nB; ++ui;
  }
  PG8_WAIT_V(0);
  if (wr == 0) PG8_BAR;
  PG8_BAR;
  if constexpr (Epi::AFTER_DRAIN) E.fused(acc, cur, wr, wc, fr, fq, lds);
#undef PG8_SA
#undef PG8_SB
#undef PG8_STAGE
#undef PG8_LDA
#undef PG8_LDB
#undef PG8_MMA
#undef PG8_WAIT_V
#undef PG8_WAIT_L
#undef PG8_BAR
#undef PG8_SCHED
}

struct TileSched {
  const u16* A; const u16* B; int lda, ldb, nM, nN, G, c;
  __device__ __forceinline__ bool next(int i, GUnit& u) const {
    int pm, pn; if (!tile_order(i * G + c, nM, nN, pm, pn)) return false;
    u.pm = pm; u.pn = pn; u.aux = 0; u.A = (const char*)(A + (size_t)pm * BM * lda); u.B = (const char*)(B + (size_t)pn * BM * ldb); return true;
  }
};
struct BranchSched {
  const u16* brin; const u16* wbr; int G, c;
  __device__ __forceinline__ bool next(int i, GUnit& u) const {
    int pm, pn; const int ti = i / 3, br = i - ti * 3; if (!tile_order(ti * G + c, 48, 4, pm, pn)) return false;
    u.pm = pm; u.pn = pn; u.aux = br; u.A = (const char*)(brin + (size_t)br * NTOK * 512 + (size_t)pm * BM * 512); u.B = (const char*)(wbr + (size_t)br * D * 512 + (size_t)pn * BM * 512); return true;
  }
};
struct OneSched { GUnit u; __device__ __forceinline__ bool next(int i, GUnit& o) const { if (i != 0) return false; o = u; return true; } };

__device__ __forceinline__ bf16x8 pack8(const f32x4& a, const f32x4& b) {
  u32x4 o; o[0] = cvt_pk_bf16(a[0], a[1]); o[1] = cvt_pk_bf16(a[2], a[3]); o[2] = cvt_pk_bf16(b[0], b[1]); o[3] = cvt_pk_bf16(b[2], b[3]); return __builtin_bit_cast(bf16x8, o);
}
__device__ __forceinline__ bf16x4 pack4(float a, float b, float c, float d) { u32x2 o; o[0] = cvt_pk_bf16(a, b); o[1] = cvt_pk_bf16(c, d); return __builtin_bit_cast(bf16x4, o); }

struct EpiSwiglu {
  static constexpr bool AFTER_DRAIN = false;
  u16* h;
  __device__ __forceinline__ void operator()(const f32x4 (&acc)[2][2][4][2], const GUnit& u, int wr, int wc, int fr, int fq) const {
    const int row0 = u.pm * BM + wr * 64 + fr, col0 = u.pn * 128 + wc * 32 + fq * 8;
#pragma unroll
    for (int ai = 0; ai < 2; ++ai)
#pragma unroll
      for (int m = 0; m < 4; ++m) {
        f32x4 r[2];
#pragma unroll
        for (int n = 0; n < 2; ++n)
#pragma unroll
          for (int j = 0; j < 4; ++j) { const float a = acc[ai][0][m][n][j], g = acc[ai][1][m][n][j]; r[n][j] = a * sigmoidf_(a) * g; }
        *(bf16x8*)(h + (size_t)(row0 + ai * HALF + m * 16) * DFF + col0) = pack8(r[0], r[1]);
      }
  }
};
struct EpiResidNorm {
  static constexpr bool AFTER_DRAIN = true;
  const Params& p; int l, kind;
  __device__ __forceinline__ void fused(f32x4 (&acc)[2][2][4][2], const GUnit& un, int wr, int wc, int fr, int fq, LAS unsigned char* lds) const {
    const bool isout = kind == 8, fin = (kind == 11 && l == 1), firstres = (l == 0 && kind == 2);
    const int use = l * 3 + (kind == 2 ? 0 : (isout ? 1 : 2)), nk = kind == 2 ? 1 : (isout ? 2 : 0), nl = kind == 11 ? l + 1 : l;
    float* x = p.out; const float* xc = firstres ? p.x_prompt : p.out; const float* xl = firstres ? p.x_sample : p.out + (size_t)NCTX * D;
    const float* gatev = p.mods + (size_t)l * 5 * 9216 + (isout ? 5 : (kind == 2 ? 2 : 8)) * 1024; const float coef = isout ? 1.0f : 0.5f;
    u16* u = p.u; const float* gn = fin ? p.g_final : p.g_norm + ((size_t)nl * 3 + nk) * D; const float* mdn = fin ? p.mods : p.mods + (size_t)nl * 5 * 9216 + nk * 3 * 1024;
    float* part = p.part + (size_t)use * 48 * 4 * 256; unsigned* cnt = p.ctr + XB_PCNT + use * 48;
    const int tid = tid_opaque();
    const int row0 = un.pm * BM + wr * 64 + fr, col0 = un.pn * BM + wc * 32 + fq * 8;
    const int cond = cond_of(un.pm * BM);
    const float* gp = gatev + cond * 9216 + col0;
    const float* xs = (un.pm < 32) ? xc : xl - (size_t)NCTX * D;
    LAS float* rp = (LAS float*)lds; LAS float* rs = rp + 1024;
    f32x4 g[2][2];
#pragma unroll
    for (int bj = 0; bj < 2; ++bj)
#pragma unroll
      for (int n = 0; n < 2; ++n) g[bj][n] = coef * *(const f32x4*)(gp + bj * HALF + n * 4);
#pragma unroll
    for (int ai = 0; ai < 2; ++ai)
#pragma unroll
      for (int m = 0; m < 4; ++m) {
        f32x4 xv[2][2];
#pragma unroll
        for (int bj = 0; bj < 2; ++bj)
#pragma unroll
          for (int n = 0; n < 2; ++n) xv[bj][n] = *(const f32x4*)(xs + (size_t)(row0 + ai * HALF + m * 16) * D + col0 + bj * HALF + n * 4);
        float s = 0.f;
#pragma unroll
        for (int bj = 0; bj < 2; ++bj)
#pragma unroll
          for (int n = 0; n < 2; ++n) { const f32x4 xn = xv[bj][n] + g[bj][n] * acc[ai][bj][m][n]; acc[ai][bj][m][n] = xn;
            s += xn[0] * xn[0] + xn[1] * xn[1] + xn[2] * xn[2] + xn[3] * xn[3];
            if (!fin) *(f32x4*)(x + (size_t)(row0 + ai * HALF + m * 16) * D + col0 + bj * HALF + n * 4) = xn; }
        s += __shfl_xor(s, 16); s += __shfl_xor(s, 32);
        if (fq == 0) rp[(ai * HALF + wr * 64 + m * 16 + fr) * 4 + wc] = s;
      }
    __syncthreads();
    float* slot = part + (size_t)(un.pm * 4) * 256;
    if (tid < 256) { const float t = (rp[tid * 4] + rp[tid * 4 + 1]) + (rp[tid * 4 + 2] + rp[tid * 4 + 3]);
      __hip_atomic_store(slot + un.pn * 256 + tid, t, __ATOMIC_RELAXED, __HIP_MEMORY_SCOPE_AGENT); }
    asm volatile("s_waitcnt vmcnt(0)" ::: "memory");
    __syncthreads();
    if (tid == 0) {
      __hip_atomic_fetch_add(cnt + un.pm, 1u, __ATOMIC_RELAXED, __HIP_MEMORY_SCOPE_AGENT);
      unsigned sp = 0;
      while (__hip_atomic_load(cnt + un.pm, __ATOMIC_RELAXED, __HIP_MEMORY_SCOPE_AGENT) < 4u) { __builtin_amdgcn_s_sleep(1); if (++sp > (1u << 22)) break; }
    }
    __syncthreads();
    if (tid < 256) { float t = 0.f;
#pragma unroll
      for (int q = 0; q < 4; ++q) t += __hip_atomic_load(slot + q * 256 + tid, __ATOMIC_RELAXED, __HIP_MEMORY_SCOPE_AGENT);
      rs[tid] = rsqrtf(t * (1.f / 1024.f) + EPS); }
    __syncthreads();
    const float* md = mdn + cond * 9216 + col0; const float* gnp = gn + col0;
    f32x4 gw[2][2], sh[2][2];
#pragma unroll
    for (int bj = 0; bj < 2; ++bj)
#pragma unroll
      for (int n = 0; n < 2; ++n) { gw[bj][n] = *(const f32x4*)(gnp + bj * HALF + n * 4);
        if (!fin) { gw[bj][n] *= (1.f + *(const f32x4*)(md + 1024 + bj * HALF + n * 4)); sh[bj][n] = *(const f32x4*)(md + bj * HALF + n * 4); } }
#pragma unroll
    for (int ai = 0; ai < 2; ++ai)
#pragma unroll
      for (int m = 0; m < 4; ++m) { const int rl = ai * HALF + wr * 64 + m * 16 + fr; const float rstd = rs[rl]; const unsigned eo = (unsigned)((un.pm * BM + rl) * D + col0);
#pragma unroll
        for (int bj = 0; bj < 2; ++bj) {
          if (fin) { *(f32x4*)(x + (eo + bj * HALF)) = acc[ai][bj][m][0] * rstd * gw[bj][0]; *(f32x4*)(x + (eo + bj * HALF + 4)) = acc[ai][bj][m][1] * rstd * gw[bj][1]; }
          else *(bf16x8*)(u + (eo + bj * HALF)) = pack8(acc[ai][bj][m][0] * rstd * gw[bj][0] + sh[bj][0], acc[ai][bj][m][1] * rstd * gw[bj][1] + sh[bj][1]); } }
  }
};
struct EpiBig {
  static constexpr bool AFTER_DRAIN = false;
  u16 *zA, *gb, *Yt; float* out; int l; float* gate; const float* bmg;
  __device__ __forceinline__ void operator()(const f32x4 (&acc)[2][2][4][2], const GUnit& u, int wr, int wc, int fr, int fq) const {
    const int row0 = u.pm * BM + wr * 64 + fr; const int pn = u.pn; const int colw = wc * 32 + fq * 8;
#pragma unroll
    for (int ai = 0; ai < 2; ++ai)
#pragma unroll
      for (int m = 0; m < 4; ++m) {
        const int row = row0 + ai * HALF + m * 16;
#pragma unroll
        for (int bj = 0; bj < 2; ++bj) {
          const int c = pn * BM + bj * HALF + colw;
          f32x4 v0 = acc[ai][bj][m][0], v1 = acc[ai][bj][m][1];
          if (pn < 6) {
            *(bf16x8*)(zA + (size_t)row * ZLD + c) = pack8(v0, v1);
            if (pn >= 2 && row < NCTX) {
              const int cc = (c - 512) & 511, hh = cc >> 7, d = cc & 127, b = row >> 8, t = row & 255;
              float* o = out + (pn < 4 ? O_CK : O_CV) + ((((size_t)(b * 2 + l) * 4 + hh) * 256 + t) * 128 + d);
              *(f32x4*)o = v0; *(f32x4*)(o + 4) = v1;
            }
          } else if (pn < 10) {
            const int cp = c - 1536, g = cp >> 8, j = cp & 255, cs = j >> 7, np = j & 127;
            u16* base;
            if (row < NCTX) { const int b = row >> 8, t = row & 255; base = Yt + (size_t)b * 512 * 512 + (size_t)(g * 128 + np) * 512 + cs * 256 + t;
#pragma unroll
              for (int q = 0; q < 4; ++q) { base[(size_t)q * 512] = f2bf(v0[q]); base[(size_t)(q + 4) * 512] = f2bf(v1[q]); }
            } else { const int rr = row - NCTX, b = rr >> 10, t = rr & 1023; base = Yt + (size_t)32 * 512 * 512 + (size_t)b * 512 * 2048 + (size_t)(g * 128 + np) * 2048 + cs * 1024 + t;
#pragma unroll
              for (int q = 0; q < 4; ++q) { base[(size_t)q * 2048] = f2bf(v0[q]); base[(size_t)(q + 4) * 2048] = f2bf(v1[q]); }
            }
          } else if (pn < 18) {
            if (pn == 12 || pn == 13) { v0 *= 0.08838834764831845f; v1 *= 0.08838834764831845f; }
            if (pn >= 16) {
#pragma unroll
              for (int q = 0; q < 4; ++q) { v0[q] = sigmoidf_(v0[q]); v1[q] = sigmoidf_(v1[q]); }
            }
            *(bf16x8*)(zA + (size_t)row * ZLD + (c - 1024)) = pack8(v0, v1);
          } else if (pn < 30) {
#pragma unroll
            for (int q = 0; q < 4; ++q) { v0[q] = sigmoidf_(v0[q]); v1[q] = sigmoidf_(v1[q]); }
            *(bf16x8*)(gb + (size_t)row * GBLD + (c - 4608)) = pack8(v0, v1);
          } else if (bj == 0 && wc == 0 && fq < 2) {
#pragma unroll
            for (int q = 0; q < 8; ++q) { const int j = fq * 8 + q; float a = (q < 4 ? v0[q] : v1[q - 4]) + bmg[l * 16 + j];
              if ((j >> 2) & 1) a = fminf(a, 0.f) - log1pf(__expf(-fabsf(a)));
              gate[(size_t)row * 16 + j] = a; }
          }
        }
      }
  }
};
struct EpiBranch {
  static constexpr bool AFTER_DRAIN = false;
  u16* tmp; const u16* gb; u16* merged;
  __device__ __forceinline__ void operator()(const f32x4 (&acc)[2][2][4][2], const GUnit& u, int wr, int wc, int fr, int fq) const {
    const int row0 = u.pm * BM + wr * 64 + fr, col0 = u.pn * BM + wc * 32 + fq * 8; const int br = u.aux;
    u16* dst = br < 2 ? tmp : merged;
#pragma unroll
    for (int ai = 0; ai < 2; ++ai)
#pragma unroll
      for (int mp = 0; mp < 2; ++mp) {
        bf16x8 g8[2][2], t8[2][2];
#pragma unroll
        for (int mm = 0; mm < 2; ++mm)
#pragma unroll
          for (int bj = 0; bj < 2; ++bj) { const int row = row0 + ai * HALF + (mp * 2 + mm) * 16, c = col0 + bj * HALF;
            g8[mm][bj] = *(const bf16x8*)(gb + (size_t)row * GBLD + br * D + c);
            if (br > 0) t8[mm][bj] = *(const bf16x8*)(tmp + (size_t)row * D + c); }
#pragma unroll
        for (int mm = 0; mm < 2; ++mm)
#pragma unroll
          for (int bj = 0; bj < 2; ++bj) { const int row = row0 + ai * HALF + (mp * 2 + mm) * 16, c = col0 + bj * HALF; const int m = mp * 2 + mm;
            f32x4 r0, r1;
#pragma unroll
            for (int q = 0; q < 4; ++q) { r0[q] = bf2f((u16)g8[mm][bj][q]) * acc[ai][bj][m][0][q]; r1[q] = bf2f((u16)g8[mm][bj][q + 4]) * acc[ai][bj][m][1][q]; }
            if (br > 0) {
#pragma unroll
              for (int q = 0; q < 4; ++q) { r0[q] += bf2f((u16)t8[mm][bj][q]); r1[q] += bf2f((u16)t8[mm][bj][q + 4]); } }
            *(bf16x8*)(dst + (size_t)row * D + c) = pack8(r0, r1); }
      }
  }
};
struct EpiFour {
  static constexpr bool AFTER_DRAIN = false;
  u16* fo; float scale;
  __device__ __forceinline__ void operator()(const f32x4 (&acc)[2][2][4][2], const GUnit& u, int wr, int wc, int fr, int fq) const {
    const int row0 = u.pm + wr * 64 + fr, col0 = u.pn * BM + wc * 32 + fq * 8;
#pragma unroll
    for (int ai = 0; ai < 2; ++ai)
#pragma unroll
      for (int m = 0; m < 4; ++m)
#pragma unroll
        for (int bj = 0; bj < 2; ++bj)
          *(bf16x8*)(fo + (size_t)(row0 + ai * HALF + m * 16) * 512 + col0 + bj * HALF) = pack8(acc[ai][bj][m][0] * scale, acc[ai][bj][m][1] * scale);
  }
};

struct TrJob { const float* src; u16* dst; int lds_, ldd, k0, ns0, nd0, mode; };
__device__ __forceinline__ void tr_decode(const Params& p, int l, int j, TrJob& t) {
  t.mode = 0;
  if (j < 352 || (j >= 528 && j < 880)) { const bool second = j >= 528; const int q = second ? j - 528 : j; const int kt = q / 22, nb = q % 22;
    t.src = (second ? p.w_ffn2_in : p.w_ffn1_in) + (size_t)l * D * 2 * DFF; t.dst = second ? p.wt_ffn2_in : p.wt_ffn1_in; t.lds_ = 2 * DFF; t.ldd = D; t.k0 = kt * 64; t.ns0 = nb * 256; t.nd0 = 0; t.mode = 1; }
  else if (j < 528 || (j >= 880 && j < 1056)) { const bool second = j >= 880; const int q = second ? j - 880 : j - 352; const int kt = q >> 2, nb = q & 3;
    t.src = (second ? p.w_ffn2_out : p.w_ffn1_out) + (size_t)l * DFF * D; t.dst = second ? p.wt_ffn2_out : p.wt_ffn1_out; t.lds_ = D; t.ldd = DFF; t.k0 = kt * 64; t.ns0 = nb * 256; t.nd0 = t.ns0; }
  else if (j < 1280) { const int q = j - 1056, kt = q / 14, nb = q % 14; t.src = p.w_in + (size_t)l * D * PIN; t.dst = p.wt_big; t.lds_ = PIN; t.ldd = D; t.k0 = kt * 64;
    if (nb < 6) { t.ns0 = nb * 256; t.nd0 = t.ns0; } else { t.ns0 = 2048 + (nb - 6) * 256; t.nd0 = t.ns0 + 512; } }
  else if (j < 1472) { const int q = j - 1280, kt = q / 12, nb = q % 12; t.src = p.w_branch_gate + (size_t)l * D * 3 * D; t.dst = p.wt_big; t.lds_ = 3 * D; t.ldd = D; t.k0 = kt * 64; t.ns0 = nb * 256; t.nd0 = 4608 + t.ns0; }
  else if (j < 1568) { const int q = j - 1472, br = q >> 5, jj = q & 31, kt = jj >> 2, nb = jj & 3;
    t.src = (br == 0 ? p.w_br_attn : br == 1 ? p.w_br_four : p.w_br_mlstm) + (size_t)l * 512 * D; t.dst = p.wt_br + (size_t)br * D * 512; t.lds_ = D; t.ldd = 512; t.k0 = kt * 64; t.ns0 = nb * 256; t.nd0 = t.ns0; }
  else { const int q = j - 1568, kt = q >> 2, nb = q & 3; t.src = p.w_out + (size_t)l * D * D; t.dst = p.wt_out; t.lds_ = D; t.ldd = D; t.k0 = kt * 64; t.ns0 = nb * 256; t.nd0 = t.ns0; }
}
__device__ __forceinline__ void tr_load(const TrJob& t, int tid, f32x4 (&r)[8]) {
#pragma unroll
  for (int i = 0; i < 8; ++i) { const int idx = tid + i * 512, kk = idx >> 6, c4 = idx & 63; r[i] = *(const f32x4*)(t.src + (size_t)(t.k0 + kk) * t.lds_ + t.ns0 + c4 * 4); }
}

__device__ void wf_job(const Params& p, int l, int job, LAS float* sm) {
  const int tid = tid_opaque();
  const int g = job >> 5, kb = (job >> 1) & 15, jh = job & 1; LAS float* W = sm; LAS float* ct = sm + 64 * 129;
  __syncthreads();
  for (int i = tid; i < 64 * 32; i += 512) { const int kk = i >> 5, c4 = i & 31;
    const float4 v = *(const float4*)(p.w_in + ((size_t)l * D + kb * 64 + kk) * PIN + 1536 + g * 128 + c4 * 4);
    LAS float* s = W + kk * 129 + c4 * 4; s[0] = v.x; s[1] = v.y; s[2] = v.z; s[3] = v.w; }
  if (tid < 128) ct[tid] = cospif((float)tid / 64.f);
  __syncthreads();
  const int kk = tid & 63, jg = tid >> 6; float a[16];
#pragma unroll
  for (int q = 0; q < 16; ++q) a[q] = 0.f;
  const int jbase = jh * 128 + jg * 16;
  for (int c = 0; c < 128; ++c) { const float w = W[kk * 129 + c];
#pragma unroll
    for (int q = 0; q < 16; ++q) { const int j = jbase + q; const int idx = jh ? ((c * (j - 128) - 32) & 127) : ((c * j) & 127); a[q] += w * ct[idx]; } }
#pragma unroll
  for (int q = 0; q < 16; ++q) p.wt_big[(size_t)(1536 + g * 256 + jbase + q) * D + kb * 64 + kk] = f2bf(a[q]);
}

__device__ void mods_job(const Params& p, int job, LAS float* sm) {
  const int tid = tid_opaque();
  const int l = job / 72, cb = job % 72; LAS float* sc = sm; LAS float* part = sm + 5 * 1024;
  __syncthreads();
  for (int i = tid; i < 5 * 1024; i += 512) { const int ci = i >> 10, k = i & 1023; const float v = ci == 0 ? p.c_ctx[k] : p.c[(ci - 1) * D + k]; sc[i] = v * sigmoidf_(v); }
  __syncthreads();
  const int cg4 = tid & 31, kp = tid >> 5; f32x4 a[5];
#pragma unroll
  for (int ci = 0; ci < 5; ++ci) a[ci] = (f32x4){0.f, 0.f, 0.f, 0.f};
  const float* wp = p.w_ada + ((size_t)l * D + kp * 64) * 9216 + cb * 128 + cg4 * 4;
#pragma unroll 8
  for (int k = 0; k < 64; ++k) { const f32x4 w = *(const f32x4*)(wp + (size_t)k * 9216);
#pragma unroll
    for (int ci = 0; ci < 5; ++ci) a[ci] += sc[ci * 1024 + kp * 64 + k] * w; }
#pragma unroll
  for (int ci = 0; ci < 5; ++ci)
#pragma unroll
    for (int q = 0; q < 4; ++q) part[(kp * 5 + ci) * 128 + cg4 * 4 + q] = a[ci][q];
  __syncthreads();
  for (int o = tid; o < 640; o += 512) { const int ci = o >> 7, cc = o & 127; float s = p.b_ada[(size_t)l * 9216 + cb * 128 + cc];
    for (int q = 0; q < 16; ++q) s += part[(q * 5 + ci) * 128 + cc];
    p.mods[((size_t)l * 5 + ci) * 9216 + cb * 128 + cc] = s; }
}

__device__ void prep_seg(const Params& p, int l, int seg, LAS unsigned char* lds, volatile LAS int* segdone) {
  if (segdone[l * 2 + seg]) return;
  const int tid = tid_opaque(); LAS float* sm = (LAS float*)lds; LAS int* s_job = (LAS int*)(lds + 131072 - 16);
  const int qi = 8 + l * 2 + seg;
  const int npre = seg ? 129 : (l == 0 ? 144 : 0), trofs = seg ? 528 : 0, ntr = seg ? 1104 : 528;
  const int trbase = npre, njobs = npre + ntr;
  int job;
  for (;;) {
    __syncthreads();
    if (tid == 0) *s_job = (int)atomicAdd(p.ctr + XB_CTR + qi, 1u);
    __syncthreads();
    job = *s_job;
    if (job >= njobs && tid == 0) segdone[l * 2 + seg] = 1;
    if (job >= trbase) break;
    if (seg && job == 128) { for (int i = tid; i < 16 * 1024; i += 512) { const int j = i >> 10, k = i & 1023; p.wt_big[(size_t)(7680 + j) * D + k] = f2bf(p.w_in[((size_t)l * D + k) * PIN + 4096 + j]); } }
    else if (seg) wf_job(p, l, job, sm); else mods_job(p, job, sm);
  }
  if (job >= njobs) return;
  f32x4 r[8]; TrJob t;
  tr_decode(p, l, job - trbase + trofs, t); tr_load(t, tid, r);
  for (;;) {
    __syncthreads();
#pragma unroll
    for (int i = 0; i < 8; ++i) { const int idx = tid + i * 512, kk = idx >> 6, c4 = idx & 63; LAS float* s = sm + kk * 257 + c4 * 4; s[0] = r[i][0]; s[1] = r[i][1]; s[2] = r[i][2]; s[3] = r[i][3]; }
    if (tid == 0) *s_job = (int)atomicAdd(p.ctr + XB_CTR + qi, 1u);
    __syncthreads();
    const int nextjob = *s_job; const TrJob cur = t;
    if (nextjob >= njobs && tid == 0) segdone[l * 2 + seg] = 1;
    if (nextjob < njobs) { tr_decode(p, l, nextjob - trbase + trofs, t); tr_load(t, tid, r); }
#pragma unroll
    for (int i = 0; i < 4; ++i) { const int unit = tid + i * 512, nn = unit >> 3, ch = unit & 7; bf16x8 o;
#pragma unroll
      for (int q = 0; q < 8; ++q) o[q] = (short)f2bf(sm[(ch * 8 + q) * 257 + nn]);
      int drow;
      if (cur.mode == 1) { const int col = cur.ns0 + nn, isg = col >= DFF, hid = col - isg * DFF; drow = (hid >> 7) * 256 + isg * 128 + (hid & 127); } else drow = cur.nd0 + nn;
      *(bf16x8*)(cur.dst + (size_t)drow * cur.ldd + cur.k0 + ch * 8) = o; }
    if (nextjob >= njobs) break;
  }
}

__device__ void phase0(const Params& p, LAS unsigned char* lds) {
  const int tid = tid_opaque(); const int G = gridDim.x;
  if (blockIdx.x == 0 && tid >= 64 && tid < 66) { const int l = tid - 64; const float* lp = p.attn_lambda + l * 256; float s1 = 0.f, s2 = 0.f;
    for (int i = 0; i < 64; ++i) { s1 += lp[i] * lp[64 + i]; s2 += lp[128 + i] * lp[192 + i]; }
    p.lam[l] = expf(s1) - expf(s2) + lam_init_of(l); }
  const int gtid = blockIdx.x * 512 + tid, gn = G * 512;
  for (int i = gtid; i < 1024 * 2048; i += gn) { const int tp = i >> 11, col = i & 2047, t = col & 1023, s = col >> 10; const int r = (t * tp) & 1023; const float x = (float)r / 512.f;
    p.cs1024[i] = f2bf(s ? -sinpif(x) : cospif(x)); }
  for (int i = gtid; i < 256 * 512; i += gn) { const int tp = i >> 9, col = i & 511, t = col & 255, s = col >> 8; const int r = (t * tp) & 255; const float x = (float)r / 128.f;
    p.cs256[i] = f2bf(s ? -sinpif(x) : cospif(x)); }
  for (int i = gtid; i < 1024 * 32; i += gn) { const int t = i >> 5, pp = i & 31; const float pos = pp < 16 ? (float)(t >> 6) : (float)(t & 63);
    const float inv = powf(10000.f, -(float)(pp & 15) / 16.f); float s, c; sincosf(pos * inv, &s, &c); p.rope[2 * i] = c; p.rope[2 * i + 1] = s; }
}

__device__ __forceinline__ float wave_sum(float v) {
#pragma unroll
  for (int o = 32; o >= 1; o >>= 1) v += __shfl_xor(v, o);
  return v;
}
__device__ void norm_phase(const Params& p, int l, int which, LAS unsigned char* lds) {
  const int tid = tid_opaque(), wid = tid >> 6, lane = tid & 63; const bool gates = which == 1;
  LAS float* Wg = (LAS float*)lds; LAS float* ur = Wg + 16384 + wid * 1024;
  if (gates) { __syncthreads();
    for (int i = tid; i < 4096; i += 512) { const int k = i >> 2, q = i & 3; const float4 v = *(const float4*)(p.w_in + ((size_t)l * D + k) * PIN + 4096 + q * 4);
      LAS float* s = Wg + k * 16 + q * 4; s[0] = v.x; s[1] = v.y; s[2] = v.z; s[3] = v.w; }
    __syncthreads(); }
  float* X = p.out; const bool first = (l == 0 && which == 0);
  const float* Xc = first ? p.x_prompt : X; const float* Xl = first ? p.x_sample : X + (size_t)NCTX * D;
#define XROW(r) ((r) < NCTX ? Xc + (size_t)(r) * D : Xl + (size_t)((r) - NCTX) * D)
  f32x4 v[4], vn[4];
  { const int rg0 = blockIdx.x; if (rg0 < NTOK / 8) { const float* xr = XROW(rg0 * 8 + wid);
#pragma unroll
      for (int i = 0; i < 4; ++i) v[i] = *(const f32x4*)(xr + i * 256 + lane * 4); } }
  for (int rg = blockIdx.x; rg < NTOK / 8; rg += gridDim.x) {
    const int row = rg * 8 + wid; float* xr = X + (size_t)row * D;
    const int rgn = rg + gridDim.x;
    if (rgn < NTOK / 8) { const float* xn = XROW(rgn * 8 + wid);
#pragma unroll
      for (int i = 0; i < 4; ++i) vn[i] = *(const f32x4*)(xn + i * 256 + lane * 4); }
    float ss = 0.f;
#pragma unroll
    for (int i = 0; i < 4; ++i) ss += v[i][0] * v[i][0] + v[i][1] * v[i][1] + v[i][2] * v[i][2] + v[i][3] * v[i][3];
    ss = wave_sum(ss); const float rstd = rsqrtf(ss * (1.f / 1024.f) + EPS);
    if (which == 3) {
#pragma unroll
      for (int i = 0; i < 4; ++i) { const f32x4 g = *(const f32x4*)(p.g_final + i * 256 + lane * 4); *(f32x4*)(xr + i * 256 + lane * 4) = v[i] * rstd * g; }
    } else {
      const float* md = p.mods + ((size_t)l * 5 + cond_of(row)) * 9216 + which * 3 * 1024; const float* gn = p.g_norm + ((size_t)l * 3 + which) * D;
#pragma unroll
      for (int i = 0; i < 4; ++i) { const int c = i * 256 + lane * 4; const f32x4 g = *(const f32x4*)(gn + c), sh = *(const f32x4*)(md + c), sc = *(const f32x4*)(md + 1024 + c);
        v[i] = v[i] * rstd * g * (1.f + sc) + sh;
        *(bf16x4*)(p.u + (size_t)row * D + c) = pack4(v[i][0], v[i][1], v[i][2], v[i][3]); }
      if (gates) {
        __syncthreads();
#pragma unroll
        for (int i = 0; i < 4; ++i) { LAS float* s = ur + i * 256 + lane * 4; s[0] = v[i][0]; s[1] = v[i][1]; s[2] = v[i][2]; s[3] = v[i][3]; }
        __syncthreads();
        const int j = lane & 15, kp = lane >> 4; float a = 0.f;
#pragma unroll 8
        for (int kk = 0; kk < 256; ++kk) a += ur[kk * 4 + kp] * Wg[(kk * 4 + kp) * 16 + j];
        a += __shfl_xor(a, 16); a += __shfl_xor(a, 32);
        if (lane < 16) { a += p.b_mgate[l * 16 + j]; if ((j >> 2) & 1) a = fminf(a, 0.f) - log1pf(__expf(-fabsf(a))); p.gate[(size_t)row * 16 + j] = a; }
      }
    }
#pragma unroll
    for (int i = 0; i < 4; ++i) v[i] = vn[i];
  }
}

__device__ void attn_item(const Params& p, int l, int item, LAS unsigned char* lds) {
  const int tid = tid_opaque(), wid = tid >> 6, lane = tid & 63, fr = lane & 15, fq = lane >> 4;
  const bool lat = item < 128; int b, h, qb, seqbase, nkt;
  if (lat) { b = item >> 5; h = (item >> 3) & 3; qb = item & 7; seqbase = NCTX + b * 1024; nkt = 20; }
  else { const int i2 = item - 128; b = i2 >> 3; h = (i2 >> 1) & 3; qb = i2 & 1; seqbase = b * 256; nkt = 4; }
  LAS unsigned char* Ks = lds; LAS unsigned char* VT = lds + 64 * 272;
  const float2* rope = (const float2*)p.rope;
  const int qtok = qb * 128 + wid * 16 + fr;
  bf16x8 Qf[2][2];
  { const u16* qp = p.zA + (size_t)(seqbase + qtok) * ZLD + h * 128;
#pragma unroll
    for (int i = 0; i < 2; ++i)
#pragma unroll
      for (int kk = 0; kk < 2; ++kk) Qf[i][kk] = *(const bf16x8*)(qp + i * 64 + kk * 32 + fq * 8);
    if (lat) {
#pragma unroll
      for (int j = 0; j < 8; ++j) { const float2 cs = rope[qtok * 32 + fq * 8 + j];
#pragma unroll
        for (int i = 0; i < 2; ++i) { const float x1 = bf2f((u16)Qf[i][0][j]), x2 = bf2f((u16)Qf[i][1][j]);
          Qf[i][0][j] = (short)f2bf(x1 * cs.x - x2 * cs.y); Qf[i][1][j] = (short)f2bf(x1 * cs.y + x2 * cs.x); } }
    }
  }
  f32x4 O[2][8];
#pragma unroll
  for (int i = 0; i < 2; ++i)
#pragma unroll
    for (int d = 0; d < 8; ++d) O[i][d] = (f32x4){0.f, 0.f, 0.f, 0.f};
  float mrun[2] = {-1e30f, -1e30f}, lrun[2] = {0.f, 0.f};
  const float sc = 0.125f * 1.4426950408889634f;
  const int skey = tid >> 3, ssub = tid & 7, smap = ssub >> 2, spg = ssub & 3, sd1 = smap * 64 + spg * 8;
  f32x4 kraw[4], vraw[4]; float2 rcs[8];
#define ATT_ISSUE(kt_) do { const int kt__ = (kt_); const int gk = kt__ * 64 + skey, gkv = kt__ * 64 + lane; \
    if (lat && kt__ < 4) { const float* kp = p.cache_k + ((((size_t)(b * 2 + l) * 4 + h) * 256 + gk) * 128) + sd1; \
      kraw[0] = *(const f32x4*)kp; kraw[1] = *(const f32x4*)(kp + 4); kraw[2] = *(const f32x4*)(kp + 32); kraw[3] = *(const f32x4*)(kp + 36); \
      const float* vp = p.cache_v + ((((size_t)(b * 2 + l) * 4 + h) * 256 + gkv) * 128) + wid * 16; \
      vraw[0] = *(const f32x4*)vp; vraw[1] = *(const f32x4*)(vp + 4); vraw[2] = *(const f32x4*)(vp + 8); vraw[3] = *(const f32x4*)(vp + 12); \
    } else { const int tok = lat ? gk - 256 : gk, tokv = lat ? gkv - 256 : gkv; const u16* kp = p.zA + (size_t)(seqbase + tok) * ZLD + 512 + h * 128 + sd1; \
      kraw[0] = *(const f32x4*)kp; kraw[1] = *(const f32x4*)(kp + 32); \
      const u16* vp = p.zA + (size_t)(seqbase + tokv) * ZLD + 1024 + h * 128 + wid * 16; vraw[0] = *(const f32x4*)vp; vraw[1] = *(const f32x4*)(vp + 8); \
      if (lat) { _Pragma("unroll") for (int j = 0; j < 8; ++j) rcs[j] = rope[tok * 32 + spg * 8 + j]; } } } while (0)
  ATT_ISSUE(0);
  for (int kt = 0; kt < nkt; ++kt) {
    __syncthreads();
    { float x1[8], x2[8];
      if (lat && kt < 4) {
#pragma unroll
        for (int j = 0; j < 4; ++j) { x1[j] = kraw[0][j]; x1[j + 4] = kraw[1][j]; x2[j] = kraw[2][j]; x2[j + 4] = kraw[3][j]; }
      } else { const bf16x8 a = __builtin_bit_cast(bf16x8, kraw[0]), bb = __builtin_bit_cast(bf16x8, kraw[1]);
#pragma unroll
        for (int j = 0; j < 8; ++j) { x1[j] = bf2f((u16)a[j]); x2[j] = bf2f((u16)bb[j]); }
        if (lat) {
#pragma unroll
          for (int j = 0; j < 8; ++j) { const float2 cs = rcs[j]; const float o1 = x1[j] * cs.x - x2[j] * cs.y, o2 = x1[j] * cs.y + x2[j] * cs.x; x1[j] = o1; x2[j] = o2; }
        }
      }
      bf16x8 o1, o2;
      { u32x4 t1, t2;
#pragma unroll
        for (int j = 0; j < 4; ++j) { t1[j] = cvt_pk_bf16(x1[2 * j], x1[2 * j + 1]); t2[j] = cvt_pk_bf16(x2[2 * j], x2[2 * j + 1]); }
        o1 = __builtin_bit_cast(bf16x8, t1); o2 = __builtin_bit_cast(bf16x8, t2); }
      *(LAS bf16x8*)(Ks + skey * 272 + sd1 * 2) = o1; *(LAS bf16x8*)(Ks + skey * 272 + (sd1 + 32) * 2) = o2;
    }
    { const int key = lane, d0 = wid * 16; u16 xv[16];
      if (lat && kt < 4) {
#pragma unroll
        for (int q = 0; q < 4; ++q)
#pragma unroll
          for (int j = 0; j < 4; ++j) xv[q * 4 + j] = f2bf(vraw[q][j]);
      } else { const bf16x8 a = __builtin_bit_cast(bf16x8, vraw[0]), bb = __builtin_bit_cast(bf16x8, vraw[1]);
#pragma unroll
        for (int j = 0; j < 8; ++j) { xv[j] = (u16)a[j]; xv[j + 8] = (u16)bb[j]; } }
      const int pos = (key & 32) | (((key >> 2) & 3) << 3) | (((key >> 4) & 1) << 2) | (key & 3);
#pragma unroll
      for (int i = 0; i < 16; ++i) *(LAS u16*)(VT + (d0 + i) * 144 + pos * 2) = xv[i];
    }
    if (kt + 1 < nkt) ATT_ISSUE(kt + 1);
    __syncthreads();
    bf16x8 Pf[2][2];
#pragma unroll
    for (int i = 0; i < 2; ++i) {
      f32x4 S[4];
#pragma unroll
      for (int st = 0; st < 4; ++st) { S[st] = (f32x4){0.f, 0.f, 0.f, 0.f};
#pragma unroll
        for (int kk = 0; kk < 2; ++kk) { const bf16x8 Kf = *(const LAS bf16x8*)(Ks + (st * 16 + fr) * 272 + (i * 64 + kk * 32 + fq * 8) * 2);
          S[st] = __builtin_amdgcn_mfma_f32_16x16x32_bf16(Kf, Qf[i][kk], S[st], 0, 0, 0); } }
      float mx = -1e30f;
#pragma unroll
      for (int st = 0; st < 4; ++st)
#pragma unroll
        for (int j = 0; j < 4; ++j) mx = fmaxf(mx, S[st][j]);
      mx = fmaxf(mx, __shfl_xor(mx, 16)); mx = fmaxf(mx, __shfl_xor(mx, 32));
      const float mnew = fmaxf(mrun[i], mx), alpha = __builtin_amdgcn_exp2f((mrun[i] - mnew) * sc); mrun[i] = mnew;
      float ls = 0.f;
#pragma unroll
      for (int st = 0; st < 4; ++st)
#pragma unroll
        for (int j = 0; j < 4; ++j) { const float pv = __builtin_amdgcn_exp2f((S[st][j] - mnew) * sc); ls += pv; S[st][j] = pv; }
      lrun[i] = lrun[i] * alpha + ls;
#pragma unroll
      for (int d = 0; d < 8; ++d) O[i][d] *= alpha;
#pragma unroll
      for (int ks = 0; ks < 2; ++ks)
#pragma unroll
        for (int j = 0; j < 1; ++j) Pf[i][ks] = pack8(S[2 * ks], S[2 * ks + 1]);
    }
#pragma unroll
    for (int d = 0; d < 8; ++d)
#pragma unroll
      for (int ks = 0; ks < 2; ++ks) { const bf16x8 Vf = *(const LAS bf16x8*)(VT + (d * 16 + fr) * 144 + (ks * 32 + fq * 8) * 2);
        O[0][d] = __builtin_amdgcn_mfma_f32_16x16x32_bf16(Vf, Pf[0][ks], O[0][d], 0, 0, 0);
        O[1][d] = __builtin_amdgcn_mfma_f32_16x16x32_bf16(Vf, Pf[1][ks], O[1][d], 0, 0, 0); }
  }
#undef ATT_ISSUE
  float inv[2];
#pragma unroll
  for (int i = 0; i < 2; ++i) { float lt = lrun[i]; lt += __shfl_xor(lt, 16); lt += __shfl_xor(lt, 32); inv[i] = 1.f / lt; }
  const float lam = p.lam[l], li = lam_init_of(l); const float i0 = inv[0], i1 = inv[1] * lam;
  float ss = 0.f;
#pragma unroll
  for (int d = 0; d < 8; ++d)
#pragma unroll
    for (int j = 0; j < 4; ++j) { const float o = O[0][d][j] * i0 - O[1][d][j] * i1; O[0][d][j] = o; ss += o * o; }
  ss += __shfl_xor(ss, 16); ss += __shfl_xor(ss, 32);
  const float rstd = rsqrtf(ss * (1.f / 128.f) + EPS) * (1.f - li);
  u16* op = p.brin + (size_t)(seqbase + qtok) * 512 + h * 128 + fq * 4; const float* gs = p.g_attn_sub + l * 128 + fq * 4;
#pragma unroll
  for (int d = 0; d < 8; ++d) { const f32x4 g = *(const f32x4*)(gs + d * 16);
    *(bf16x4*)(op + d * 16) = pack4(O[0][d][0] * rstd * g[0], O[0][d][1] * rstd * g[1], O[0][d][2] * rstd * g[2], O[0][d][3] * rstd * g[3]); }
}

__device__ void mlstm_item(const Params& p, int l, int item, LAS unsigned char* lds) {
  const int tid = tid_opaque(), wid = tid >> 6, lane = tid & 63, fr = lane & 15, fq = lane >> 4;
  const bool lat = item < 32; int b, h, dir, seqbase, T;
  if (lat) { b = item >> 3; h = (item >> 1) & 3; dir = item & 1; seqbase = NCTX + b * 1024; T = 1024; }
  else { const int i2 = item - 32; b = i2 >> 3; h = (i2 >> 1) & 3; dir = i2 & 1; seqbase = b * 256; T = 256; }
  const int nch = T >> 6;
  LAS unsigned char* Qs = lds; LAS unsigned char* Ks = lds + 17408; LAS unsigned char* KTs = lds + 34816; LAS unsigned char* VTs = lds + 53248;
  LAS unsigned char* Cs = lds + 71680; LAS unsigned char* Ss = lds + 106496; LAS float* fl = (LAS float*)(lds + 115712);
  LAS float* a_s = fl; LAS float* g_s = fl + 64; LAS float* sp_s = fl + 128; LAS float* wl_s = fl + 192; LAS float* em_s = fl + 256; LAS float* nq_s = fl + 320;
  LAS float* denp = fl + 384; LAS float* nvec = fl + 512; LAS float* scal = fl + 640;
  const size_t sidx = ((size_t)(b * 2 + l) * 2 + dir) * 4 + h;
  f32x4 accC[8];
  __syncthreads();
  if (lat) { const float* cp = p.state_C + sidx * 16384 + (size_t)(wid * 16 + fr) * 128 + fq * 4;
#pragma unroll
    for (int kt = 0; kt < 8; ++kt) accC[kt] = *(const f32x4*)(cp + kt * 16);
    if (tid < 128) nvec[tid] = p.state_n[sidx * 128 + tid];
  } else {
#pragma unroll
    for (int kt = 0; kt < 8; ++kt) accC[kt] = (f32x4){0.f, 0.f, 0.f, 0.f};
    if (tid < 128) nvec[tid] = 0.f;
  }
#pragma unroll
  for (int kt = 0; kt < 8; ++kt) *(LAS bf16x4*)(Cs + (wid * 16 + fr) * 272 + (kt * 16 + fq * 4) * 2) = pack4(accC[kt][0], accC[kt][1], accC[kt][2], accC[kt][3]);
  float mst = lat ? p.state_m[sidx] : 0.f;
  f32x4 qraw[2], kraw[2], vraw[2]; float igr = 0.f, lfr = 0.f;
#define ML_ISSUE(ch_) do { const int ch__ = (ch_); { const int pos = tid >> 3, c16 = (tid & 7) * 16; const int gp_ = ch__ * 64 + pos, tok = dir ? T - 1 - gp_ : gp_; \
      const u16* zp = p.zA + (size_t)(seqbase + tok) * ZLD + h * 128 + c16; \
      qraw[0] = *(const f32x4*)(zp + 1536); qraw[1] = *(const f32x4*)(zp + 1536 + 8); kraw[0] = *(const f32x4*)(zp + 2048); kraw[1] = *(const f32x4*)(zp + 2048 + 8); } \
    { const int gp_ = ch__ * 64 + lane, tok = dir ? T - 1 - gp_ : gp_; const u16* vp = p.zA + (size_t)(seqbase + tok) * ZLD + 2560 + h * 128 + wid * 16; \
      vraw[0] = *(const f32x4*)vp; vraw[1] = *(const f32x4*)(vp + 8); \
      if (wid == 0) { const float* gp = p.gate + (size_t)(seqbase + tok) * 16 + dir * 8 + h; igr = gp[0]; lfr = gp[4]; } } } while (0)
  ML_ISSUE(0);
  for (int ch = 0; ch < nch; ++ch) {
    if (wid == 0) {
      const float ig = igr, lf = lfr; float bs = lf;
#pragma unroll
      for (int o = 1; o < 64; o <<= 1) { const float t = __shfl_up(bs, o); if (lane >= o) bs += t; }
      const float a = ig - bs; float gm = a;
#pragma unroll
      for (int o = 1; o < 64; o <<= 1) { const float t = __shfl_up(gm, o); if (lane >= o) gm = fmaxf(gm, t); }
      gm = fmaxf(gm, mst);
      const float g63 = __shfl(gm, 63), b63 = __shfl(bs, 63);
      a_s[lane] = a; g_s[lane] = gm; sp_s[lane] = __expf(mst - gm); wl_s[lane] = __expf(a - g63); em_s[lane] = __expf(-(bs + gm));
      if (lane == 0) { scal[0] = __expf(mst - g63); scal[1] = b63 + g63; } }
    { const int pos = tid >> 3, c16 = (tid & 7) * 16;
      *(LAS f32x4*)(Qs + pos * 272 + c16 * 2) = qraw[0]; *(LAS f32x4*)(Qs + pos * 272 + c16 * 2 + 16) = qraw[1];
      *(LAS f32x4*)(Ks + pos * 272 + c16 * 2) = kraw[0]; *(LAS f32x4*)(Ks + pos * 272 + c16 * 2 + 16) = kraw[1]; }
    { const bf16x8 v0 = __builtin_bit_cast(bf16x8, vraw[0]), v1 = __builtin_bit_cast(bf16x8, vraw[1]);
#pragma unroll
      for (int i = 0; i < 8; ++i) { *(LAS u16*)(VTs + (wid * 16 + i) * 144 + lane * 2) = (u16)v0[i]; *(LAS u16*)(VTs + (wid * 16 + 8 + i) * 144 + lane * 2) = (u16)v1[i]; } }
    if (ch + 1 < nch) ML_ISSUE(ch + 1);
    __syncthreads();
    { const float wl = wl_s[lane]; const bf16x8 k0 = *(const LAS bf16x8*)(Ks + lane * 272 + wid * 32), k1 = *(const LAS bf16x8*)(Ks + lane * 272 + wid * 32 + 16);
#pragma unroll
      for (int i = 0; i < 8; ++i) { *(LAS u16*)(KTs + (wid * 16 + i) * 144 + lane * 2) = f2bf(bf2f((u16)k0[i]) * wl); *(LAS u16*)(KTs + (wid * 16 + 8 + i) * 144 + lane * 2) = f2bf(bf2f((u16)k1[i]) * wl); } }
    { const int tt = wid & 3, spq = wid >> 2; const int t = tt * 16 + fr; const float gt = g_s[t]; float dsum = 0.f;
      bf16x8 Qf[4];
#pragma unroll
      for (int kk = 0; kk < 4; ++kk) Qf[kk] = *(const LAS bf16x8*)(Qs + t * 272 + (kk * 32 + fq * 8) * 2);
#pragma unroll
      for (int s2 = 0; s2 < 2; ++s2) { const int st = spq * 2 + s2; f32x4 acc = (f32x4){0.f, 0.f, 0.f, 0.f};
        if (st <= tt) {
#pragma unroll
          for (int kk = 0; kk < 4; ++kk) { const bf16x8 Kf = *(const LAS bf16x8*)(Ks + (st * 16 + fr) * 272 + (kk * 32 + fq * 8) * 2); acc = __builtin_amdgcn_mfma_f32_16x16x32_bf16(Kf, Qf[kk], acc, 0, 0, 0); }
        }
        float vv[4];
#pragma unroll
        for (int j = 0; j < 4; ++j) { const int s = st * 16 + fq * 4 + j; const float w = (s <= t) ? __expf(a_s[s] - gt) : 0.f; vv[j] = acc[j] * w; dsum += vv[j]; }
        *(LAS bf16x4*)(Ss + t * 144 + (st * 16 + fq * 4) * 2) = pack4(vv[0], vv[1], vv[2], vv[3]); }
      dsum += __shfl_xor(dsum, 16); dsum += __shfl_xor(dsum, 32);
      if (fq == 0) denp[spq * 64 + t] = dsum; }
    { const int t = tid >> 3, part = tid & 7; const bf16x8 q0 = *(const LAS bf16x8*)(Qs + t * 272 + part * 32), q1 = *(const LAS bf16x8*)(Qs + t * 272 + part * 32 + 16); float s = 0.f;
#pragma unroll
      for (int i = 0; i < 8; ++i) s += nvec[part * 16 + i] * bf2f((u16)q0[i]) + nvec[part * 16 + 8 + i] * bf2f((u16)q1[i]);
      s += __shfl_xor(s, 1); s += __shfl_xor(s, 2); s += __shfl_xor(s, 4);
      if (part == 0) nq_s[t] = s; }
    __syncthreads();
    const float decay = scal[0];
    { const int tt = wid & 3, vh = wid >> 2; const int t = tt * 16 + fr; const float spt = sp_s[t]; const float den = spt * nq_s[t] + denp[t] + denp[64 + t];
      const float rdn = 1.f / fmaxf(fabsf(den), em_s[t]);
      bf16x8 Qf[4], Sf[2];
#pragma unroll
      for (int kk = 0; kk < 4; ++kk) Qf[kk] = *(const LAS bf16x8*)(Qs + t * 272 + (kk * 32 + fq * 8) * 2);
#pragma unroll
      for (int ks = 0; ks < 2; ++ks) Sf[ks] = *(const LAS bf16x8*)(Ss + t * 144 + (ks * 32 + fq * 8) * 2);
      const int gp_ = ch * 64 + t, tok = dir ? T - 1 - gp_ : gp_; u16* hp = p.hdir + ((size_t)dir * NTOK + seqbase + tok) * 512 + h * 128 + fq * 4;
#pragma unroll
      for (int v4 = 0; v4 < 4; ++v4) { const int vt = vh * 4 + v4; f32x4 aS = (f32x4){0.f, 0.f, 0.f, 0.f}, aI = (f32x4){0.f, 0.f, 0.f, 0.f};
#pragma unroll
        for (int kk = 0; kk < 4; ++kk) { const bf16x8 Cf = *(const LAS bf16x8*)(Cs + (vt * 16 + fr) * 272 + (kk * 32 + fq * 8) * 2); aS = __builtin_amdgcn_mfma_f32_16x16x32_bf16(Cf, Qf[kk], aS, 0, 0, 0); }
#pragma unroll
        for (int ks = 0; ks < 2; ++ks) { const bf16x8 Vf = *(const LAS bf16x8*)(VTs + (vt * 16 + fr) * 144 + (ks * 32 + fq * 8) * 2); aI = __builtin_amdgcn_mfma_f32_16x16x32_bf16(Vf, Sf[ks], aI, 0, 0, 0); }
        const bf16x4 hv = pack4((spt * aS[0] + aI[0]) * rdn, (spt * aS[1] + aI[1]) * rdn, (spt * aS[2] + aI[2]) * rdn, (spt * aS[3] + aI[3]) * rdn);
        __hip_atomic_store((unsigned long long*)(hp + vt * 16), __builtin_bit_cast(unsigned long long, hv), __ATOMIC_RELAXED, __HIP_MEMORY_SCOPE_AGENT); } }
    float nsum = 0.f;
    { bf16x8 Vf[2];
#pragma unroll
      for (int ks = 0; ks < 2; ++ks) Vf[ks] = *(const LAS bf16x8*)(VTs + (wid * 16 + fr) * 144 + (ks * 32 + fq * 8) * 2);
#pragma unroll
      for (int kt = 0; kt < 8; ++kt) { accC[kt] *= decay;
#pragma unroll
        for (int ks = 0; ks < 2; ++ks) { const bf16x8 Kf = *(const LAS bf16x8*)(KTs + (kt * 16 + fr) * 144 + (ks * 32 + fq * 8) * 2); accC[kt] = __builtin_amdgcn_mfma_f32_16x16x32_bf16(Kf, Vf[ks], accC[kt], 0, 0, 0); } }
      if (tid < 128) {
#pragma unroll
        for (int q = 0; q < 8; ++q) { const bf16x8 kv = *(const LAS bf16x8*)(KTs + tid * 144 + q * 16);
#pragma unroll
          for (int i = 0; i < 8; ++i) nsum += bf2f((u16)kv[i]); } } }
    mst = scal[1];
    __syncthreads();
#pragma unroll
    for (int kt = 0; kt < 8; ++kt) *(LAS bf16x4*)(Cs + (wid * 16 + fr) * 272 + (kt * 16 + fq * 4) * 2) = pack4(accC[kt][0], accC[kt][1], accC[kt][2], accC[kt][3]);
    if (tid < 128) nvec[tid] = decay * nvec[tid] + nsum;
  }
#undef ML_ISSUE
  if (!lat) {
    float* cpb = p.out + O_SC + sidx * 16384; const unsigned coff = (unsigned)((wid * 16 + fr) * 128 + fq * 4);
#pragma unroll
    for (int kt = 0; kt < 8; ++kt) *(f32x4*)(cpb + (coff + kt * 16)) = accC[kt];
    __syncthreads();
    if (tid < 128) p.out[O_SN + sidx * 128 + tid] = nvec[tid];
    if (tid == 0) p.out[O_SM + sidx] = mst;
  }
  asm volatile("s_waitcnt vmcnt(0)" ::: "memory");
  __syncthreads();
  LAS unsigned* flag = (LAS unsigned*)(fl + 644);
  if (tid == 0) *flag = __hip_atomic_fetch_add(p.ctr + XB_MCNT + l * 144 + (lat ? 32 + b : b) * 4 + h, 1u, __ATOMIC_RELAXED, __HIP_MEMORY_SCOPE_AGENT);
  __syncthreads();
  if (*flag == 1u) {
    const int rsub = tid >> 4, cq = tid & 15; const float* g = p.g_mlstm + l * 128 + cq * 8;
    for (int r0 = 0; r0 < T; r0 += 32) {
      const size_t row = (size_t)(seqbase + r0 + rsub); const int c = h * 128 + cq * 8;
      const unsigned long long* pf = (const unsigned long long*)(p.hdir + row * 512 + c); const unsigned long long* pb = (const unsigned long long*)(p.hdir + ((size_t)NTOK + row) * 512 + c);
      unsigned long long f0 = __hip_atomic_load(pf, __ATOMIC_RELAXED, __HIP_MEMORY_SCOPE_AGENT), f1 = __hip_atomic_load(pf + 1, __ATOMIC_RELAXED, __HIP_MEMORY_SCOPE_AGENT);
      unsigned long long b0 = __hip_atomic_load(pb, __ATOMIC_RELAXED, __HIP_MEMORY_SCOPE_AGENT), b1 = __hip_atomic_load(pb + 1, __ATOMIC_RELAXED, __HIP_MEMORY_SCOPE_AGENT);
      const bf16x8 mo = *(const bf16x8*)(p.zA + row * ZLD + 3072 + c);
      const bf16x4 hf0 = __builtin_bit_cast(bf16x4, f0), hf1 = __builtin_bit_cast(bf16x4, f1), hb0 = __builtin_bit_cast(bf16x4, b0), hb1 = __builtin_bit_cast(bf16x4, b1);
      float s[8], ss = 0.f;
#pragma unroll
      for (int i = 0; i < 4; ++i) { s[i] = bf2f((u16)hf0[i]) + bf2f((u16)hb0[i]); s[i + 4] = bf2f((u16)hf1[i]) + bf2f((u16)hb1[i]); }
#pragma unroll
      for (int i = 0; i < 8; ++i) ss += s[i] * s[i];
      ss += __shfl_xor(ss, 1); ss += __shfl_xor(ss, 2); ss += __shfl_xor(ss, 4); ss += __shfl_xor(ss, 8);
      const float rstd = rsqrtf(ss * (1.f / 128.f) + EPS);
      f32x4 o0, o1;
#pragma unroll
      for (int i = 0; i < 4; ++i) { o0[i] = s[i] * rstd * g[i] * bf2f((u16)mo[i]); o1[i] = s[i + 4] * rstd * g[i + 4] * bf2f((u16)mo[i + 4]); }
      *(bf16x8*)(p.brin + ((size_t)2 * NTOK + row) * 512 + c) = pack8(o0, o1);
    }
  }
}

__device__ void mixers_phase(const Params& p, int ci, int l, LAS unsigned char* lds, int mask = 7) {
  __shared__ int s_item;
  const int tid = tid_opaque();
  for (;;) {
    __syncthreads();
    if (tid == 0) s_item = (int)atomicAdd(p.ctr + XB_CTR + ci, 1u);
    __syncthreads();
    const int item = s_item;
    if (item >= 768) break;
    const int ty = (item < 32 || (item >= 192 && item < 256)) ? 4 : ((item < 64 || (item >= 256 && item < 512)) ? 1 : 2);
    if (!(mask & ty)) continue;
    if (ty == 4) {
      OneSched S; int ld; float scale;
      if (item < 32) { const int b = item >> 3, mt = (item >> 1) & 3, nt = item & 1; ld = 2048; scale = 1.f / sqrtf(1024.f * 128.f);
        S.u.A = (const char*)(p.cs1024 + (size_t)mt * 256 * 2048); S.u.B = (const char*)(p.Yt + (size_t)32 * 512 * 512 + (size_t)b * 512 * 2048 + (size_t)nt * 256 * 2048);
        S.u.pm = NCTX + b * 1024 + mt * 256; S.u.pn = nt; S.u.aux = 0; }
      else { const int i2 = item - 192, b = i2 >> 1, nt = i2 & 1; ld = 512; scale = 1.f / sqrtf(256.f * 128.f);
        S.u.A = (const char*)p.cs256; S.u.B = (const char*)(p.Yt + (size_t)b * 512 * 512 + (size_t)nt * 256 * 512);
        S.u.pm = b * 256; S.u.pn = nt; S.u.aux = 0; }
      EpiFour E{p.brin + (size_t)NTOK * 512, scale};
      gemm_phase(lds, ld, ld, ld, S, E);
    } else if (ty == 1) mlstm_item(p, l, item < 64 ? item - 32 : 32 + (item - 256), lds);
    else attn_item(p, l, item < 192 ? item - 64 : 128 + (item - 512), lds);
  }
}

__device__ void mpost_phase(const Params& p, int l) {
  const int tid = tid_opaque(), wid = tid >> 6, lane = tid & 63;
  for (int row = blockIdx.x * 8 + wid; row < NTOK; row += gridDim.x * 8) {
    const bf16x8 hf = *(const bf16x8*)(p.hdir + (size_t)row * 512 + lane * 8), hb = *(const bf16x8*)(p.hdir + ((size_t)NTOK + row) * 512 + lane * 8);
    const bf16x8 mo = *(const bf16x8*)(p.zA + (size_t)row * ZLD + 3072 + lane * 8);
    float s[8], ss = 0.f;
#pragma unroll
    for (int i = 0; i < 8; ++i) { s[i] = bf2f((u16)hf[i]) + bf2f((u16)hb[i]); ss += s[i] * s[i]; }
    ss += __shfl_xor(ss, 1); ss += __shfl_xor(ss, 2); ss += __shfl_xor(ss, 4); ss += __shfl_xor(ss, 8);
    const float rstd = rsqrtf(ss * (1.f / 128.f) + EPS); const float* g = p.g_mlstm + l * 128 + (lane & 15) * 8; bf16x8 o;
#pragma unroll
    for (int i = 0; i < 8; ++i) o[i] = (short)f2bf(s[i] * rstd * g[i] * bf2f((u16)mo[i]));
    *(bf16x8*)(p.brin + ((size_t)2 * NTOK + row) * 512 + lane * 8) = o;
  }
}

__global__ void __launch_bounds__(512) fwd_megakernel(Params p_) {
  const Params& p = *(const Params*)(const __attribute__((address_space(4))) void*)__builtin_amdgcn_kernarg_segment_ptr();
  extern __shared__ __attribute__((aligned(16))) unsigned char shm_[];
  LAS unsigned char* lds = (LAS unsigned char*)shm_;
  cg::grid_group grid = cg::this_grid();
  const int G = gridDim.x, c = blockIdx.x;
  __shared__ uint4 xb_words; __shared__ int s_segdone[4];
  if (threadIdx.x == 0) xb_words = make_uint4(0u, 0u, 0u, 0u);
  if (threadIdx.x < 4) s_segdone[threadIdx.x] = 0;
  __syncthreads();
  const XcdBarrier xb = xcd_barrier_post(p.ctr, (volatile LAS unsigned*)&xb_words);
#define GSYNC() xcd_barrier(xb)
  if (p.out == nullptr) grid.sync();
  for (int ph = 0; ph < 25; ++ph) {
    const int l = ph == 0 ? 0 : (ph - 1) / 12, kind = ph == 0 ? -1 : (ph - 1) - l * 12;
    if (kind == 3 || kind == 9 || kind == 6 || (kind == 0 && l == 1)) continue;
    const float* md = p.mods + (size_t)l * 5 * 9216;
    int hl = -1, hs = 0;
    if (kind == -1) { phase0(p, lds); hl = 0; hs = 0; }
    else if (kind == 0) norm_phase(p, 0, 0, lds);
    else if (kind == 1 || kind == 10) {
      TileSched S{p.u, kind == 1 ? p.wt_ffn1_in : p.wt_ffn2_in, D, D, 48, 22, G, c}; EpiSwiglu E{p.zA}; gemm_phase(lds, D, D, D, S, E);
      if (kind == 1) { hl = l; hs = 1; } else if (l == 0) { hl = 1; hs = 0; }
    } else if (kind == 2 || kind == 11 || kind == 8) {
      const bool isout = kind == 8; const int Kd = isout ? D : DFF;
      TileSched S{isout ? p.hdir : p.zA, isout ? p.wt_out : (kind == 2 ? p.wt_ffn1_out : p.wt_ffn2_out), Kd, Kd, 48, 4, G, c};
      EpiResidNorm E{p, l, kind};
      gemm_phase(lds, Kd, Kd, Kd, S, E);
      if (kind == 2) { hl = l; hs = 1; } else if (l == 0) { hl = 1; hs = 0; }
    } else if (kind == 4) { TileSched S{p.u, p.wt_big, D, D, 48, 31, G, c}; EpiBig E{p.zA, p.gb, p.Yt, p.out, l, p.gate, p.b_mgate}; gemm_phase(lds, D, D, D, S, E); }
    else if (kind == 5) mixers_phase(p, l, l, lds);
    else if (kind == 6) mpost_phase(p, l);
    else { BranchSched S{p.brin, p.wt_br, G, c}; EpiBranch E{p.zA, p.gb, p.hdir}; gemm_phase(lds, 512, 512, 512, S, E); if (l == 0) { hl = 1; hs = 0; } }
    if (hl >= 0) prep_seg(p, hl, hs, lds, (volatile LAS int*)s_segdone);
    GSYNC();
  }
}


extern "C" void kernel_launch(void* const* d_in, const int* in_sizes, int n_in, void* d_out, int out_size, void* d_ws, size_t ws_size, hipStream_t stream) {
  static int grid_blocks = 0;
  if (!grid_blocks) {
    int dev = 0, cus = 0, per_cu = 0;
    hipGetDevice(&dev);
    hipDeviceGetAttribute(&cus, hipDeviceAttributeMultiprocessorCount, dev);
    hipFuncSetAttribute((const void*)fwd_megakernel, hipFuncAttributeMaxDynamicSharedMemorySize, LDS_BYTES);
    hipOccupancyMaxActiveBlocksPerMultiprocessor(&per_cu, (const void*)fwd_megakernel, 512, LDS_BYTES);
    if (per_cu < 1) per_cu = 1;
    grid_blocks = cus * 1;
    (void)hipGetLastError();
  }
  Params p{};
  const float** ip = (const float**)&p;
  for (int i = 0; i < 27; ++i) ip[i] = (const float*)d_in[i];
  p.out = (float*)d_out;
  char* w = (char*)d_ws; size_t off = 0;
  auto take = [&](size_t bytes) { char* r = w + off; off += (bytes + 255) & ~(size_t)255; return r; };
  p.wt_ffn1_in = (u16*)take((size_t)2 * DFF * D * 2); p.wt_ffn1_out = (u16*)take((size_t)D * DFF * 2);
  p.wt_ffn2_in = (u16*)take((size_t)2 * DFF * D * 2); p.wt_ffn2_out = (u16*)take((size_t)D * DFF * 2);
  p.wt_big = (u16*)take((size_t)NBIG * D * 2); p.wt_br = (u16*)take((size_t)3 * D * 512 * 2); p.wt_out = (u16*)take((size_t)D * D * 2);
  p.u = (u16*)take((size_t)NTOK * D * 2);
  p.zA = (u16*)take((size_t)NTOK * ZLD * 2); p.gb = (u16*)take((size_t)NTOK * GBLD * 2);
  p.Yt = (u16*)take((size_t)NTOK * 1024 * 2); p.brin = (u16*)take((size_t)3 * NTOK * 512 * 2); p.hdir = (u16*)take((size_t)2 * NTOK * 512 * 2);
  p.cs1024 = (u16*)take((size_t)1024 * 2048 * 2); p.cs256 = (u16*)take((size_t)256 * 512 * 2);
  p.mods = (float*)take((size_t)2 * 5 * 9216 * 4); p.gate = (float*)take((size_t)NTOK * 16 * 4); p.rope = (float*)take((size_t)1024 * 32 * 2 * 4);
  p.lam = (float*)take(256); p.part = (float*)take((size_t)6 * 48 * 4 * 256 * 4); p.ctr = (unsigned*)take(BAR_TOTAL_WORDS * 4);
  if (off > ws_size) { fprintf(stderr, "kernel_launch: workspace too small: need %zu have %zu\n", off, ws_size); return; }
  if (hipMemsetAsync(p.ctr, 0, BAR_TOTAL_WORDS * 4, stream) != hipSuccess) { fprintf(stderr, "memset failed\n"); return; }
  void* args[] = {&p};
  hipError_t e = hipLaunchCooperativeKernel((const void*)fwd_megakernel, dim3(grid_blocks), dim3(512), args, LDS_BYTES, stream);
  if (e != hipSuccess) fprintf(stderr, "cooperative launch failed: %s (grid %d)\n", hipGetErrorString(e), grid_blocks);
}
```

```cpp
#include <hip/hip_runtime.h>
#include <hip/hip_cooperative_groups.h>
#include <cstdio>
namespace cg = cooperative_groups;

typedef unsigned short u16;
typedef short bf16x8 __attribute__((ext_vector_type(8)));
typedef short bf16x4 __attribute__((ext_vector_type(4)));
typedef float f32x4 __attribute__((ext_vector_type(4)));
#define LAS __attribute__((address_space(3)))

constexpr int D = 1024, NTOK = 12288, NCTX = 8192, DFF = 2816, PIN = 4112, NBIG = 7936, ZLD = 3584, GBLD = 3072;
constexpr int LDS_BYTES = 131072;
#ifndef PROBE
#define PROBE 0
#endif
constexpr float EPS = 1e-6f;
constexpr size_t O_Y = 0, O_CK = 12582912, O_CV = 20971520, O_SC = 29360128, O_SN = 37748736, O_SM = 37814272;

struct Params {
  const float *x_prompt, *x_sample, *cache_k, *cache_v, *state_C, *state_n, *state_m, *c, *c_ctx, *w_ada, *b_ada, *g_norm,
      *w_ffn1_in, *w_ffn1_out, *w_ffn2_in, *w_ffn2_out, *w_in, *b_mgate, *attn_lambda, *g_attn_sub, *g_mlstm, *w_branch_gate,
      *w_br_attn, *w_br_four, *w_br_mlstm, *w_out, *g_final;
  float* out;
  u16 *wt_ffn1_in, *wt_ffn1_out, *wt_ffn2_in, *wt_ffn2_out, *wt_big, *wt_br, *wt_out;
  u16 *u, *zA, *gb, *Yt, *brin, *hdir, *cs1024, *cs256;
  float *mods, *gate, *rope, *lam, *part;
  unsigned* ctr;
};

typedef float f32x2_ __attribute__((ext_vector_type(2)));
typedef __bf16 bf16v2_ __attribute__((ext_vector_type(2)));
__device__ __forceinline__ unsigned cvt_pk_bf16(float lo, float hi) { f32x2_ v = {lo, hi}; bf16v2_ r = __builtin_convertvector(v, bf16v2_); return __builtin_bit_cast(unsigned, r); }
__device__ __forceinline__ u16 f2bf(float f) { return (u16)cvt_pk_bf16(f, 0.f); }
typedef unsigned u32x4 __attribute__((ext_vector_type(4)));
typedef unsigned u32x2 __attribute__((ext_vector_type(2)));
__device__ __forceinline__ float bf2f(u16 h) { return __uint_as_float(((unsigned)h) << 16); }
__device__ __forceinline__ int tid_opaque() { int t = threadIdx.x; asm volatile("" : "+v"(t)); return t; }
__device__ __forceinline__ float sigmoidf_(float x) { return __builtin_amdgcn_rcpf(1.f + __builtin_amdgcn_exp2f(-1.4426950408889634f * x)); }
__device__ __forceinline__ int cond_of(int row) { return row < NCTX ? 0 : 1 + ((row - NCTX) >> 10); }
__device__ __forceinline__ float lam_init_of(int l) { return l == 0 ? 0.2f : (0.8f - 0.6f * 0.74081822068f); }


#define XB_TMO      128
#define XB_XCNT(j)  (256  + 64 * (j))
#define XB_XSUB(j)  (1280 + 64 * (j))
#define XB_XGEN(j)  (2304 + 64 * (j))
#define XB_TOP      3328
#define XB_TOPGEN   3392
#define XCD_BAR_WORDS 3456
#define XB_CTR      3520
#define XB_PCNT     3584
#define XB_MCNT     3968
#define BAR_TOTAL_WORDS 4352
#define XB_SPIN_CAP (1u << 18)
__device__ __forceinline__ unsigned xb_ld(unsigned* p)              { return __hip_atomic_load(p, __ATOMIC_RELAXED, __HIP_MEMORY_SCOPE_AGENT); }
__device__ __forceinline__ unsigned xb_add(unsigned* p, unsigned v) { return __hip_atomic_fetch_add(p, v, __ATOMIC_RELAXED, __HIP_MEMORY_SCOPE_AGENT); }
__device__ __forceinline__ unsigned xb_xcc_id() { return (unsigned)__builtin_amdgcn_s_getreg((3 << 11) | 20) & 0xFu; }
#define XB_SPIN(cond, bar) do { unsigned _sp = 0; while (cond) { __builtin_amdgcn_s_sleep(1); \
    if ((++_sp & 255u) == 0u) { if (xb_ld(&(bar)[XB_TMO])) break; if (_sp > XB_SPIN_CAP) { atomicAdd(&(bar)[XB_TMO], 1u); break; } } } } while (0)
struct XcdBarrier { unsigned* bar; unsigned x; volatile LAS unsigned* st; };
__device__ __forceinline__ XcdBarrier xcd_barrier_post(unsigned* bar, volatile LAS unsigned* st) {
  XcdBarrier b; b.bar = bar; b.x = xb_xcc_id(); b.st = st;
  if (threadIdx.x == 0) (void)xb_add(&bar[XB_XCNT(b.x)], 1u);
  return b;
}
__device__ __forceinline__ void xcd_barrier_complete(unsigned* bar, unsigned x, unsigned& nloc, unsigned& nx) {
  const unsigned G = gridDim.x * gridDim.y * gridDim.z;
  unsigned sum, cnt, mine, sp = 0u;
  for (;;) {
    sum = 0u; cnt = 0u; mine = 0u;
#pragma unroll
    for (unsigned j = 0; j < 16; ++j) { const unsigned c = xb_ld(&bar[XB_XCNT(j)]); sum += c; cnt += (c > 0u) ? 1u : 0u; mine = (j == x) ? c : mine; }
    if (sum == G) break;
    __builtin_amdgcn_s_sleep(1);
    if ((++sp & 255u) == 0u) { if (xb_ld(&bar[XB_TMO])) break; if (sp > XB_SPIN_CAP) { atomicAdd(&bar[XB_TMO], 1u); break; } }
  }
  nloc = mine > 0u ? mine : 1u; nx = cnt > 0u ? cnt : 1u;
}
__device__ __forceinline__ void xcd_barrier(const XcdBarrier& b) {
  asm volatile("s_waitcnt vmcnt(0)" ::: "memory");
  __syncthreads();
  if (threadIdx.x == 0) {
    unsigned* bar = b.bar;
    __builtin_amdgcn_s_waitcnt(0);
    unsigned nloc = b.st[0], nx = b.st[1];
    if (nloc == 0u) { xcd_barrier_complete(bar, b.x, nloc, nx); b.st[0] = nloc; b.st[1] = nx; }
    const unsigned old = xb_add(&bar[XB_XSUB(b.x)], 1u);
    const unsigned gen = old / nloc;
    if (old + 1u == (gen + 1u) * nloc) {
      __builtin_amdgcn_fence(__ATOMIC_RELEASE, "agent");
      asm volatile("s_waitcnt vmcnt(0)" ::: "memory");
      const unsigned og = xb_add(&bar[XB_TOP], 1u);
      const unsigned tg = og / nx;
      if (og + 1u == (tg + 1u) * nx) xb_add(&bar[XB_TOPGEN], 1u);
      else XB_SPIN(xb_ld(&bar[XB_TOPGEN]) == tg, bar);
      __builtin_amdgcn_fence(__ATOMIC_ACQUIRE, "agent");
      xb_add(&bar[XB_XGEN(b.x)], 1u);
      asm volatile("s_waitcnt vmcnt(0)" ::: "memory");
    } else {
      XB_SPIN(xb_ld(&bar[XB_XGEN(b.x)]) == gen, bar);
      __builtin_amdgcn_fence(__ATOMIC_ACQUIRE, "agent");
      asm volatile("s_waitcnt vmcnt(0)" ::: "memory");
    }
  }
  __syncthreads();
}

constexpr int BM = 256, BK = 64, HALF = 128, HTB = HALF * BK * 2;
__device__ __forceinline__ int lds_byte(int r, int c) { const int st = (r >> 4) * 2 + (c >> 5), rr = r & 15, cc = c & 31, ob = rr * 64 + cc * 2; return st * 1024 + (ob ^ (((ob >> 9) & 1) << 5)); }
__device__ __forceinline__ void stage_rc(int b, int& R, int& C) { const int st = b / 1024, sb = b % 1024, swz = sb ^ (((sb >> 9) & 1) << 5); R = (st >> 1) * 16 + swz / 64; C = (st & 1) * 32 + (swz % 64) / 2; }
__device__ __forceinline__ int perm32(int rho) { const int n = rho >> 4, i = rho & 15; return 8 * (i >> 2) + 4 * n + (i & 3); }

struct GUnit { const char* A; const char* B; int pm, pn, aux; };

__device__ __forceinline__ bool tile_order(int L, int nM, int nN, int& pm, int& pn) {
  const int nwg = nM * nN; if (L >= nwg) return false;
  int wgid = L; { const int q = nwg / 8, r = nwg % 8, xcd = wgid % 8, off = wgid / 8; wgid = (xcd < r ? xcd * (q + 1) : r * (q + 1) + (xcd - r) * q) + off; }
  const int nig = 8 * nN, gid = wgid / nig, fm = gid * 8, gsz = (nM - fm) < 8 ? (nM - fm) : 8;
  pm = fm + ((wgid % nig) % gsz); pn = (wgid % nig) / gsz; return true;
}

template <int MT, class Sched, class Epi>
__device__ __forceinline__ void gemm_phase(LAS unsigned char* lds, const int lda, const int ldb, const int K, const Sched& S, const Epi& E) {
  const int tid = tid_opaque(), wid = __builtin_amdgcn_readfirstlane(tid >> 6), lane = tid & 63, wr = wid >> 2, wc = wid & 3, fr = lane & 15, fq = lane >> 4;
  const int nt = K / BK;
  unsigned voffA[2], voffB[2];
#pragma unroll
  for (int i = 0; i < 2; ++i) { int R, C; stage_rc(tid * 16 + i * 8192, R, C); const int Rb = (R & ~31) + perm32(R & 31);
    voffA[i] = (unsigned)(R * lda + C) * 2u; voffB[i] = (unsigned)(Rb * ldb + C) * 2u; }
  const size_t kstep = (size_t)(BK * 2);
  const size_t hstepA = (size_t)(MT * 32) * lda * 2, hstepB = (size_t)HALF * ldb * 2;
  const unsigned ldsw = (unsigned)wid * 1024u;
  const int aoff = lds_byte(wr * (MT * 16) + fr, fq * 8), boff = lds_byte(wc * 32 + fr, fq * 8);
#define PG8_SA(b, h) (((b) * 2 + (h)) * HTB)
#define PG8_SB(b, h) ((4 + (b) * 2 + (h)) * HTB)
#define PG8_STAGE(bufoff, gbase, voff) do { _Pragma("unroll") for (int _i = 0; _i < 2; ++_i) \
    __builtin_amdgcn_global_load_lds((const unsigned*)((const char*)(gbase) + (voff)[_i]), (LAS unsigned*)(lds + (bufoff) + ldsw + _i * 8192), 16, 0, 0); } while (0)
#define PG8_STAGEA(bufoff, gbase, voff) do { _Pragma("unroll") for (int _i = 0; _i < 2; ++_i) if (MT == 4 || _i == 0 || wid < 4) \
    __builtin_amdgcn_global_load_lds((const unsigned*)((const char*)(gbase) + (voff)[_i]), (LAS unsigned*)(lds + (bufoff) + ldsw + _i * 8192), 16, 0, 0); } while (0)
#define PG8_LDA(dst, b, h) do { _Pragma("unroll") for (int m = 0; m < MT; ++m) _Pragma("unroll") for (int k = 0; k < 2; ++k) dst[m][k] = *(const LAS bf16x8*)(lds + PG8_SA(b, h) + aoff + m * 2048 + k * 1024); } while (0)
#define PG8_LDB(dst, b, h) do { _Pragma("unroll") for (int n = 0; n < 2; ++n) _Pragma("unroll") for (int k = 0; k < 2; ++k) dst[n][k] = *(const LAS bf16x8*)(lds + PG8_SB(b, h) + boff + n * 2048 + k * 1024); } while (0)
#define PG8_MMA(ai, bj, At, Bt) do { __builtin_amdgcn_s_setprio(1); _Pragma("unroll") for (int m = 0; m < MT; ++m) _Pragma("unroll") for (int n = 0; n < 2; ++n) _Pragma("unroll") for (int k = 0; k < 2; ++k) \
    acc[ai][bj][m][n] = __builtin_amdgcn_mfma_f32_16x16x32_bf16(Bt[n][k], At[m][k], acc[ai][bj][m][n], 0, 0, 0); __builtin_amdgcn_s_setprio(0); } while (0)
#define PG8_WAIT_V(n) asm volatile("s_waitcnt vmcnt(" #n ")" ::: "memory")
#define PG8_WAIT_L(n) asm volatile("s_waitcnt lgkmcnt(" #n ")" ::: "memory")
#define PG8_WAIT_VA do { if constexpr (MT == 4) asm volatile("s_waitcnt vmcnt(4)" ::: "memory"); else asm volatile("s_waitcnt vmcnt(3)" ::: "memory"); } while (0)
#define PG8_WAIT_VB do { if constexpr (MT == 4) asm volatile("s_waitcnt vmcnt(6)" ::: "memory"); else asm volatile("s_waitcnt vmcnt(5)" ::: "memory"); } while (0)
#define PG8_WAIT_LB do { if constexpr (MT == 4) asm volatile("s_waitcnt lgkmcnt(8)" ::: "memory"); else asm volatile("s_waitcnt lgkmcnt(6)" ::: "memory"); } while (0)
#define PG8_BAR __builtin_amdgcn_s_barrier()
#define PG8_SCHED __builtin_amdgcn_sched_barrier(0)
  GUnit cur, nxt; int ui = 0;
  if (!S.next(0, cur)) return;
  f32x4 acc[2][2][MT][2];
#pragma unroll
  for (int a = 0; a < 2; ++a)
#pragma unroll
    for (int b = 0; b < 2; ++b)
#pragma unroll
      for (int m = 0; m < MT; ++m)
#pragma unroll
        for (int n = 0; n < 2; ++n) acc[a][b][m][n] = (f32x4){0.f, 0.f, 0.f, 0.f};
  bf16x8 At[MT][2], B0[2][2], B1[2][2];
  const char* cA = cur.A; const char* cB = cur.B;
  PG8_STAGE(PG8_SB(0, 0), cB, voffB); PG8_STAGEA(PG8_SA(0, 0), cA, voffA); PG8_STAGE(PG8_SB(0, 1), cB + hstepB, voffB); PG8_STAGEA(PG8_SA(0, 1), cA + hstepA, voffA);
  if (wr == 1) PG8_BAR;
  PG8_WAIT_VA; PG8_BAR;
  PG8_STAGE(PG8_SB(1, 0), cB + kstep, voffB); PG8_STAGEA(PG8_SA(1, 0), cA + kstep, voffA); PG8_STAGE(PG8_SB(1, 1), cB + hstepB + kstep, voffB);
  PG8_WAIT_VB; PG8_BAR;
  for (;;) {
    const bool has_next = S.next(ui + 1, nxt);
    const char* nA = has_next ? nxt.A : cA; const char* nB = has_next ? nxt.B : cB;
    for (int t = 0; t < nt; t += 2) {
      const bool last = (t == nt - 2);
      const char* a1 = cA + (size_t)(t + 1) * kstep;
      const char* a2 = last ? nA : cA + (size_t)(t + 2) * kstep; const char* b2 = last ? nB : cB + (size_t)(t + 2) * kstep;
      const char* a3 = a2 + kstep; const char* b3 = b2 + kstep;
      PG8_LDB(B0, 0, 0); PG8_SCHED; PG8_LDA(At, 0, 0); PG8_STAGEA(PG8_SA(1, 1), a1 + hstepA, voffA);
      PG8_WAIT_LB; PG8_BAR; PG8_WAIT_L(0); PG8_MMA(0, 0, At, B0); PG8_BAR; PG8_SCHED;
      PG8_LDB(B1, 0, 1); PG8_STAGE(PG8_SB(0, 0), b2, voffB);
      PG8_BAR; PG8_WAIT_L(0); PG8_MMA(0, 1, At, B1); PG8_BAR;
      PG8_LDA(At, 0, 1); PG8_STAGEA(PG8_SA(0, 0), a2, voffA);
      PG8_BAR; PG8_WAIT_L(0); PG8_MMA(1, 0, At, B0); PG8_BAR; PG8_SCHED;
      PG8_STAGE(PG8_SB(0, 1), b2 + hstepB, voffB);
      PG8_WAIT_VB; PG8_BAR; PG8_MMA(1, 1, At, B1); PG8_BAR;
      PG8_LDB(B0, 1, 0); PG8_SCHED; PG8_LDA(At, 1, 0); PG8_STAGEA(PG8_SA(0, 1), a2 + hstepA, voffA);
      PG8_WAIT_LB; PG8_BAR; PG8_WAIT_L(0); PG8_MMA(0, 0, At, B0); PG8_BAR; PG8_SCHED;
      PG8_LDB(B1, 1, 1); PG8_STAGE(PG8_SB(1, 0), b3, voffB);
      PG8_BAR; PG8_WAIT_L(0); PG8_MMA(0, 1, At, B1); PG8_BAR;
      PG8_LDA(At, 1, 1); PG8_STAGEA(PG8_SA(1, 0), a3, voffA);
      PG8_BAR; PG8_WAIT_L(0); PG8_MMA(1, 0, At, B0); PG8_BAR; PG8_SCHED;
      PG8_STAGE(PG8_SB(1, 1), b3 + hstepB, voffB);
      PG8_WAIT_VB; PG8_BAR; PG8_MMA(1, 1, At, B1); PG8_BAR;
    }
    if constexpr (!Epi::AFTER_DRAIN) E(acc, cur, wr, wc, fr, fq);
    if (!has_next) break;
#pragma unroll
    for (int a = 0; a < 2; ++a)
#pragma unroll
      for (int b = 0; b < 2; ++b)
#pragma unroll
        for (int m = 0; m < MT; ++m)
#pragma unroll
          for (int n = 0; n < 2; ++n) acc[a][b][m][n] = (f32x4){0.f, 0.f, 0.f, 0.f};
    cur = nxt; cA = nA; cB = nB; ++ui;
  }
  PG8_WAIT_V(0);
  if (wr == 0) PG8_BAR;
  PG8_BAR;
  if constexpr (Epi::AFTER_DRAIN) E.fused(acc, cur, wr, wc, fr, fq, lds);
#undef PG8_SA
#undef PG8_SB
#undef PG8_STAGE
#undef PG8_STAGEA
#undef PG8_WAIT_VA
#undef PG8_WAIT_VB
#undef PG8_WAIT_LB
#undef PG8_LDA
#undef PG8_LDB
#undef PG8_MMA
#undef PG8_WAIT_V
#undef PG8_WAIT_L
#undef PG8_BAR
#undef PG8_SCHED
}

struct TileSched {
  const u16* A; const u16* B; int lda, ldb, nM, nN, G, c, bm;
  __device__ __forceinline__ bool next(int i, GUnit& u) const {
    int pm, pn; if (!tile_order(i * G + c, nM, nN, pm, pn)) return false;
    u.pm = pm; u.pn = pn; u.aux = 0; u.A = (const char*)(A + (size_t)pm * bm * lda); u.B = (const char*)(B + (size_t)pn * BM * ldb); return true;
  }
};
struct BranchSched {
  const u16* brin; const u16* wbr; int G, c;
  __device__ __forceinline__ bool next(int i, GUnit& u) const {
    int pm, pn; const int ti = i / 3, br = i - ti * 3; if (!tile_order(ti * G + c, 64, 4, pm, pn)) return false;
    u.pm = pm; u.pn = pn; u.aux = br; u.A = (const char*)(brin + (size_t)br * NTOK * 512 + (size_t)pm * 192 * 512); u.B = (const char*)(wbr + (size_t)br * D * 512 + (size_t)pn * BM * 512); return true;
  }
};
struct OneSched { GUnit u; __device__ __forceinline__ bool next(int i, GUnit& o) const { if (i != 0) return false; o = u; return true; } };

__device__ __forceinline__ bf16x8 pack8(const f32x4& a, const f32x4& b) {
  u32x4 o; o[0] = cvt_pk_bf16(a[0], a[1]); o[1] = cvt_pk_bf16(a[2], a[3]); o[2] = cvt_pk_bf16(b[0], b[1]); o[3] = cvt_pk_bf16(b[2], b[3]); return __builtin_bit_cast(bf16x8, o);
}
__device__ __forceinline__ bf16x4 pack4(float a, float b, float c, float d) { u32x2 o; o[0] = cvt_pk_bf16(a, b); o[1] = cvt_pk_bf16(c, d); return __builtin_bit_cast(bf16x4, o); }

struct EpiSwiglu {
  static constexpr bool AFTER_DRAIN = false;
  u16* h;
  __device__ __forceinline__ void operator()(const f32x4 (&acc)[2][2][4][2], const GUnit& u, int wr, int wc, int fr, int fq) const {
    const int row0 = u.pm * BM + wr * 64 + fr, col0 = u.pn * 128 + wc * 32 + fq * 8;
#pragma unroll
    for (int ai = 0; ai < 2; ++ai)
#pragma unroll
      for (int m = 0; m < 4; ++m) {
        f32x4 r[2];
#pragma unroll
        for (int n = 0; n < 2; ++n)
#pragma unroll
          for (int j = 0; j < 4; ++j) { const float a = acc[ai][0][m][n][j], g = acc[ai][1][m][n][j]; r[n][j] = a * sigmoidf_(a) * g; }
        *(bf16x8*)(h + (size_t)(row0 + ai * HALF + m * 16) * DFF + col0) = pack8(r[0], r[1]);
      }
  }
};
struct EpiResidNorm {
  static constexpr bool AFTER_DRAIN = true;
  const Params& p; int l, kind;
  __device__ __forceinline__ void fused(f32x4 (&acc)[2][2][3][2], const GUnit& un, int wr, int wc, int fr, int fq, LAS unsigned char* lds) const {
    const bool isout = kind == 8, fin = (kind == 11 && l == 1), firstres = (l == 0 && kind == 2);
    const int use = l * 3 + (kind == 2 ? 0 : (isout ? 1 : 2)), nk = kind == 2 ? 1 : (isout ? 2 : 0), nl = kind == 11 ? l + 1 : l;
    float* x = p.out; const float* xc = firstres ? p.x_prompt : p.out; const float* xl = firstres ? p.x_sample : p.out + (size_t)NCTX * D;
    const float* gatev = p.mods + (size_t)l * 5 * 9216 + (isout ? 5 : (kind == 2 ? 2 : 8)) * 1024; const float coef = isout ? 1.0f : 0.5f;
    u16* u = p.u; const float* gn = fin ? p.g_final : p.g_norm + ((size_t)nl * 3 + nk) * D; const float* mdn = fin ? p.mods : p.mods + (size_t)nl * 5 * 9216 + nk * 3 * 1024;
    float* part = p.part + (size_t)use * 64 * 4 * 192; unsigned* cnt = p.ctr + XB_PCNT + use * 64;
    const int tid = tid_opaque();
    const int col0 = un.pn * BM + wc * 32 + fq * 8;
    LAS float* rp = (LAS float*)lds; LAS float* rs = rp + 1024;
#pragma unroll
    for (int ai = 0; ai < 2; ++ai)
#pragma unroll
      for (int m = 0; m < 3; ++m) {
        const int rl = ai * 96 + wr * 48 + m * 16 + fr; const int row = un.pm * 192 + rl;
        const float* xs = (row < NCTX ? xc + (size_t)row * D : xl + (size_t)(row - NCTX) * D) + col0;
        const float* gp = gatev + cond_of(row) * 9216 + col0;
        f32x4 xv[2][2], g[2][2];
#pragma unroll
        for (int bj = 0; bj < 2; ++bj)
#pragma unroll
          for (int n = 0; n < 2; ++n) { xv[bj][n] = *(const f32x4*)(xs + bj * HALF + n * 4); g[bj][n] = *(const f32x4*)(gp + bj * HALF + n * 4); }
        float s = 0.f;
#pragma unroll
        for (int bj = 0; bj < 2; ++bj)
#pragma unroll
          for (int n = 0; n < 2; ++n) { const f32x4 xn = xv[bj][n] + coef * g[bj][n] * acc[ai][bj][m][n]; acc[ai][bj][m][n] = xn;
            s += xn[0] * xn[0] + xn[1] * xn[1] + xn[2] * xn[2] + xn[3] * xn[3];
            if (!fin) *(f32x4*)(x + (size_t)row * D + col0 + bj * HALF + n * 4) = xn; }
        s += __shfl_xor(s, 16); s += __shfl_xor(s, 32);
        if (fq == 0) rp[rl * 4 + wc] = s;
      }
    __syncthreads();
    float* slot = part + (size_t)(un.pm * 4) * 192;
    if (tid < 192) { const float t = (rp[tid * 4] + rp[tid * 4 + 1]) + (rp[tid * 4 + 2] + rp[tid * 4 + 3]);
      __hip_atomic_store(slot + un.pn * 192 + tid, t, __ATOMIC_RELAXED, __HIP_MEMORY_SCOPE_AGENT); }
    asm volatile("s_waitcnt vmcnt(0)" ::: "memory");
    __syncthreads();
    if (tid == 0) {
      __hip_atomic_fetch_add(cnt + un.pm, 1u, __ATOMIC_RELAXED, __HIP_MEMORY_SCOPE_AGENT);
      unsigned sp = 0;
      while (__hip_atomic_load(cnt + un.pm, __ATOMIC_RELAXED, __HIP_MEMORY_SCOPE_AGENT) < 4u) { __builtin_amdgcn_s_sleep(1); if (++sp > (1u << 22)) break; }
    }
    __syncthreads();
    if (tid < 192) { float t = 0.f;
#pragma unroll
      for (int q = 0; q < 4; ++q) t += __hip_atomic_load(slot + q * 192 + tid, __ATOMIC_RELAXED, __HIP_MEMORY_SCOPE_AGENT);
      rs[tid] = rsqrtf(t * (1.f / 1024.f) + EPS); }
    __syncthreads();
    const float* gnp = gn + col0;
    f32x4 gw0[2][2];
#pragma unroll
    for (int bj = 0; bj < 2; ++bj)
#pragma unroll
      for (int n = 0; n < 2; ++n) gw0[bj][n] = *(const f32x4*)(gnp + bj * HALF + n * 4);
#pragma unroll
    for (int ai = 0; ai < 2; ++ai)
#pragma unroll
      for (int m = 0; m < 3; ++m) { const int rl = ai * 96 + wr * 48 + m * 16 + fr; const float rstd = rs[rl]; const int row = un.pm * 192 + rl; const unsigned eo = (unsigned)(row * D + col0);
        if (fin) {
#pragma unroll
          for (int bj = 0; bj < 2; ++bj) { *(f32x4*)(x + (eo + bj * HALF)) = acc[ai][bj][m][0] * rstd * gw0[bj][0]; *(f32x4*)(x + (eo + bj * HALF + 4)) = acc[ai][bj][m][1] * rstd * gw0[bj][1]; }
        } else { const float* md = mdn + cond_of(row) * 9216 + col0;
#pragma unroll
          for (int bj = 0; bj < 2; ++bj) { f32x4 o[2];
#pragma unroll
            for (int n = 0; n < 2; ++n) o[n] = acc[ai][bj][m][n] * rstd * gw0[bj][n] * (1.f + *(const f32x4*)(md + 1024 + bj * HALF + n * 4)) + *(const f32x4*)(md + bj * HALF + n * 4);
            *(bf16x8*)(u + (eo + bj * HALF)) = pack8(o[0], o[1]); } } }
  }
};
struct EpiBig {
  static constexpr bool AFTER_DRAIN = false;
  u16 *zA, *gb, *Yt; float* out; int l; float* gate; const float* bmg;
  __device__ __forceinline__ void operator()(const f32x4 (&acc)[2][2][4][2], const GUnit& u, int wr, int wc, int fr, int fq) const {
    const int row0 = u.pm * BM + wr * 64 + fr; const int pn = u.pn; const int colw = wc * 32 + fq * 8;
#pragma unroll
    for (int ai = 0; ai < 2; ++ai)
#pragma unroll
      for (int m = 0; m < 4; ++m) {
        const int row = row0 + ai * HALF + m * 16;
#pragma unroll
        for (int bj = 0; bj < 2; ++bj) {
          const int c = pn * BM + bj * HALF + colw;
          f32x4 v0 = acc[ai][bj][m][0], v1 = acc[ai][bj][m][1];
          if (pn < 6) {
            *(bf16x8*)(zA + (size_t)row * ZLD + c) = pack8(v0, v1);
            if (pn >= 2 && row < NCTX) {
              const int cc = (c - 512) & 511, hh = cc >> 7, d = cc & 127, b = row >> 8, t = row & 255;
              float* o = out + (pn < 4 ? O_CK : O_CV) + ((((size_t)(b * 2 + l) * 4 + hh) * 256 + t) * 128 + d);
              *(f32x4*)o = v0; *(f32x4*)(o + 4) = v1;
            }
          } else if (pn < 10) {
            const int cp = c - 1536, g = cp >> 8, j = cp & 255, cs = j >> 7, np = j & 127;
            u16* base;
            if (row < NCTX) { const int b = row >> 8, t = row & 255; base = Yt + (size_t)b * 512 * 512 + (size_t)(g * 128 + np) * 512 + cs * 256 + t;
#pragma unroll
              for (int q = 0; q < 4; ++q) { base[(size_t)q * 512] = f2bf(v0[q]); base[(size_t)(q + 4) * 512] = f2bf(v1[q]); }
            } else { const int rr = row - NCTX, b = rr >> 10, t = rr & 1023; base = Yt + (size_t)32 * 512 * 512 + (size_t)b * 512 * 2048 + (size_t)(g * 128 + np) * 2048 + cs * 1024 + t;
#pragma unroll
              for (int q = 0; q < 4; ++q) { base[(size_t)q * 2048] = f2bf(v0[q]); base[(size_t)(q + 4) * 2048] = f2bf(v1[q]); }
            }
          } else if (pn < 18) {
            if (pn == 12 || pn == 13) { v0 *= 0.08838834764831845f; v1 *= 0.08838834764831845f; }
            if (pn >= 16) {
#pragma unroll
              for (int q = 0; q < 4; ++q) { v0[q] = sigmoidf_(v0[q]); v1[q] = sigmoidf_(v1[q]); }
            }
            *(bf16x8*)(zA + (size_t)row * ZLD + (c - 1024)) = pack8(v0, v1);
          } else if (pn < 30) {
#pragma unroll
            for (int q = 0; q < 4; ++q) { v0[q] = sigmoidf_(v0[q]); v1[q] = sigmoidf_(v1[q]); }
            *(bf16x8*)(gb + (size_t)row * GBLD + (c - 4608)) = pack8(v0, v1);
          } else if (bj == 0 && wc == 0 && fq < 2) {
#pragma unroll
            for (int q = 0; q < 8; ++q) { const int j = fq * 8 + q; float a = (q < 4 ? v0[q] : v1[q - 4]) + bmg[l * 16 + j];
              if ((j >> 2) & 1) a = fminf(a, 0.f) - log1pf(__expf(-fabsf(a)));
              gate[(size_t)row * 16 + j] = a; }
          }
        }
      }
  }
};
struct EpiBranch {
  static constexpr bool AFTER_DRAIN = false;
  u16* tmp; const u16* gb; u16* merged;
  __device__ __forceinline__ void operator()(const f32x4 (&acc)[2][2][3][2], const GUnit& u, int wr, int wc, int fr, int fq) const {
    const int row0 = u.pm * 192 + wr * 48 + fr, col0 = u.pn * BM + wc * 32 + fq * 8; const int br = u.aux;
    u16* dst = br < 2 ? tmp : merged;
#pragma unroll
    for (int ai = 0; ai < 2; ++ai) {
      bf16x8 g8[3][2], t8[3][2];
#pragma unroll
      for (int m = 0; m < 3; ++m)
#pragma unroll
        for (int bj = 0; bj < 2; ++bj) { const int row = row0 + ai * 96 + m * 16, c = col0 + bj * HALF;
          g8[m][bj] = *(const bf16x8*)(gb + (size_t)row * GBLD + br * D + c);
          if (br > 0) t8[m][bj] = *(const bf16x8*)(tmp + (size_t)row * D + c); }
#pragma unroll
      for (int m = 0; m < 3; ++m)
#pragma unroll
        for (int bj = 0; bj < 2; ++bj) { const int row = row0 + ai * 96 + m * 16, c = col0 + bj * HALF;
          f32x4 r0, r1;
#pragma unroll
          for (int q = 0; q < 4; ++q) { r0[q] = bf2f((u16)g8[m][bj][q]) * acc[ai][bj][m][0][q]; r1[q] = bf2f((u16)g8[m][bj][q + 4]) * acc[ai][bj][m][1][q]; }
          if (br > 0) {
#pragma unroll
            for (int q = 0; q < 4; ++q) { r0[q] += bf2f((u16)t8[m][bj][q]); r1[q] += bf2f((u16)t8[m][bj][q + 4]); } }
          *(bf16x8*)(dst + (size_t)row * D + c) = pack8(r0, r1); }
    }
  }
};
struct EpiFour {
  static constexpr bool AFTER_DRAIN = false;
  u16* fo; float scale;
  __device__ __forceinline__ void operator()(const f32x4 (&acc)[2][2][4][2], const GUnit& u, int wr, int wc, int fr, int fq) const {
    const int row0 = u.pm + wr * 64 + fr, col0 = u.pn * BM + wc * 32 + fq * 8;
#pragma unroll
    for (int ai = 0; ai < 2; ++ai)
#pragma unroll
      for (int m = 0; m < 4; ++m)
#pragma unroll
        for (int bj = 0; bj < 2; ++bj)
          *(bf16x8*)(fo + (size_t)(row0 + ai * HALF + m * 16) * 512 + col0 + bj * HALF) = pack8(acc[ai][bj][m][0] * scale, acc[ai][bj][m][1] * scale);
  }
};

struct TrJob { const float* src; u16* dst; int lds_, ldd, k0, ns0, nd0, mode; };
__device__ __forceinline__ void tr_decode(const Params& p, int l, int j, TrJob& t) {
  t.mode = 0;
  if (j < 352 || (j >= 528 && j < 880)) { const bool second = j >= 528; const int q = second ? j - 528 : j; const int kt = q / 22, nb = q % 22;
    t.src = (second ? p.w_ffn2_in : p.w_ffn1_in) + (size_t)l * D * 2 * DFF; t.dst = second ? p.wt_ffn2_in : p.wt_ffn1_in; t.lds_ = 2 * DFF; t.ldd = D; t.k0 = kt * 64; t.ns0 = nb * 256; t.nd0 = 0; t.mode = 1; }
  else if (j < 528 || (j >= 880 && j < 1056)) { const bool second = j >= 880; const int q = second ? j - 880 : j - 352; const int kt = q >> 2, nb = q & 3;
    t.src = (second ? p.w_ffn2_out : p.w_ffn1_out) + (size_t)l * DFF * D; t.dst = second ? p.wt_ffn2_out : p.wt_ffn1_out; t.lds_ = D; t.ldd = DFF; t.k0 = kt * 64; t.ns0 = nb * 256; t.nd0 = t.ns0; }
  else if (j < 1280) { const int q = j - 1056, kt = q / 14, nb = q % 14; t.src = p.w_in + (size_t)l * D * PIN; t.dst = p.wt_big; t.lds_ = PIN; t.ldd = D; t.k0 = kt * 64;
    if (nb < 6) { t.ns0 = nb * 256; t.nd0 = t.ns0; } else { t.ns0 = 2048 + (nb - 6) * 256; t.nd0 = t.ns0 + 512; } }
  else if (j < 1472) { const int q = j - 1280, kt = q / 12, nb = q % 12; t.src = p.w_branch_gate + (size_t)l * D * 3 * D; t.dst = p.wt_big; t.lds_ = 3 * D; t.ldd = D; t.k0 = kt * 64; t.ns0 = nb * 256; t.nd0 = 4608 + t.ns0; }
  else if (j < 1568) { const int q = j - 1472, br = q >> 5, jj = q & 31, kt = jj >> 2, nb = jj & 3;
    t.src = (br == 0 ? p.w_br_attn : br == 1 ? p.w_br_four : p.w_br_mlstm) + (size_t)l * 512 * D; t.dst = p.wt_br + (size_t)br * D * 512; t.lds_ = D; t.ldd = 512; t.k0 = kt * 64; t.ns0 = nb * 256; t.nd0 = t.ns0; }
  else { const int q = j - 1568, kt = q >> 2, nb = q & 3; t.src = p.w_out + (size_t)l * D * D; t.dst = p.wt_out; t.lds_ = D; t.ldd = D; t.k0 = kt * 64; t.ns0 = nb * 256; t.nd0 = t.ns0; }
}
__device__ __forceinline__ void tr_load(const TrJob& t, int tid, f32x4 (&r)[8]) {
#pragma unroll
  for (int i = 0; i < 8; ++i) { const int idx = tid + i * 512, kk = idx >> 6, c4 = idx & 63; r[i] = *(const f32x4*)(t.src + (size_t)(t.k0 + kk) * t.lds_ + t.ns0 + c4 * 4); }
}

__device__ void wf_job(const Params& p, int l, int job, LAS float* sm) {
  const int tid = tid_opaque();
  const int g = job >> 5, kb = (job >> 1) & 15, jh = job & 1; LAS float* W = sm; LAS float* ct = sm + 64 * 129;
  __syncthreads();
  for (int i = tid; i < 64 * 32; i += 512) { const int kk = i >> 5, c4 = i & 31;
    const float4 v = *(const float4*)(p.w_in + ((size_t)l * D + kb * 64 + kk) * PIN + 1536 + g * 128 + c4 * 4);
    LAS float* s = W + kk * 129 + c4 * 4; s[0] = v.x; s[1] = v.y; s[2] = v.z; s[3] = v.w; }
  if (tid < 128) ct[tid] = cospif((float)tid / 64.f);
  __syncthreads();
  const int kk = tid & 63, jg = tid >> 6; float a[16];
#pragma unroll
  for (int q = 0; q < 16; ++q) a[q] = 0.f;
  const int jbase = jh * 128 + jg * 16;
  for (int c = 0; c < 128; ++c) { const float w = W[kk * 129 + c];
#pragma unroll
    for (int q = 0; q < 16; ++q) { const int j = jbase + q; const int idx = jh ? ((c * (j - 128) - 32) & 127) : ((c * j) & 127); a[q] += w * ct[idx]; } }
#pragma unroll
  for (int q = 0; q < 16; ++q) p.wt_big[(size_t)(1536 + g * 256 + jbase + q) * D + kb * 64 + kk] = f2bf(a[q]);
}

__device__ void mods_job(const Params& p, int job, LAS float* sm) {
  const int tid = tid_opaque();
  const int l = job / 72, cb = job % 72; LAS float* sc = sm; LAS float* part = sm + 5 * 1024;
  __syncthreads();
  for (int i = tid; i < 5 * 1024; i += 512) { const int ci = i >> 10, k = i & 1023; const float v = ci == 0 ? p.c_ctx[k] : p.c[(ci - 1) * D + k]; sc[i] = v * sigmoidf_(v); }
  __syncthreads();
  const int cg4 = tid & 31, kp = tid >> 5; f32x4 a[5];
#pragma unroll
  for (int ci = 0; ci < 5; ++ci) a[ci] = (f32x4){0.f, 0.f, 0.f, 0.f};
  const float* wp = p.w_ada + ((size_t)l * D + kp * 64) * 9216 + cb * 128 + cg4 * 4;
#pragma unroll 8
  for (int k = 0; k < 64; ++k) { const f32x4 w = *(const f32x4*)(wp + (size_t)k * 9216);
#pragma unroll
    for (int ci = 0; ci < 5; ++ci) a[ci] += sc[ci * 1024 + kp * 64 + k] * w; }
#pragma unroll
  for (int ci = 0; ci < 5; ++ci)
#pragma unroll
    for (int q = 0; q < 4; ++q) part[(kp * 5 + ci) * 128 + cg4 * 4 + q] = a[ci][q];
  __syncthreads();
  for (int o = tid; o < 640; o += 512) { const int ci = o >> 7, cc = o & 127; float s = p.b_ada[(size_t)l * 9216 + cb * 128 + cc];
    for (int q = 0; q < 16; ++q) s += part[(q * 5 + ci) * 128 + cc];
    p.mods[((size_t)l * 5 + ci) * 9216 + cb * 128 + cc] = s; }
}

__device__ void prep_seg(const Params& p, int l, int seg, LAS unsigned char* lds, volatile LAS int* segdone) {
  if (segdone[l * 2 + seg]) return;
  const int tid = tid_opaque(); LAS float* sm = (LAS float*)lds; LAS int* s_job = (LAS int*)(lds + 131072 - 16);
  const int qi = 8 + l * 2 + seg;
  const int npre = seg ? 129 : (l == 0 ? 144 : 0), trofs = seg ? 528 : 0, ntr = seg ? 1104 : 528;
  const int trbase = npre, njobs = npre + ntr;
  int job;
  for (;;) {
    __syncthreads();
    if (tid == 0) *s_job = (int)atomicAdd(p.ctr + XB_CTR + qi, 1u);
    __syncthreads();
    job = *s_job;
    if (job >= njobs && tid == 0) segdone[l * 2 + seg] = 1;
    if (job >= trbase) break;
    if (seg && job == 128) { for (int i = tid; i < 16 * 1024; i += 512) { const int j = i >> 10, k = i & 1023; p.wt_big[(size_t)(7680 + j) * D + k] = f2bf(p.w_in[((size_t)l * D + k) * PIN + 4096 + j]); } }
    else if (seg) wf_job(p, l, job, sm); else mods_job(p, job, sm);
  }
  if (job >= njobs) return;
  f32x4 r[8]; TrJob t;
  tr_decode(p, l, job - trbase + trofs, t); tr_load(t, tid, r);
  for (;;) {
    __syncthreads();
#pragma unroll
    for (int i = 0; i < 8; ++i) { const int idx = tid + i * 512, kk = idx >> 6, c4 = idx & 63; LAS float* s = sm + kk * 257 + c4 * 4; s[0] = r[i][0]; s[1] = r[i][1]; s[2] = r[i][2]; s[3] = r[i][3]; }
    if (tid == 0) *s_job = (int)atomicAdd(p.ctr + XB_CTR + qi, 1u);
    __syncthreads();
    const int nextjob = *s_job; const TrJob cur = t;
    if (nextjob >= njobs && tid == 0) segdone[l * 2 + seg] = 1;
    if (nextjob < njobs) { tr_decode(p, l, nextjob - trbase + trofs, t); tr_load(t, tid, r); }
#pragma unroll
    for (int i = 0; i < 4; ++i) { const int unit = tid + i * 512, nn = unit >> 3, ch = unit & 7; bf16x8 o;
#pragma unroll
      for (int q = 0; q < 8; ++q) o[q] = (short)f2bf(sm[(ch * 8 + q) * 257 + nn]);
      int drow;
      if (cur.mode == 1) { const int col = cur.ns0 + nn, isg = col >= DFF, hid = col - isg * DFF; drow = (hid >> 7) * 256 + isg * 128 + (hid & 127); } else drow = cur.nd0 + nn;
      *(bf16x8*)(cur.dst + (size_t)drow * cur.ldd + cur.k0 + ch * 8) = o; }
    if (nextjob >= njobs) break;
  }
}

__device__ void phase0(const Params& p, LAS unsigned char* lds) {
  const int tid = tid_opaque(); const int G = gridDim.x;
  if (blockIdx.x == 0 && tid >= 64 && tid < 66) { const int l = tid - 64; const float* lp = p.attn_lambda + l * 256; float s1 = 0.f, s2 = 0.f;
    for (int i = 0; i < 64; ++i) { s1 += lp[i] * lp[64 + i]; s2 += lp[128 + i] * lp[192 + i]; }
    p.lam[l] = expf(s1) - expf(s2) + lam_init_of(l); }
  const int gtid = blockIdx.x * 512 + tid, gn = G * 512;
  for (int i = gtid; i < 1024 * 2048; i += gn) { const int tp = i >> 11, col = i & 2047, t = col & 1023, s = col >> 10; const int r = (t * tp) & 1023; const float x = (float)r / 512.f;
    p.cs1024[i] = f2bf(s ? -sinpif(x) : cospif(x)); }
  for (int i = gtid; i < 256 * 512; i += gn) { const int tp = i >> 9, col = i & 511, t = col & 255, s = col >> 8; const int r = (t * tp) & 255; const float x = (float)r / 128.f;
    p.cs256[i] = f2bf(s ? -sinpif(x) : cospif(x)); }
  for (int i = gtid; i < 1024 * 32; i += gn) { const int t = i >> 5, pp = i & 31; const float pos = pp < 16 ? (float)(t >> 6) : (float)(t & 63);
    const float inv = powf(10000.f, -(float)(pp & 15) / 16.f); float s, c; sincosf(pos * inv, &s, &c); p.rope[2 * i] = c; p.rope[2 * i + 1] = s; }
}

__device__ __forceinline__ float wave_sum(float v) {
#pragma unroll
  for (int o = 32; o >= 1; o >>= 1) v += __shfl_xor(v, o);
  return v;
}
__device__ void norm_phase(const Params& p, int l, int which, LAS unsigned char* lds) {
  const int tid = tid_opaque(), wid = tid >> 6, lane = tid & 63; const bool gates = which == 1;
  LAS float* Wg = (LAS float*)lds; LAS float* ur = Wg + 16384 + wid * 1024;
  if (gates) { __syncthreads();
    for (int i = tid; i < 4096; i += 512) { const int k = i >> 2, q = i & 3; const float4 v = *(const float4*)(p.w_in + ((size_t)l * D + k) * PIN + 4096 + q * 4);
      LAS float* s = Wg + k * 16 + q * 4; s[0] = v.x; s[1] = v.y; s[2] = v.z; s[3] = v.w; }
    __syncthreads(); }
  float* X = p.out; const bool first = (l == 0 && which == 0);
  const float* Xc = first ? p.x_prompt : X; const float* Xl = first ? p.x_sample : X + (size_t)NCTX * D;
#define XROW(r) ((r) < NCTX ? Xc + (size_t)(r) * D : Xl + (size_t)((r) - NCTX) * D)
  f32x4 v[4], vn[4];
  { const int rg0 = blockIdx.x; if (rg0 < NTOK / 8) { const float* xr = XROW(rg0 * 8 + wid);
#pragma unroll
      for (int i = 0; i < 4; ++i) v[i] = *(const f32x4*)(xr + i * 256 + lane * 4); } }
  for (int rg = blockIdx.x; rg < NTOK / 8; rg += gridDim.x) {
    const int row = rg * 8 + wid; float* xr = X + (size_t)row * D;
    const int rgn = rg + gridDim.x;
    if (rgn < NTOK / 8) { const float* xn = XROW(rgn * 8 + wid);
#pragma unroll
      for (int i = 0; i < 4; ++i) vn[i] = *(const f32x4*)(xn + i * 256 + lane * 4); }
    float ss = 0.f;
#pragma unroll
    for (int i = 0; i < 4; ++i) ss += v[i][0] * v[i][0] + v[i][1] * v[i][1] + v[i][2] * v[i][2] + v[i][3] * v[i][3];
    ss = wave_sum(ss); const float rstd = rsqrtf(ss * (1.f / 1024.f) + EPS);
    if (which == 3) {
#pragma unroll
      for (int i = 0; i < 4; ++i) { const f32x4 g = *(const f32x4*)(p.g_final + i * 256 + lane * 4); *(f32x4*)(xr + i * 256 + lane * 4) = v[i] * rstd * g; }
    } else {
      const float* md = p.mods + ((size_t)l * 5 + cond_of(row)) * 9216 + which * 3 * 1024; const float* gn = p.g_norm + ((size_t)l * 3 + which) * D;
#pragma unroll
      for (int i = 0; i < 4; ++i) { const int c = i * 256 + lane * 4; const f32x4 g = *(const f32x4*)(gn + c), sh = *(const f32x4*)(md + c), sc = *(const f32x4*)(md + 1024 + c);
        v[i] = v[i] * rstd * g * (1.f + sc) + sh;
        *(bf16x4*)(p.u + (size_t)row * D + c) = pack4(v[i][0], v[i][1], v[i][2], v[i][3]); }
      if (gates) {
        __syncthreads();
#pragma unroll
        for (int i = 0; i < 4; ++i) { LAS float* s = ur + i * 256 + lane * 4; s[0] = v[i][0]; s[1] = v[i][1]; s[2] = v[i][2]; s[3] = v[i][3]; }
        __syncthreads();
        const int j = lane & 15, kp = lane >> 4; float a = 0.f;
#pragma unroll 8
        for (int kk = 0; kk < 256; ++kk) a += ur[kk * 4 + kp] * Wg[(kk * 4 + kp) * 16 + j];
        a += __shfl_xor(a, 16); a += __shfl_xor(a, 32);
        if (lane < 16) { a += p.b_mgate[l * 16 + j]; if ((j >> 2) & 1) a = fminf(a, 0.f) - log1pf(__expf(-fabsf(a))); p.gate[(size_t)row * 16 + j] = a; }
      }
    }
#pragma unroll
    for (int i = 0; i < 4; ++i) v[i] = vn[i];
  }
}

__device__ void attn_item(const Params& p, int l, int item, LAS unsigned char* lds) {
  const int tid = tid_opaque(), wid = tid >> 6, lane = tid & 63, fr = lane & 15, fq = lane >> 4;
  const bool lat = item < 128; int b, h, qb, seqbase, nkt;
  if (lat) { b = item >> 5; h = (item >> 3) & 3; qb = item & 7; seqbase = NCTX + b * 1024; nkt = 20; }
  else { const int i2 = item - 128; b = i2 >> 3; h = (i2 >> 1) & 3; qb = i2 & 1; seqbase = b * 256; nkt = 4; }
  LAS unsigned char* Ks = lds; LAS unsigned char* VT = lds + 64 * 272;
  const float2* rope = (const float2*)p.rope;
  const int qtok = qb * 128 + wid * 16 + fr;
  bf16x8 Qf[2][2];
  { const u16* qp = p.zA + (size_t)(seqbase + qtok) * ZLD + h * 128;
#pragma unroll
    for (int i = 0; i < 2; ++i)
#pragma unroll
      for (int kk = 0; kk < 2; ++kk) Qf[i][kk] = *(const bf16x8*)(qp + i * 64 + kk * 32 + fq * 8);
    if (lat) {
#pragma unroll
      for (int j = 0; j < 8; ++j) { const float2 cs = rope[qtok * 32 + fq * 8 + j];
#pragma unroll
        for (int i = 0; i < 2; ++i) { const float x1 = bf2f((u16)Qf[i][0][j]), x2 = bf2f((u16)Qf[i][1][j]);
          Qf[i][0][j] = (short)f2bf(x1 * cs.x - x2 * cs.y); Qf[i][1][j] = (short)f2bf(x1 * cs.y + x2 * cs.x); } }
    }
  }
  f32x4 O[2][8];
#pragma unroll
  for (int i = 0; i < 2; ++i)
#pragma unroll
    for (int d = 0; d < 8; ++d) O[i][d] = (f32x4){0.f, 0.f, 0.f, 0.f};
  float mrun[2] = {-1e30f, -1e30f}, lrun[2] = {0.f, 0.f};
  const float sc = 0.125f * 1.4426950408889634f;
  const int skey = tid >> 3, ssub = tid & 7, smap = ssub >> 2, spg = ssub & 3, sd1 = smap * 64 + spg * 8;
  f32x4 kraw[4], vraw[4]; float2 rcs[8];
#define ATT_ISSUE(kt_) do { const int kt__ = (kt_); const int gk = kt__ * 64 + skey, gkv = kt__ * 64 + lane; \
    if (lat && kt__ < 4) { const float* kp = p.cache_k + ((((size_t)(b * 2 + l) * 4 + h) * 256 + gk) * 128) + sd1; \
      kraw[0] = *(const f32x4*)kp; kraw[1] = *(const f32x4*)(kp + 4); kraw[2] = *(const f32x4*)(kp + 32); kraw[3] = *(const f32x4*)(kp + 36); \
      const float* vp = p.cache_v + ((((size_t)(b * 2 + l) * 4 + h) * 256 + gkv) * 128) + wid * 16; \
      vraw[0] = *(const f32x4*)vp; vraw[1] = *(const f32x4*)(vp + 4); vraw[2] = *(const f32x4*)(vp + 8); vraw[3] = *(const f32x4*)(vp + 12); \
    } else { const int tok = lat ? gk - 256 : gk, tokv = lat ? gkv - 256 : gkv; const u16* kp = p.zA + (size_t)(seqbase + tok) * ZLD + 512 + h * 128 + sd1; \
      kraw[0] = *(const f32x4*)kp; kraw[1] = *(const f32x4*)(kp + 32); \
      const u16* vp = p.zA + (size_t)(seqbase + tokv) * ZLD + 1024 + h * 128 + wid * 16; vraw[0] = *(const f32x4*)vp; vraw[1] = *(const f32x4*)(vp + 8); \
      if (lat) { _Pragma("unroll") for (int j = 0; j < 8; ++j) rcs[j] = rope[tok * 32 + spg * 8 + j]; } } } while (0)
  ATT_ISSUE(0);
  for (int kt = 0; kt < nkt; ++kt) {
    __syncthreads();
    { float x1[8], x2[8];
      if (lat && kt < 4) {
#pragma unroll
        for (int j = 0; j < 4; ++j) { x1[j] = kraw[0][j]; x1[j + 4] = kraw[1][j]; x2[j] = kraw[2][j]; x2[j + 4] = kraw[3][j]; }
      } else { const bf16x8 a = __builtin_bit_cast(bf16x8, kraw[0]), bb = __builtin_bit_cast(bf16x8, kraw[1]);
#pragma unroll
        for (int j = 0; j < 8; ++j) { x1[j] = bf2f((u16)a[j]); x2[j] = bf2f((u16)bb[j]); }
        if (lat) {
#pragma unroll
          for (int j = 0; j < 8; ++j) { const float2 cs = rcs[j]; const float o1 = x1[j] * cs.x - x2[j] * cs.y, o2 = x1[j] * cs.y + x2[j] * cs.x; x1[j] = o1; x2[j] = o2; }
        }
      }
      bf16x8 o1, o2;
      { u32x4 t1, t2;
#pragma unroll
        for (int j = 0; j < 4; ++j) { t1[j] = cvt_pk_bf16(x1[2 * j], x1[2 * j + 1]); t2[j] = cvt_pk_bf16(x2[2 * j], x2[2 * j + 1]); }
        o1 = __builtin_bit_cast(bf16x8, t1); o2 = __builtin_bit_cast(bf16x8, t2); }
      *(LAS bf16x8*)(Ks + skey * 272 + sd1 * 2) = o1; *(LAS bf16x8*)(Ks + skey * 272 + (sd1 + 32) * 2) = o2;
    }
    { const int key = lane, d0 = wid * 16; u16 xv[16];
      if (lat && kt < 4) {
#pragma unroll
        for (int q = 0; q < 4; ++q)
#pragma unroll
          for (int j = 0; j < 4; ++j) xv[q * 4 + j] = f2bf(vraw[q][j]);
      } else { const bf16x8 a = __builtin_bit_cast(bf16x8, vraw[0]), bb = __builtin_bit_cast(bf16x8, vraw[1]);
#pragma unroll
        for (int j = 0; j < 8; ++j) { xv[j] = (u16)a[j]; xv[j + 8] = (u16)bb[j]; } }
      const int pos = (key & 32) | (((key >> 2) & 3) << 3) | (((key >> 4) & 1) << 2) | (key & 3);
#pragma unroll
      for (int i = 0; i < 16; ++i) *(LAS u16*)(VT + (d0 + i) * 144 + pos * 2) = xv[i];
    }
    if (kt + 1 < nkt) ATT_ISSUE(kt + 1);
    __syncthreads();
    bf16x8 Pf[2][2];
#pragma unroll
    for (int i = 0; i < 2; ++i) {
      f32x4 S[4];
#pragma unroll
      for (int st = 0; st < 4; ++st) { S[st] = (f32x4){0.f, 0.f, 0.f, 0.f};
#pragma unroll
        for (int kk = 0; kk < 2; ++kk) { const bf16x8 Kf = *(const LAS bf16x8*)(Ks + (st * 16 + fr) * 272 + (i * 64 + kk * 32 + fq * 8) * 2);
          S[st] = __builtin_amdgcn_mfma_f32_16x16x32_bf16(Kf, Qf[i][kk], S[st], 0, 0, 0); } }
      float mx = -1e30f;
#pragma unroll
      for (int st = 0; st < 4; ++st)
#pragma unroll
        for (int j = 0; j < 4; ++j) mx = fmaxf(mx, S[st][j]);
      mx = fmaxf(mx, __shfl_xor(mx, 16)); mx = fmaxf(mx, __shfl_xor(mx, 32));
      const float mnew = fmaxf(mrun[i], mx), alpha = __builtin_amdgcn_exp2f((mrun[i] - mnew) * sc); mrun[i] = mnew;
      float ls = 0.f;
#pragma unroll
      for (int st = 0; st < 4; ++st)
#pragma unroll
        for (int j = 0; j < 4; ++j) { const float pv = __builtin_amdgcn_exp2f((S[st][j] - mnew) * sc); ls += pv; S[st][j] = pv; }
      lrun[i] = lrun[i] * alpha + ls;
#pragma unroll
      for (int d = 0; d < 8; ++d) O[i][d] *= alpha;
#pragma unroll
      for (int ks = 0; ks < 2; ++ks)
#pragma unroll
        for (int j = 0; j < 1; ++j) Pf[i][ks] = pack8(S[2 * ks], S[2 * ks + 1]);
    }
#pragma unroll
    for (int d = 0; d < 8; ++d)
#pragma unroll
      for (int ks = 0; ks < 2; ++ks) { const bf16x8 Vf = *(const LAS bf16x8*)(VT + (d * 16 + fr) * 144 + (ks * 32 + fq * 8) * 2);
        O[0][d] = __builtin_amdgcn_mfma_f32_16x16x32_bf16(Vf, Pf[0][ks], O[0][d], 0, 0, 0);
        O[1][d] = __builtin_amdgcn_mfma_f32_16x16x32_bf16(Vf, Pf[1][ks], O[1][d], 0, 0, 0); }
  }
#undef ATT_ISSUE
  float inv[2];
#pragma unroll
  for (int i = 0; i < 2; ++i) { float lt = lrun[i]; lt += __shfl_xor(lt, 16); lt += __shfl_xor(lt, 32); inv[i] = 1.f / lt; }
  const float lam = p.lam[l], li = lam_init_of(l); const float i0 = inv[0], i1 = inv[1] * lam;
  float ss = 0.f;
#pragma unroll
  for (int d = 0; d < 8; ++d)
#pragma unroll
    for (int j = 0; j < 4; ++j) { const float o = O[0][d][j] * i0 - O[1][d][j] * i1; O[0][d][j] = o; ss += o * o; }
  ss += __shfl_xor(ss, 16); ss += __shfl_xor(ss, 32);
  const float rstd = rsqrtf(ss * (1.f / 128.f) + EPS) * (1.f - li);
  u16* op = p.brin + (size_t)(seqbase + qtok) * 512 + h * 128 + fq * 4; const float* gs = p.g_attn_sub + l * 128 + fq * 4;
#pragma unroll
  for (int d = 0; d < 8; ++d) { const f32x4 g = *(const f32x4*)(gs + d * 16);
    *(bf16x4*)(op + d * 16) = pack4(O[0][d][0] * rstd * g[0], O[0][d][1] * rstd * g[1], O[0][d][2] * rstd * g[2], O[0][d][3] * rstd * g[3]); }
}

__device__ void mlstm_item(const Params& p, int l, int item, LAS unsigned char* lds) {
  const int tid = tid_opaque(), wid = tid >> 6, lane = tid & 63, fr = lane & 15, fq = lane >> 4;
  const bool lat = item < 32; int b, h, dir, seqbase, T;
  if (lat) { b = item >> 3; h = (item >> 1) & 3; dir = item & 1; seqbase = NCTX + b * 1024; T = 1024; }
  else { const int i2 = item - 32; b = i2 >> 3; h = (i2 >> 1) & 3; dir = i2 & 1; seqbase = b * 256; T = 256; }
  const int nch = T >> 6;
  LAS unsigned char* Qs = lds; LAS unsigned char* Ks = lds + 17408; LAS unsigned char* KTs = lds + 34816; LAS unsigned char* VTs = lds + 53248;
  LAS unsigned char* Cs = lds + 71680; LAS unsigned char* Ss = lds + 106496; LAS float* fl = (LAS float*)(lds + 115712);
  LAS float* a_s = fl; LAS float* g_s = fl + 64; LAS float* sp_s = fl + 128; LAS float* wl_s = fl + 192; LAS float* em_s = fl + 256; LAS float* nq_s = fl + 320;
  LAS float* denp = fl + 384; LAS float* nvec = fl + 512; LAS float* scal = fl + 640;
  const size_t sidx = ((size_t)(b * 2 + l) * 2 + dir) * 4 + h;
  f32x4 accC[8];
  __syncthreads();
  if (lat) { const float* cp = p.state_C + sidx * 16384 + (size_t)(wid * 16 + fr) * 128 + fq * 4;
#pragma unroll
    for (int kt = 0; kt < 8; ++kt) accC[kt] = *(const f32x4*)(cp + kt * 16);
    if (tid < 128) nvec[tid] = p.state_n[sidx * 128 + tid];
  } else {
#pragma unroll
    for (int kt = 0; kt < 8; ++kt) accC[kt] = (f32x4){0.f, 0.f, 0.f, 0.f};
    if (tid < 128) nvec[tid] = 0.f;
  }
#pragma unroll
  for (int kt = 0; kt < 8; ++kt) *(LAS bf16x4*)(Cs + (wid * 16 + fr) * 272 + (kt * 16 + fq * 4) * 2) = pack4(accC[kt][0], accC[kt][1], accC[kt][2], accC[kt][3]);
  float mst = lat ? p.state_m[sidx] : 0.f;
  f32x4 qraw[2], kraw[2], vraw[2]; float igr = 0.f, lfr = 0.f;
#define ML_ISSUE(ch_) do { const int ch__ = (ch_); { const int pos = tid >> 3, c16 = (tid & 7) * 16; const int gp_ = ch__ * 64 + pos, tok = dir ? T - 1 - gp_ : gp_; \
      const u16* zp = p.zA + (size_t)(seqbase + tok) * ZLD + h * 128 + c16; \
      qraw[0] = *(const f32x4*)(zp + 1536); qraw[1] = *(const f32x4*)(zp + 1536 + 8); kraw[0] = *(const f32x4*)(zp + 2048); kraw[1] = *(const f32x4*)(zp + 2048 + 8); } \
    { const int gp_ = ch__ * 64 + lane, tok = dir ? T - 1 - gp_ : gp_; const u16* vp = p.zA + (size_t)(seqbase + tok) * ZLD + 2560 + h * 128 + wid * 16; \
      vraw[0] = *(const f32x4*)vp; vraw[1] = *(const f32x4*)(vp + 8); \
      if (wid == 0) { const float* gp = p.gate + (size_t)(seqbase + tok) * 16 + dir * 8 + h; igr = gp[0]; lfr = gp[4]; } } } while (0)
  ML_ISSUE(0);
  for (int ch = 0; ch < nch; ++ch) {
    if (wid == 0) {
      const float ig = igr, lf = lfr; float bs = lf;
#pragma unroll
      for (int o = 1; o < 64; o <<= 1) { const float t = __shfl_up(bs, o); if (lane >= o) bs += t; }
      const float a = ig - bs; float gm = a;
#pragma unroll
      for (int o = 1; o < 64; o <<= 1) { const float t = __shfl_up(gm, o); if (lane >= o) gm = fmaxf(gm, t); }
      gm = fmaxf(gm, mst);
      const float g63 = __shfl(gm, 63), b63 = __shfl(bs, 63);
      a_s[lane] = a; g_s[lane] = gm; sp_s[lane] = __expf(mst - gm); wl_s[lane] = __expf(a - g63); em_s[lane] = __expf(-(bs + gm));
      if (lane == 0) { scal[0] = __expf(mst - g63); scal[1] = b63 + g63; } }
    { const int pos = tid >> 3, c16 = (tid & 7) * 16;
      *(LAS f32x4*)(Qs + pos * 272 + c16 * 2) = qraw[0]; *(LAS f32x4*)(Qs + pos * 272 + c16 * 2 + 16) = qraw[1];
      *(LAS f32x4*)(Ks + pos * 272 + c16 * 2) = kraw[0]; *(LAS f32x4*)(Ks + pos * 272 + c16 * 2 + 16) = kraw[1]; }
    { const bf16x8 v0 = __builtin_bit_cast(bf16x8, vraw[0]), v1 = __builtin_bit_cast(bf16x8, vraw[1]);
#pragma unroll
      for (int i = 0; i < 8; ++i) { *(LAS u16*)(VTs + (wid * 16 + i) * 144 + lane * 2) = (u16)v0[i]; *(LAS u16*)(VTs + (wid * 16 + 8 + i) * 144 + lane * 2) = (u16)v1[i]; } }
    if (ch + 1 < nch) ML_ISSUE(ch + 1);
    __syncthreads();
    { const float wl = wl_s[lane]; const bf16x8 k0 = *(const LAS bf16x8*)(Ks + lane * 272 + wid * 32), k1 = *(const LAS bf16x8*)(Ks + lane * 272 + wid * 32 + 16);
#pragma unroll
      for (int i = 0; i < 8; ++i) { *(LAS u16*)(KTs + (wid * 16 + i) * 144 + lane * 2) = f2bf(bf2f((u16)k0[i]) * wl); *(LAS u16*)(KTs + (wid * 16 + 8 + i) * 144 + lane * 2) = f2bf(bf2f((u16)k1[i]) * wl); } }
    { const int tt = wid & 3, spq = wid >> 2; const int t = tt * 16 + fr; const float gt = g_s[t]; float dsum = 0.f;
      bf16x8 Qf[4];
#pragma unroll
      for (int kk = 0; kk < 4; ++kk) Qf[kk] = *(const LAS bf16x8*)(Qs + t * 272 + (kk * 32 + fq * 8) * 2);
#pragma unroll
      for (int s2 = 0; s2 < 2; ++s2) { const int st = spq * 2 + s2; f32x4 acc = (f32x4){0.f, 0.f, 0.f, 0.f};
        if (st <= tt) {
#pragma unroll
          for (int kk = 0; kk < 4; ++kk) { const bf16x8 Kf = *(const LAS bf16x8*)(Ks + (st * 16 + fr) * 272 + (kk * 32 + fq * 8) * 2); acc = __builtin_amdgcn_mfma_f32_16x16x32_bf16(Kf, Qf[kk], acc, 0, 0, 0); }
        }
        float vv[4];
#pragma unroll
        for (int j = 0; j < 4; ++j) { const int s = st * 16 + fq * 4 + j; const float w = (s <= t) ? __expf(a_s[s] - gt) : 0.f; vv[j] = acc[j] * w; dsum += vv[j]; }
        *(LAS bf16x4*)(Ss + t * 144 + (st * 16 + fq * 4) * 2) = pack4(vv[0], vv[1], vv[2], vv[3]); }
      dsum += __shfl_xor(dsum, 16); dsum += __shfl_xor(dsum, 32);
      if (fq == 0) denp[spq * 64 + t] = dsum; }
    { const int t = tid >> 3, part = tid & 7; const bf16x8 q0 = *(const LAS bf16x8*)(Qs + t * 272 + part * 32), q1 = *(const LAS bf16x8*)(Qs + t * 272 + part * 32 + 16); float s = 0.f;
#pragma unroll
      for (int i = 0; i < 8; ++i) s += nvec[part * 16 + i] * bf2f((u16)q0[i]) + nvec[part * 16 + 8 + i] * bf2f((u16)q1[i]);
      s += __shfl_xor(s, 1); s += __shfl_xor(s, 2); s += __shfl_xor(s, 4);
      if (part == 0) nq_s[t] = s; }
    __syncthreads();
    const float decay = scal[0];
    { const int tt = wid & 3, vh = wid >> 2; const int t = tt * 16 + fr; const float spt = sp_s[t]; const float den = spt * nq_s[t] + denp[t] + denp[64 + t];
      const float rdn = 1.f / fmaxf(fabsf(den), em_s[t]);
      bf16x8 Qf[4], Sf[2];
#pragma unroll
      for (int kk = 0; kk < 4; ++kk) Qf[kk] = *(const LAS bf16x8*)(Qs + t * 272 + (kk * 32 + fq * 8) * 2);
#pragma unroll
      for (int ks = 0; ks < 2; ++ks) Sf[ks] = *(const LAS bf16x8*)(Ss + t * 144 + (ks * 32 + fq * 8) * 2);
      const int gp_ = ch * 64 + t, tok = dir ? T - 1 - gp_ : gp_; u16* hp = p.hdir + ((size_t)dir * NTOK + seqbase + tok) * 512 + h * 128 + fq * 4;
#pragma unroll
      for (int v4 = 0; v4 < 4; ++v4) { const int vt = vh * 4 + v4; f32x4 aS = (f32x4){0.f, 0.f, 0.f, 0.f}, aI = (f32x4){0.f, 0.f, 0.f, 0.f};
#pragma unroll
        for (int kk = 0; kk < 4; ++kk) { const bf16x8 Cf = *(const LAS bf16x8*)(Cs + (vt * 16 + fr) * 272 + (kk * 32 + fq * 8) * 2); aS = __builtin_amdgcn_mfma_f32_16x16x32_bf16(Cf, Qf[kk], aS, 0, 0, 0); }
#pragma unroll
        for (int ks = 0; ks < 2; ++ks) { const bf16x8 Vf = *(const LAS bf16x8*)(VTs + (vt * 16 + fr) * 144 + (ks * 32 + fq * 8) * 2); aI = __builtin_amdgcn_mfma_f32_16x16x32_bf16(Vf, Sf[ks], aI, 0, 0, 0); }
        const bf16x4 hv = pack4((spt * aS[0] + aI[0]) * rdn, (spt * aS[1] + aI[1]) * rdn, (spt * aS[2] + aI[2]) * rdn, (spt * aS[3] + aI[3]) * rdn);
        __hip_atomic_store((unsigned long long*)(hp + vt * 16), __builtin_bit_cast(unsigned long long, hv), __ATOMIC_RELAXED, __HIP_MEMORY_SCOPE_AGENT); } }
    float nsum = 0.f;
    { bf16x8 Vf[2];
#pragma unroll
      for (int ks = 0; ks < 2; ++ks) Vf[ks] = *(const LAS bf16x8*)(VTs + (wid * 16 + fr) * 144 + (ks * 32 + fq * 8) * 2);
#pragma unroll
      for (int kt = 0; kt < 8; ++kt) { accC[kt] *= decay;
#pragma unroll
        for (int ks = 0; ks < 2; ++ks) { const bf16x8 Kf = *(const LAS bf16x8*)(KTs + (kt * 16 + fr) * 144 + (ks * 32 + fq * 8) * 2); accC[kt] = __builtin_amdgcn_mfma_f32_16x16x32_bf16(Kf, Vf[ks], accC[kt], 0, 0, 0); } }
      if (tid < 128) {
#pragma unroll
        for (int q = 0; q < 8; ++q) { const bf16x8 kv = *(const LAS bf16x8*)(KTs + tid * 144 + q * 16);
#pragma unroll
          for (int i = 0; i < 8; ++i) nsum += bf2f((u16)kv[i]); } } }
    mst = scal[1];
    __syncthreads();
#pragma unroll
    for (int kt = 0; kt < 8; ++kt) *(LAS bf16x4*)(Cs + (wid * 16 + fr) * 272 + (kt * 16 + fq * 4) * 2) = pack4(accC[kt][0], accC[kt][1], accC[kt][2], accC[kt][3]);
    if (tid < 128) nvec[tid] = decay * nvec[tid] + nsum;
  }
#undef ML_ISSUE
  if (!lat) {
    float* cpb = p.out + O_SC + sidx * 16384; const unsigned coff = (unsigned)((wid * 16 + fr) * 128 + fq * 4);
#pragma unroll
    for (int kt = 0; kt < 8; ++kt) *(f32x4*)(cpb + (coff + kt * 16)) = accC[kt];
    __syncthreads();
    if (tid < 128) p.out[O_SN + sidx * 128 + tid] = nvec[tid];
    if (tid == 0) p.out[O_SM + sidx] = mst;
  }
  asm volatile("s_waitcnt vmcnt(0)" ::: "memory");
  __syncthreads();
  LAS unsigned* flag = (LAS unsigned*)(fl + 644);
  if (tid == 0) *flag = __hip_atomic_fetch_add(p.ctr + XB_MCNT + l * 144 + (lat ? 32 + b : b) * 4 + h, 1u, __ATOMIC_RELAXED, __HIP_MEMORY_SCOPE_AGENT);
  __syncthreads();
  if (*flag == 1u) {
    const int rsub = tid >> 4, cq = tid & 15; const float* g = p.g_mlstm + l * 128 + cq * 8;
    for (int r0 = 0; r0 < T; r0 += 32) {
      const size_t row = (size_t)(seqbase + r0 + rsub); const int c = h * 128 + cq * 8;
      const unsigned long long* pf = (const unsigned long long*)(p.hdir + row * 512 + c); const unsigned long long* pb = (const unsigned long long*)(p.hdir + ((size_t)NTOK + row) * 512 + c);
      unsigned long long f0 = __hip_atomic_load(pf, __ATOMIC_RELAXED, __HIP_MEMORY_SCOPE_AGENT), f1 = __hip_atomic_load(pf + 1, __ATOMIC_RELAXED, __HIP_MEMORY_SCOPE_AGENT);
      unsigned long long b0 = __hip_atomic_load(pb, __ATOMIC_RELAXED, __HIP_MEMORY_SCOPE_AGENT), b1 = __hip_atomic_load(pb + 1, __ATOMIC_RELAXED, __HIP_MEMORY_SCOPE_AGENT);
      const bf16x8 mo = *(const bf16x8*)(p.zA + row * ZLD + 3072 + c);
      const bf16x4 hf0 = __builtin_bit_cast(bf16x4, f0), hf1 = __builtin_bit_cast(bf16x4, f1), hb0 = __builtin_bit_cast(bf16x4, b0), hb1 = __builtin_bit_cast(bf16x4, b1);
      float s[8], ss = 0.f;
#pragma unroll
      for (int i = 0; i < 4; ++i) { s[i] = bf2f((u16)hf0[i]) + bf2f((u16)hb0[i]); s[i + 4] = bf2f((u16)hf1[i]) + bf2f((u16)hb1[i]); }
#pragma unroll
      for (int i = 0; i < 8; ++i) ss += s[i] * s[i];
      ss += __shfl_xor(ss, 1); ss += __shfl_xor(ss, 2); ss += __shfl_xor(ss, 4); ss += __shfl_xor(ss, 8);
      const float rstd = rsqrtf(ss * (1.f / 128.f) + EPS);
      f32x4 o0, o1;
#pragma unroll
      for (int i = 0; i < 4; ++i) { o0[i] = s[i] * rstd * g[i] * bf2f((u16)mo[i]); o1[i] = s[i + 4] * rstd * g[i + 4] * bf2f((u16)mo[i + 4]); }
      *(bf16x8*)(p.brin + ((size_t)2 * NTOK + row) * 512 + c) = pack8(o0, o1);
    }
  }
}

__device__ void mixers_phase(const Params& p, int ci, int l, LAS unsigned char* lds, int mask = 7) {
  __shared__ int s_item;
  const int tid = tid_opaque();
  for (;;) {
    __syncthreads();
    if (tid == 0) s_item = (int)atomicAdd(p.ctr + XB_CTR + ci, 1u);
    __syncthreads();
    const int item = s_item;
    if (item >= 768) break;
    const int ty = (item < 32 || (item >= 192 && item < 256)) ? 4 : ((item < 64 || (item >= 256 && item < 512)) ? 1 : 2);
    if (!(mask & ty)) continue;
    if (ty == 4) {
      OneSched S; int ld; float scale;
      if (item < 32) { const int b = item >> 3, mt = (item >> 1) & 3, nt = item & 1; ld = 2048; scale = 1.f / sqrtf(1024.f * 128.f);
        S.u.A = (const char*)(p.cs1024 + (size_t)mt * 256 * 2048); S.u.B = (const char*)(p.Yt + (size_t)32 * 512 * 512 + (size_t)b * 512 * 2048 + (size_t)nt * 256 * 2048);
        S.u.pm = NCTX + b * 1024 + mt * 256; S.u.pn = nt; S.u.aux = 0; }
      else { const int i2 = item - 192, b = i2 >> 1, nt = i2 & 1; ld = 512; scale = 1.f / sqrtf(256.f * 128.f);
        S.u.A = (const char*)p.cs256; S.u.B = (const char*)(p.Yt + (size_t)b * 512 * 512 + (size_t)nt * 256 * 512);
        S.u.pm = b * 256; S.u.pn = nt; S.u.aux = 0; }
      EpiFour E{p.brin + (size_t)NTOK * 512, scale};
      gemm_phase<4>(lds, ld, ld, ld, S, E);
    } else if (ty == 1) mlstm_item(p, l, item < 64 ? item - 32 : 32 + (item - 256), lds);
    else attn_item(p, l, item < 192 ? item - 64 : 128 + (item - 512), lds);
  }
}

__device__ void mpost_phase(const Params& p, int l) {
  const int tid = tid_opaque(), wid = tid >> 6, lane = tid & 63;
  for (int row = blockIdx.x * 8 + wid; row < NTOK; row += gridDim.x * 8) {
    const bf16x8 hf = *(const bf16x8*)(p.hdir + (size_t)row * 512 + lane * 8), hb = *(const bf16x8*)(p.hdir + ((size_t)NTOK + row) * 512 + lane * 8);
    const bf16x8 mo = *(const bf16x8*)(p.zA + (size_t)row * ZLD + 3072 + lane * 8);
    float s[8], ss = 0.f;
#pragma unroll
    for (int i = 0; i < 8; ++i) { s[i] = bf2f((u16)hf[i]) + bf2f((u16)hb[i]); ss += s[i] * s[i]; }
    ss += __shfl_xor(ss, 1); ss += __shfl_xor(ss, 2); ss += __shfl_xor(ss, 4); ss += __shfl_xor(ss, 8);
    const float rstd = rsqrtf(ss * (1.f / 128.f) + EPS); const float* g = p.g_mlstm + l * 128 + (lane & 15) * 8; bf16x8 o;
#pragma unroll
    for (int i = 0; i < 8; ++i) o[i] = (short)f2bf(s[i] * rstd * g[i] * bf2f((u16)mo[i]));
    *(bf16x8*)(p.brin + ((size_t)2 * NTOK + row) * 512 + lane * 8) = o;
  }
}

__global__ void __launch_bounds__(512) fwd_megakernel(Params p_) {
  const Params& p = *(const Params*)(const __attribute__((address_space(4))) void*)__builtin_amdgcn_kernarg_segment_ptr();
  extern __shared__ __attribute__((aligned(16))) unsigned char shm_[];
  LAS unsigned char* lds = (LAS unsigned char*)shm_;
  cg::grid_group grid = cg::this_grid();
  const int G = gridDim.x, c = blockIdx.x;
  __shared__ uint4 xb_words; __shared__ int s_segdone[4];
  if (threadIdx.x == 0) xb_words = make_uint4(0u, 0u, 0u, 0u);
  if (threadIdx.x < 4) s_segdone[threadIdx.x] = 0;
  __syncthreads();
  const XcdBarrier xb = xcd_barrier_post(p.ctr, (volatile LAS unsigned*)&xb_words);
#define GSYNC() xcd_barrier(xb)
  if (p.out == nullptr) grid.sync();
  for (int ph = 0; ph < 25; ++ph) {
    const int l = ph == 0 ? 0 : (ph - 1) / 12, kind = ph == 0 ? -1 : (ph - 1) - l * 12;
    if (kind == 3 || kind == 9 || kind == 6 || (kind == 0 && l == 1)) continue;
    const float* md = p.mods + (size_t)l * 5 * 9216;
    int hl = -1, hs = 0;
    if (kind == -1) { phase0(p, lds); hl = 0; hs = 0; }
    else if (kind == 0) norm_phase(p, 0, 0, lds);
    else if (kind == 1 || kind == 10) {
      TileSched S{p.u, kind == 1 ? p.wt_ffn1_in : p.wt_ffn2_in, D, D, 48, 22, G, c, 256}; EpiSwiglu E{p.zA}; gemm_phase<4>(lds, D, D, D, S, E);
      if (kind == 1) { hl = l; hs = 1; } else if (l == 0) { hl = 1; hs = 0; }
    } else if (kind == 2 || kind == 11 || kind == 8) {
      const bool isout = kind == 8; const int Kd = isout ? D : DFF;
      TileSched S{isout ? p.hdir : p.zA, isout ? p.wt_out : (kind == 2 ? p.wt_ffn1_out : p.wt_ffn2_out), Kd, Kd, 64, 4, G, c, 192};
      EpiResidNorm E{p, l, kind};
      gemm_phase<3>(lds, Kd, Kd, Kd, S, E);
      if (kind == 2) { hl = l; hs = 1; } else if (l == 0) { hl = 1; hs = 0; }
    } else if (kind == 4) { TileSched S{p.u, p.wt_big, D, D, 48, 31, G, c, 256}; EpiBig E{p.zA, p.gb, p.Yt, p.out, l, p.gate, p.b_mgate}; gemm_phase<4>(lds, D, D, D, S, E); }
    else if (kind == 5) mixers_phase(p, l, l, lds);
    else if (kind == 6) mpost_phase(p, l);
    else { BranchSched S{p.brin, p.wt_br, G, c}; EpiBranch E{p.zA, p.gb, p.hdir}; gemm_phase<3>(lds, 512, 512, 512, S, E); if (l == 0) { hl = 1; hs = 0; } }
    if (hl >= 0) prep_seg(p, hl, hs, lds, (volatile LAS int*)s_segdone);
    GSYNC();
  }
}


extern "C" void kernel_launch(void* const* d_in, const int* in_sizes, int n_in, void* d_out, int out_size, void* d_ws, size_t ws_size, hipStream_t stream) {
  static int grid_blocks = 0;
  if (!grid_blocks) {
    int dev = 0, cus = 0, per_cu = 0;
    hipGetDevice(&dev);
    hipDeviceGetAttribute(&cus, hipDeviceAttributeMultiprocessorCount, dev);
    hipFuncSetAttribute((const void*)fwd_megakernel, hipFuncAttributeMaxDynamicSharedMemorySize, LDS_BYTES);
    hipOccupancyMaxActiveBlocksPerMultiprocessor(&per_cu, (const void*)fwd_megakernel, 512, LDS_BYTES);
    if (per_cu < 1) per_cu = 1;
    grid_blocks = cus * 1;
    (void)hipGetLastError();
  }
  Params p{};
  const float** ip = (const float**)&p;
  for (int i = 0; i < 27; ++i) ip[i] = (const float*)d_in[i];
  p.out = (float*)d_out;
  char* w = (char*)d_ws; size_t off = 0;
  auto take = [&](size_t bytes) { char* r = w + off; off += (bytes + 255) & ~(size_t)255; return r; };
  p.wt_ffn1_in = (u16*)take((size_t)2 * DFF * D * 2); p.wt_ffn1_out = (u16*)take((size_t)D * DFF * 2);
  p.wt_ffn2_in = (u16*)take((size_t)2 * DFF * D * 2); p.wt_ffn2_out = (u16*)take((size_t)D * DFF * 2);
  p.wt_big = (u16*)take((size_t)NBIG * D * 2); p.wt_br = (u16*)take((size_t)3 * D * 512 * 2); p.wt_out = (u16*)take((size_t)D * D * 2);
  p.u = (u16*)take((size_t)NTOK * D * 2);
  p.zA = (u16*)take((size_t)NTOK * ZLD * 2); p.gb = (u16*)take((size_t)NTOK * GBLD * 2);
  p.Yt = (u16*)take((size_t)NTOK * 1024 * 2); p.brin = (u16*)take((size_t)3 * NTOK * 512 * 2); p.hdir = (u16*)take((size_t)2 * NTOK * 512 * 2);
  p.cs1024 = (u16*)take((size_t)1024 * 2048 * 2); p.cs256 = (u16*)take((size_t)256 * 512 * 2);
  p.mods = (float*)take((size_t)2 * 5 * 9216 * 4); p.gate = (float*)take((size_t)NTOK * 16 * 4); p.rope = (float*)take((size_t)1024 * 32 * 2 * 4);
  p.lam = (float*)take(256); p.part = (float*)take((size_t)6 * 48 * 4 * 256 * 4); p.ctr = (unsigned*)take(BAR_TOTAL_WORDS * 4);
  if (off > ws_size) { fprintf(stderr, "kernel_launch: workspace too small: need %zu have %zu\n", off, ws_size); return; }
  if (hipMemsetAsync(p.ctr, 0, BAR_TOTAL_WORDS * 4, stream) != hipSuccess) { fprintf(stderr, "memset failed\n"); return; }
  void* args[] = {&p};
  hipError_t e = hipLaunchCooperativeKernel((const void*)fwd_megakernel, dim3(grid_blocks), dim3(512), args, LDS_BYTES, stream);
  if (e != hipSuccess) fprintf(stderr, "cooperative launch failed: %s (grid %d)\n", hipGetErrorString(e), grid_blocks);
}
```

```cpp
#include <hip/hip_runtime.h>
#include <hip/hip_cooperative_groups.h>
#include <cstdio>
namespace cg = cooperative_groups;

typedef unsigned short u16;
typedef short bf16x8 __attribute__((ext_vector_type(8)));
typedef short bf16x4 __attribute__((ext_vector_type(4)));
typedef float f32x4 __attribute__((ext_vector_type(4)));
#define LAS __attribute__((address_space(3)))

constexpr int D = 1024, NTOK = 12288, NCTX = 8192, DFF = 2816, PIN = 4112, NBIG = 7936, ZLD = 3584, GBLD = 3072;
constexpr int LDS_BYTES = 131072;
#ifndef PROBE
#define PROBE 0
#endif
constexpr float EPS = 1e-6f;
constexpr size_t O_Y = 0, O_CK = 12582912, O_CV = 20971520, O_SC = 29360128, O_SN = 37748736, O_SM = 37814272;

struct Params {
  const float *x_prompt, *x_sample, *cache_k, *cache_v, *state_C, *state_n, *state_m, *c, *c_ctx, *w_ada, *b_ada, *g_norm,
      *w_ffn1_in, *w_ffn1_out, *w_ffn2_in, *w_ffn2_out, *w_in, *b_mgate, *attn_lambda, *g_attn_sub, *g_mlstm, *w_branch_gate,
      *w_br_attn, *w_br_four, *w_br_mlstm, *w_out, *g_final;
  float* out;
  u16 *wt_ffn1_in, *wt_ffn1_out, *wt_ffn2_in, *wt_ffn2_out, *wt_big, *wt_br, *wt_out;
  u16 *u, *zA, *gb, *Yt, *brin, *hdir, *cs1024, *cs256;
  float *mods, *gate, *rope, *lam, *part;
  unsigned* ctr;
};

typedef float f32x2_ __attribute__((ext_vector_type(2)));
typedef __bf16 bf16v2_ __attribute__((ext_vector_type(2)));
__device__ __forceinline__ unsigned cvt_pk_bf16(float lo, float hi) { f32x2_ v = {lo, hi}; bf16v2_ r = __builtin_convertvector(v, bf16v2_); return __builtin_bit_cast(unsigned, r); }
__device__ __forceinline__ u16 f2bf(float f) { return (u16)cvt_pk_bf16(f, 0.f); }
typedef unsigned u32x4 __attribute__((ext_vector_type(4)));
typedef unsigned u32x2 __attribute__((ext_vector_type(2)));
__device__ __forceinline__ float bf2f(u16 h) { return __uint_as_float(((unsigned)h) << 16); }
__device__ __forceinline__ int tid_opaque() { int t = threadIdx.x; asm volatile("" : "+v"(t)); return t; }
__device__ __forceinline__ float sigmoidf_(float x) { return __builtin_amdgcn_rcpf(1.f + __builtin_amdgcn_exp2f(-1.4426950408889634f * x)); }
__device__ __forceinline__ int cond_of(int row) { return row < NCTX ? 0 : 1 + ((row - NCTX) >> 10); }
__device__ __forceinline__ float lam_init_of(int l) { return l == 0 ? 0.2f : (0.8f - 0.6f * 0.74081822068f); }


#define XB_TMO      128
#define XB_XCNT(j)  (256  + 64 * (j))
#define XB_XSUB(j)  (1280 + 64 * (j))
#define XB_XGEN(j)  (2304 + 64 * (j))
#define XB_TOP      3328
#define XB_TOPGEN   3392
#define XCD_BAR_WORDS 3456
#define XB_CTR      3520
#define XB_PCNT     3584
#define XB_MCNT     3968
#define BAR_TOTAL_WORDS 4352
#define XB_SPIN_CAP (1u << 18)
__device__ __forceinline__ unsigned xb_ld(unsigned* p)              { return __hip_atomic_load(p, __ATOMIC_RELAXED, __HIP_MEMORY_SCOPE_AGENT); }
__device__ __forceinline__ unsigned xb_add(unsigned* p, unsigned v) { return __hip_atomic_fetch_add(p, v, __ATOMIC_RELAXED, __HIP_MEMORY_SCOPE_AGENT); }
__device__ __forceinline__ unsigned xb_xcc_id() { return (unsigned)__builtin_amdgcn_s_getreg((3 << 11) | 20) & 0xFu; }
#define XB_SPIN(cond, bar) do { unsigned _sp = 0; while (cond) { __builtin_amdgcn_s_sleep(1); \
    if ((++_sp & 255u) == 0u) { if (xb_ld(&(bar)[XB_TMO])) break; if (_sp > XB_SPIN_CAP) { atomicAdd(&(bar)[XB_TMO], 1u); break; } } } } while (0)
struct XcdBarrier { unsigned* bar; unsigned x; volatile LAS unsigned* st; };
__device__ __forceinline__ XcdBarrier xcd_barrier_post(unsigned* bar, volatile LAS unsigned* st) {
  XcdBarrier b; b.bar = bar; b.x = xb_xcc_id(); b.st = st;
  if (threadIdx.x == 0) (void)xb_add(&bar[XB_XCNT(b.x)], 1u);
  return b;
}
__device__ __forceinline__ void xcd_barrier_complete(unsigned* bar, unsigned x, unsigned& nloc, unsigned& nx) {
  const unsigned G = gridDim.x * gridDim.y * gridDim.z;
  unsigned sum, cnt, mine, sp = 0u;
  for (;;) {
    sum = 0u; cnt = 0u; mine = 0u;
#pragma unroll
    for (unsigned j = 0; j < 16; ++j) { const unsigned c = xb_ld(&bar[XB_XCNT(j)]); sum += c; cnt += (c > 0u) ? 1u : 0u; mine = (j == x) ? c : mine; }
    if (sum == G) break;
    __builtin_amdgcn_s_sleep(1);
    if ((++sp & 255u) == 0u) { if (xb_ld(&bar[XB_TMO])) break; if (sp > XB_SPIN_CAP) { atomicAdd(&bar[XB_TMO], 1u); break; } }
  }
  nloc = mine > 0u ? mine : 1u; nx = cnt > 0u ? cnt : 1u;
}
__device__ __forceinline__ void xcd_barrier(const XcdBarrier& b) {
  asm volatile("s_waitcnt vmcnt(0)" ::: "memory");
  __syncthreads();
  if (threadIdx.x == 0) {
    unsigned* bar = b.bar;
    __builtin_amdgcn_s_waitcnt(0);
    unsigned nloc = b.st[0], nx = b.st[1];
    if (nloc == 0u) { xcd_barrier_complete(bar, b.x, nloc, nx); b.st[0] = nloc; b.st[1] = nx; }
    const unsigned old = xb_add(&bar[XB_XSUB(b.x)], 1u);
    const unsigned gen = old / nloc;
    if (old + 1u == (gen + 1u) * nloc) {
      __builtin_amdgcn_fence(__ATOMIC_RELEASE, "agent");
      asm volatile("s_waitcnt vmcnt(0)" ::: "memory");
      const unsigned og = xb_add(&bar[XB_TOP], 1u);
      const unsigned tg = og / nx;
      if (og + 1u == (tg + 1u) * nx) xb_add(&bar[XB_TOPGEN], 1u);
      else XB_SPIN(xb_ld(&bar[XB_TOPGEN]) == tg, bar);
      __builtin_amdgcn_fence(__ATOMIC_ACQUIRE, "agent");
      xb_add(&bar[XB_XGEN(b.x)], 1u);
      asm volatile("s_waitcnt vmcnt(0)" ::: "memory");
    } else {
      XB_SPIN(xb_ld(&bar[XB_XGEN(b.x)]) == gen, bar);
      __builtin_amdgcn_fence(__ATOMIC_ACQUIRE, "agent");
      asm volatile("s_waitcnt vmcnt(0)" ::: "memory");
    }
  }
  __syncthreads();
}

constexpr int BM = 256, BK = 64, HALF = 128, HTB = HALF * BK * 2;
__device__ __forceinline__ int lds_byte(int r, int c) { const int st = (r >> 4) * 2 + (c >> 5), rr = r & 15, cc = c & 31, ob = rr * 64 + cc * 2; return st * 1024 + (ob ^ (((ob >> 9) & 1) << 5)); }
__device__ __forceinline__ void stage_rc(int b, int& R, int& C) { const int st = b / 1024, sb = b % 1024, swz = sb ^ (((sb >> 9) & 1) << 5); R = (st >> 1) * 16 + swz / 64; C = (st & 1) * 32 + (swz % 64) / 2; }
__device__ __forceinline__ int perm32(int rho) { const int n = rho >> 4, i = rho & 15; return 8 * (i >> 2) + 4 * n + (i & 3); }

struct GUnit { const char* A; const char* B; int pm, pn, aux; };

__device__ __forceinline__ bool tile_order(int L, int nM, int nN, int& pm, int& pn) {
  const int nwg = nM * nN; if (L >= nwg) return false;
  int wgid = L; { const int q = nwg / 8, r = nwg % 8, xcd = wgid % 8, off = wgid / 8; wgid = (xcd < r ? xcd * (q + 1) : r * (q + 1) + (xcd - r) * q) + off; }
  const int nig = 8 * nN, gid = wgid / nig, fm = gid * 8, gsz = (nM - fm) < 8 ? (nM - fm) : 8;
  pm = fm + ((wgid % nig) % gsz); pn = (wgid % nig) / gsz; return true;
}

template <int MT, class Sched, class Epi>
__device__ __forceinline__ void gemm_phase(LAS unsigned char* lds, const int lda, const int ldb, const int K, const Sched& S, const Epi& E) {
  const int tid = tid_opaque(), wid = __builtin_amdgcn_readfirstlane(tid >> 6), lane = tid & 63, wr = wid >> 2, wc = wid & 3, fr = lane & 15, fq = lane >> 4;
  const int nt = K / BK;
  unsigned voffA[2], voffB[2];
#pragma unroll
  for (int i = 0; i < 2; ++i) { int R, C; stage_rc(tid * 16 + i * 8192, R, C); const int Rb = (R & ~31) + perm32(R & 31);
    voffA[i] = (unsigned)(R * lda + C) * 2u; voffB[i] = (unsigned)(Rb * ldb + C) * 2u; }
  const size_t kstep = (size_t)(BK * 2);
  const size_t hstepA = (size_t)(MT * 32) * lda * 2, hstepB = (size_t)HALF * ldb * 2;
  const unsigned ldsw = (unsigned)wid * 1024u;
  const int aoff = lds_byte(wr * (MT * 16) + fr, fq * 8), boff = lds_byte(wc * 32 + fr, fq * 8);
#define PG8_SA(b, h) (((b) * 2 + (h)) * HTB)
#define PG8_SB(b, h) ((4 + (b) * 2 + (h)) * HTB)
#define PG8_STAGE(bufoff, gbase, voff) do { _Pragma("unroll") for (int _i = 0; _i < 2; ++_i) \
    __builtin_amdgcn_global_load_lds((const unsigned*)((const char*)(gbase) + (voff)[_i]), (LAS unsigned*)(lds + (bufoff) + ldsw + _i * 8192), 16, 0, 0); } while (0)
#define PG8_STAGEA(bufoff, gbase, voff) do { _Pragma("unroll") for (int _i = 0; _i < 2; ++_i) if (MT == 4 || _i == 0 || wid < 4) \
    __builtin_amdgcn_global_load_lds((const unsigned*)((const char*)(gbase) + (voff)[_i]), (LAS unsigned*)(lds + (bufoff) + ldsw + _i * 8192), 16, 0, 0); } while (0)
#define PG8_LDA(dst, b, h) do { _Pragma("unroll") for (int m = 0; m < MT; ++m) _Pragma("unroll") for (int k = 0; k < 2; ++k) dst[m][k] = *(const LAS bf16x8*)(lds + PG8_SA(b, h) + aoff + m * 2048 + k * 1024); } while (0)
#define PG8_LDB(dst, b, h) do { _Pragma("unroll") for (int n = 0; n < 2; ++n) _Pragma("unroll") for (int k = 0; k < 2; ++k) dst[n][k] = *(const LAS bf16x8*)(lds + PG8_SB(b, h) + boff + n * 2048 + k * 1024); } while (0)
#define PG8_MMA(ai, bj, At, Bt) do { __builtin_amdgcn_s_setprio(1); _Pragma("unroll") for (int m = 0; m < MT; ++m) _Pragma("unroll") for (int n = 0; n < 2; ++n) _Pragma("unroll") for (int k = 0; k < 2; ++k) \
    acc[ai][bj][m][n] = __builtin_amdgcn_mfma_f32_16x16x32_bf16(Bt[n][k], At[m][k], acc[ai][bj][m][n], 0, 0, 0); __builtin_amdgcn_s_setprio(0); } while (0)
#define PG8_WAIT_V(n) asm volatile("s_waitcnt vmcnt(" #n ")" ::: "memory")
#define PG8_WAIT_L(n) asm volatile("s_waitcnt lgkmcnt(" #n ")" ::: "memory")
#define PG8_WAIT_VA do { if constexpr (MT == 4) asm volatile("s_waitcnt vmcnt(4)" ::: "memory"); else asm volatile("s_waitcnt vmcnt(3)" ::: "memory"); } while (0)
#define PG8_WAIT_VB do { if constexpr (MT == 4) asm volatile("s_waitcnt vmcnt(6)" ::: "memory"); else asm volatile("s_waitcnt vmcnt(5)" ::: "memory"); } while (0)
#define PG8_WAIT_LB do { if constexpr (MT == 4) asm volatile("s_waitcnt lgkmcnt(8)" ::: "memory"); else asm volatile("s_waitcnt lgkmcnt(6)" ::: "memory"); } while (0)
#define PG8_BAR __builtin_amdgcn_s_barrier()
#define PG8_SCHED __builtin_amdgcn_sched_barrier(0)
  GUnit cur, nxt; int ui = 0;
  if (!S.next(0, cur)) return;
  f32x4 acc[2][2][MT][2];
#pragma unroll
  for (int a = 0; a < 2; ++a)
#pragma unroll
    for (int b = 0; b < 2; ++b)
#pragma unroll
      for (int m = 0; m < MT; ++m)
#pragma unroll
        for (int n = 0; n < 2; ++n) acc[a][b][m][n] = (f32x4){0.f, 0.f, 0.f, 0.f};
  bf16x8 At[MT][2], B0[2][2], B1[2][2];
  const char* cA = cur.A; const char* cB = cur.B;
  PG8_STAGE(PG8_SB(0, 0), cB, voffB); PG8_STAGEA(PG8_SA(0, 0), cA, voffA); PG8_STAGE(PG8_SB(0, 1), cB + hstepB, voffB); PG8_STAGEA(PG8_SA(0, 1), cA + hstepA, voffA);
  if (wr == 1) PG8_BAR;
  PG8_WAIT_VA; PG8_BAR;
  PG8_STAGE(PG8_SB(1, 0), cB + kstep, voffB); PG8_STAGEA(PG8_SA(1, 0), cA + kstep, voffA); PG8_STAGE(PG8_SB(1, 1), cB + hstepB + kstep, voffB);
  PG8_WAIT_VB; PG8_BAR;
  for (;;) {
    const bool has_next = S.next(ui + 1, nxt);
    const char* nA = has_next ? nxt.A : cA; const char* nB = has_next ? nxt.B : cB;
    for (int t = 0; t < nt; t += 2) {
      const bool last = (t == nt - 2);
      const char* a1 = cA + (size_t)(t + 1) * kstep;
      const char* a2 = last ? nA : cA + (size_t)(t + 2) * kstep; const char* b2 = last ? nB : cB + (size_t)(t + 2) * kstep;
      const char* a3 = a2 + kstep; const char* b3 = b2 + kstep;
      PG8_LDB(B0, 0, 0); PG8_SCHED; PG8_LDA(At, 0, 0); PG8_STAGEA(PG8_SA(1, 1), a1 + hstepA, voffA);
      PG8_WAIT_LB; PG8_BAR; PG8_WAIT_L(0); PG8_MMA(0, 0, At, B0); PG8_BAR; PG8_SCHED;
      PG8_LDB(B1, 0, 1); PG8_STAGE(PG8_SB(0, 0), b2, voffB);
      PG8_BAR; PG8_WAIT_L(0); PG8_MMA(0, 1, At, B1); PG8_BAR;
      PG8_LDA(At, 0, 1); PG8_STAGEA(PG8_SA(0, 0), a2, voffA);
      PG8_BAR; PG8_WAIT_L(0); PG8_MMA(1, 0, At, B0); PG8_BAR; PG8_SCHED;
      PG8_STAGE(PG8_SB(0, 1), b2 + hstepB, voffB);
      PG8_WAIT_VB; PG8_BAR; PG8_MMA(1, 1, At, B1); PG8_BAR;
      PG8_LDB(B0, 1, 0); PG8_SCHED; PG8_LDA(At, 1, 0); PG8_STAGEA(PG8_SA(0, 1), a2 + hstepA, voffA);
      PG8_WAIT_LB; PG8_BAR; PG8_WAIT_L(0); PG8_MMA(0, 0, At, B0); PG8_BAR; PG8_SCHED;
      PG8_LDB(B1, 1, 1); PG8_STAGE(PG8_SB(1, 0), b3, voffB);
      PG8_BAR; PG8_WAIT_L(0); PG8_MMA(0, 1, At, B1); PG8_BAR;
      PG8_LDA(At, 1, 1); PG8_STAGEA(PG8_SA(1, 0), a3, voffA);
      PG8_BAR; PG8_WAIT_L(0); PG8_MMA(1, 0, At, B0); PG8_BAR; PG8_SCHED;
      PG8_STAGE(PG8_SB(1, 1), b3 + hstepB, voffB);
      PG8_WAIT_VB; PG8_BAR; PG8_MMA(1, 1, At, B1); PG8_BAR;
    }
    if constexpr (!Epi::AFTER_DRAIN) E(acc, cur, wr, wc, fr, fq);
    if (!has_next) break;
#pragma unroll
    for (int a = 0; a < 2; ++a)
#pragma unroll
      for (int b = 0; b < 2; ++b)
#pragma unroll
        for (int m = 0; m < MT; ++m)
#pragma unroll
          for (int n = 0; n < 2; ++n) acc[a][b][m][n] = (f32x4){0.f, 0.f, 0.f, 0.f};
    cur = nxt; cA = nA; cB = nB; ++ui;
  }
  PG8_WAIT_V(0);
  if (wr == 0) PG8_BAR;
  PG8_BAR;
  if constexpr (Epi::AFTER_DRAIN) E.fused(acc, cur, wr, wc, fr, fq, lds);
#undef PG8_SA
#undef PG8_SB
#undef PG8_STAGE
#undef PG8_STAGEA
#undef PG8_WAIT_VA
#undef PG8_WAIT_VB
#undef PG8_WAIT_LB
#undef PG8_LDA
#undef PG8_LDB
#undef PG8_MMA
#undef PG8_WAIT_V
#undef PG8_WAIT_L
#undef PG8_BAR
#undef PG8_SCHED
}

struct TileSched {
  const u16* A; const u16* B; int lda, ldb, nM, nN, G, c, bm;
  __device__ __forceinline__ bool next(int i, GUnit& u) const {
    int pm, pn; if (!tile_order(i * G + c, nM, nN, pm, pn)) return false;
    u.pm = pm; u.pn = pn; u.aux = 0; u.A = (const char*)(A + (size_t)pm * bm * lda); u.B = (const char*)(B + (size_t)pn * BM * ldb); return true;
  }
};
struct BranchSched {
  const u16* brin; const u16* wbr; int G, c;
  __device__ __forceinline__ bool next(int i, GUnit& u) const {
    int pm, pn; const int ti = i / 3, br = i - ti * 3; if (!tile_order(ti * G + c, 64, 4, pm, pn)) return false;
    u.pm = pm; u.pn = pn; u.aux = br; u.A = (const char*)(brin + (size_t)br * NTOK * 512 + (size_t)pm * 192 * 512); u.B = (const char*)(wbr + (size_t)br * D * 512 + (size_t)pn * BM * 512); return true;
  }
};
struct OneSched { GUnit u; __device__ __forceinline__ bool next(int i, GUnit& o) const { if (i != 0) return false; o = u; return true; } };

__device__ __forceinline__ bf16x8 pack8(const f32x4& a, const f32x4& b) {
  u32x4 o; o[0] = cvt_pk_bf16(a[0], a[1]); o[1] = cvt_pk_bf16(a[2], a[3]); o[2] = cvt_pk_bf16(b[0], b[1]); o[3] = cvt_pk_bf16(b[2], b[3]); return __builtin_bit_cast(bf16x8, o);
}
__device__ __forceinline__ bf16x4 pack4(float a, float b, float c, float d) { u32x2 o; o[0] = cvt_pk_bf16(a, b); o[1] = cvt_pk_bf16(c, d); return __builtin_bit_cast(bf16x4, o); }

struct EpiSwiglu {
  static constexpr bool AFTER_DRAIN = false;
  u16* h;
  __device__ __forceinline__ void operator()(const f32x4 (&acc)[2][2][4][2], const GUnit& u, int wr, int wc, int fr, int fq) const {
    const int row0 = u.pm * BM + wr * 64 + fr, col0 = u.pn * 128 + wc * 32 + fq * 8;
#pragma unroll
    for (int ai = 0; ai < 2; ++ai)
#pragma unroll
      for (int m = 0; m < 4; ++m) {
        f32x4 r[2];
#pragma unroll
        for (int n = 0; n < 2; ++n)
#pragma unroll
          for (int j = 0; j < 4; ++j) { const float a = acc[ai][0][m][n][j], g = acc[ai][1][m][n][j]; r[n][j] = a * sigmoidf_(a) * g; }
        *(bf16x8*)(h + (size_t)(row0 + ai * HALF + m * 16) * DFF + col0) = pack8(r[0], r[1]);
      }
  }
};
struct EpiResidNorm {
  static constexpr bool AFTER_DRAIN = true;
  const Params& p; int l, kind;
  __device__ __forceinline__ void fused(f32x4 (&acc)[2][2][3][2], const GUnit& un, int wr, int wc, int fr, int fq, LAS unsigned char* lds) const {
    const bool isout = kind == 8, fin = (kind == 11 && l == 1), firstres = (l == 0 && kind == 2);
    const int use = l * 3 + (kind == 2 ? 0 : (isout ? 1 : 2)), nk = kind == 2 ? 1 : (isout ? 2 : 0), nl = kind == 11 ? l + 1 : l;
    float* x = p.out; const float* xc = firstres ? p.x_prompt : p.out; const float* xl = firstres ? p.x_sample : p.out + (size_t)NCTX * D;
    const float* gatev = p.mods + (size_t)l * 5 * 9216 + (isout ? 5 : (kind == 2 ? 2 : 8)) * 1024; const float coef = isout ? 1.0f : 0.5f;
    u16* u = p.u; const float* gn = fin ? p.g_final : p.g_norm + ((size_t)nl * 3 + nk) * D; const float* mdn = fin ? p.mods : p.mods + (size_t)nl * 5 * 9216 + nk * 3 * 1024;
    float* part = p.part + (size_t)use * 64 * 4 * 192; unsigned* cnt = p.ctr + XB_PCNT + use * 64;
    const int tid = tid_opaque();
    const int col0 = un.pn * BM + wc * 32 + fq * 8;
    LAS float* rp = (LAS float*)lds; LAS float* rs = rp + 1024;
#pragma unroll
    for (int ai = 0; ai < 2; ++ai)
#pragma unroll
      for (int m = 0; m < 3; ++m) {
        const int rl = ai * 96 + wr * 48 + m * 16 + fr; const int row = un.pm * 192 + rl;
        const float* xs = (row < NCTX ? xc + (size_t)row * D : xl + (size_t)(row - NCTX) * D) + col0;
        const float* gp = gatev + cond_of(row) * 9216 + col0;
        f32x4 xv[2][2], g[2][2];
#pragma unroll
        for (int bj = 0; bj < 2; ++bj)
#pragma unroll
          for (int n = 0; n < 2; ++n) { xv[bj][n] = *(const f32x4*)(xs + bj * HALF + n * 4); g[bj][n] = *(const f32x4*)(gp + bj * HALF + n * 4); }
        float s = 0.f;
#pragma unroll
        for (int bj = 0; bj < 2; ++bj)
#pragma unroll
          for (int n = 0; n < 2; ++n) { const f32x4 xn = xv[bj][n] + coef * g[bj][n] * acc[ai][bj][m][n]; acc[ai][bj][m][n] = xn;
            s += xn[0] * xn[0] + xn[1] * xn[1] + xn[2] * xn[2] + xn[3] * xn[3];
            if (!fin) *(f32x4*)(x + (size_t)row * D + col0 + bj * HALF + n * 4) = xn; }
        s += __shfl_xor(s, 16); s += __shfl_xor(s, 32);
        if (fq == 0) rp[rl * 4 + wc] = s;
      }
    __syncthreads();
    float* slot = part + (size_t)(un.pm * 4) * 192;
    if (tid < 192) { const float t = (rp[tid * 4] + rp[tid * 4 + 1]) + (rp[tid * 4 + 2] + rp[tid * 4 + 3]);
      __hip_atomic_store(slot + un.pn * 192 + tid, t, __ATOMIC_RELAXED, __HIP_MEMORY_SCOPE_AGENT); }
    asm volatile("s_waitcnt vmcnt(0)" ::: "memory");
    __syncthreads();
    if (tid == 0) {
      __hip_atomic_fetch_add(cnt + un.pm, 1u, __ATOMIC_RELAXED, __HIP_MEMORY_SCOPE_AGENT);
      unsigned sp = 0;
      while (__hip_atomic_load(cnt + un.pm, __ATOMIC_RELAXED, __HIP_MEMORY_SCOPE_AGENT) < 4u) { __builtin_amdgcn_s_sleep(1); if (++sp > (1u << 22)) break; }
    }
    __syncthreads();
    if (tid < 192) { float t = 0.f;
#pragma unroll
      for (int q = 0; q < 4; ++q) t += __hip_atomic_load(slot + q * 192 + tid, __ATOMIC_RELAXED, __HIP_MEMORY_SCOPE_AGENT);
      rs[tid] = rsqrtf(t * (1.f / 1024.f) + EPS); }
    __syncthreads();
    const float* gnp = gn + col0;
    f32x4 gw0[2][2];
#pragma unroll
    for (int bj = 0; bj < 2; ++bj)
#pragma unroll
      for (int n = 0; n < 2; ++n) gw0[bj][n] = *(const f32x4*)(gnp + bj * HALF + n * 4);
#pragma unroll
    for (int ai = 0; ai < 2; ++ai)
#pragma unroll
      for (int m = 0; m < 3; ++m) { const int rl = ai * 96 + wr * 48 + m * 16 + fr; const float rstd = rs[rl]; const int row = un.pm * 192 + rl; const unsigned eo = (unsigned)(row * D + col0);
        if (fin) {
#pragma unroll
          for (int bj = 0; bj < 2; ++bj) { *(f32x4*)(x + (eo + bj * HALF)) = acc[ai][bj][m][0] * rstd * gw0[bj][0]; *(f32x4*)(x + (eo + bj * HALF + 4)) = acc[ai][bj][m][1] * rstd * gw0[bj][1]; }
        } else { const float* md = mdn + cond_of(row) * 9216 + col0;
#pragma unroll
          for (int bj = 0; bj < 2; ++bj) { f32x4 o[2];
#pragma unroll
            for (int n = 0; n < 2; ++n) o[n] = acc[ai][bj][m][n] * rstd * gw0[bj][n] * (1.f + *(const f32x4*)(md + 1024 + bj * HALF + n * 4)) + *(const f32x4*)(md + bj * HALF + n * 4);
            *(bf16x8*)(u + (eo + bj * HALF)) = pack8(o[0], o[1]); } } }
  }
};
struct EpiBig {
  static constexpr bool AFTER_DRAIN = false;
  u16 *zA, *gb, *Yt; float* out; int l; float* gate; const float* bmg;
  __device__ __forceinline__ void operator()(const f32x4 (&acc)[2][2][4][2], const GUnit& u, int wr, int wc, int fr, int fq) const {
    const int row0 = u.pm * BM + wr * 64 + fr; const int pn = u.pn; const int colw = wc * 32 + fq * 8;
#pragma unroll
    for (int ai = 0; ai < 2; ++ai)
#pragma unroll
      for (int m = 0; m < 4; ++m) {
        const int row = row0 + ai * HALF + m * 16;
#pragma unroll
        for (int bj = 0; bj < 2; ++bj) {
          const int c = pn * BM + bj * HALF + colw;
          f32x4 v0 = acc[ai][bj][m][0], v1 = acc[ai][bj][m][1];
          if (pn < 6) {
            *(bf16x8*)(zA + (size_t)row * ZLD + c) = pack8(v0, v1);
            if (pn >= 2 && row < NCTX) {
              const int cc = (c - 512) & 511, hh = cc >> 7, d = cc & 127, b = row >> 8, t = row & 255;
              float* o = out + (pn < 4 ? O_CK : O_CV) + ((((size_t)(b * 2 + l) * 4 + hh) * 256 + t) * 128 + d);
              *(f32x4*)o = v0; *(f32x4*)(o + 4) = v1;
            }
          } else if (pn < 10) {
            const int cp = c - 1536, g = cp >> 8, j = cp & 255, cs = j >> 7, np = j & 127;
            u16* base;
            if (row < NCTX) { const int b = row >> 8, t = row & 255; base = Yt + (size_t)b * 512 * 512 + (size_t)(g * 128 + np) * 512 + cs * 256 + t;
#pragma unroll
              for (int q = 0; q < 4; ++q) { base[(size_t)q * 512] = f2bf(v0[q]); base[(size_t)(q + 4) * 512] = f2bf(v1[q]); }
            } else { const int rr = row - NCTX, b = rr >> 10, t = rr & 1023; base = Yt + (size_t)32 * 512 * 512 + (size_t)b * 512 * 2048 + (size_t)(g * 128 + np) * 2048 + cs * 1024 + t;
#pragma unroll
              for (int q = 0; q < 4; ++q) { base[(size_t)q * 2048] = f2bf(v0[q]); base[(size_t)(q + 4) * 2048] = f2bf(v1[q]); }
            }
          } else if (pn < 18) {
            if (pn == 12 || pn == 13) { v0 *= 0.08838834764831845f; v1 *= 0.08838834764831845f; }
            if (pn >= 16) {
#pragma unroll
              for (int q = 0; q < 4; ++q) { v0[q] = sigmoidf_(v0[q]); v1[q] = sigmoidf_(v1[q]); }
            }
            *(bf16x8*)(zA + (size_t)row * ZLD + (c - 1024)) = pack8(v0, v1);
          } else if (pn < 30) {
#pragma unroll
            for (int q = 0; q < 4; ++q) { v0[q] = sigmoidf_(v0[q]); v1[q] = sigmoidf_(v1[q]); }
            *(bf16x8*)(gb + (size_t)row * GBLD + (c - 4608)) = pack8(v0, v1);
          } else if (bj == 0 && wc == 0 && fq < 2) {
#pragma unroll
            for (int q = 0; q < 8; ++q) { const int j = fq * 8 + q; float a = (q < 4 ? v0[q] : v1[q - 4]) + bmg[l * 16 + j];
              if ((j >> 2) & 1) a = fminf(a, 0.f) - log1pf(__expf(-fabsf(a)));
              gate[(size_t)row * 16 + j] = a; }
          }
        }
      }
  }
};
struct EpiBranch {
  static constexpr bool AFTER_DRAIN = false;
  u16* tmp; const u16* gb; u16* merged;
  __device__ __forceinline__ void operator()(const f32x4 (&acc)[2][2][3][2], const GUnit& u, int wr, int wc, int fr, int fq) const {
    const int row0 = u.pm * 192 + wr * 48 + fr, col0 = u.pn * BM + wc * 32 + fq * 8; const int br = u.aux;
    u16* dst = br < 2 ? tmp : merged;
#pragma unroll
    for (int ai = 0; ai < 2; ++ai) {
      bf16x8 g8[3][2], t8[3][2];
#pragma unroll
      for (int m = 0; m < 3; ++m)
#pragma unroll
        for (int bj = 0; bj < 2; ++bj) { const int row = row0 + ai * 96 + m * 16, c = col0 + bj * HALF;
          g8[m][bj] = *(const bf16x8*)(gb + (size_t)row * GBLD + br * D + c);
          if (br > 0) t8[m][bj] = *(const bf16x8*)(tmp + (size_t)row * D + c); }
#pragma unroll
      for (int m = 0; m < 3; ++m)
#pragma unroll
        for (int bj = 0; bj < 2; ++bj) { const int row = row0 + ai * 96 + m * 16, c = col0 + bj * HALF;
          f32x4 r0, r1;
#pragma unroll
          for (int q = 0; q < 4; ++q) { r0[q] = bf2f((u16)g8[m][bj][q]) * acc[ai][bj][m][0][q]; r1[q] = bf2f((u16)g8[m][bj][q + 4]) * acc[ai][bj][m][1][q]; }
          if (br > 0) {
#pragma unroll
            for (int q = 0; q < 4; ++q) { r0[q] += bf2f((u16)t8[m][bj][q]); r1[q] += bf2f((u16)t8[m][bj][q + 4]); } }
          *(bf16x8*)(dst + (size_t)row * D + c) = pack8(r0, r1); }
    }
  }
};
struct EpiFour {
  static constexpr bool AFTER_DRAIN = false;
  u16* fo; float scale;
  __device__ __forceinline__ void operator()(const f32x4 (&acc)[2][2][4][2], const GUnit& u, int wr, int wc, int fr, int fq) const {
    const int row0 = u.pm + wr * 64 + fr, col0 = u.pn * BM + wc * 32 + fq * 8;
#pragma unroll
    for (int ai = 0; ai < 2; ++ai)
#pragma unroll
      for (int m = 0; m < 4; ++m)
#pragma unroll
        for (int bj = 0; bj < 2; ++bj)
          *(bf16x8*)(fo + (size_t)(row0 + ai * HALF + m * 16) * 512 + col0 + bj * HALF) = pack8(acc[ai][bj][m][0] * scale, acc[ai][bj][m][1] * scale);
  }
};

struct TrJob { const float* src; u16* dst; int lds_, ldd, k0, ns0, nd0, mode; };
__device__ __forceinline__ void tr_decode(const Params& p, int l, int j, TrJob& t) {
  t.mode = 0;
  if (j < 352 || (j >= 528 && j < 880)) { const bool second = j >= 528; const int q = second ? j - 528 : j; const int kt = q / 22, nb = q % 22;
    t.src = (second ? p.w_ffn2_in : p.w_ffn1_in) + (size_t)l * D * 2 * DFF; t.dst = second ? p.wt_ffn2_in : p.wt_ffn1_in; t.lds_ = 2 * DFF; t.ldd = D; t.k0 = kt * 64; t.ns0 = nb * 256; t.nd0 = 0; t.mode = 1; }
  else if (j < 528 || (j >= 880 && j < 1056)) { const bool second = j >= 880; const int q = second ? j - 880 : j - 352; const int kt = q >> 2, nb = q & 3;
    t.src = (second ? p.w_ffn2_out : p.w_ffn1_out) + (size_t)l * DFF * D; t.dst = second ? p.wt_ffn2_out : p.wt_ffn1_out; t.lds_ = D; t.ldd = DFF; t.k0 = kt * 64; t.ns0 = nb * 256; t.nd0 = t.ns0; }
  else if (j < 1280) { const int q = j - 1056, kt = q / 14, nb = q % 14; t.src = p.w_in + (size_t)l * D * PIN; t.dst = p.wt_big; t.lds_ = PIN; t.ldd = D; t.k0 = kt * 64;
    if (nb < 6) { t.ns0 = nb * 256; t.nd0 = t.ns0; } else { t.ns0 = 2048 + (nb - 6) * 256; t.nd0 = t.ns0 + 512; } }
  else if (j < 1472) { const int q = j - 1280, kt = q / 12, nb = q % 12; t.src = p.w_branch_gate + (size_t)l * D * 3 * D; t.dst = p.wt_big; t.lds_ = 3 * D; t.ldd = D; t.k0 = kt * 64; t.ns0 = nb * 256; t.nd0 = 4608 + t.ns0; }
  else if (j < 1568) { const int q = j - 1472, br = q >> 5, jj = q & 31, kt = jj >> 2, nb = jj & 3;
    t.src = (br == 0 ? p.w_br_attn : br == 1 ? p.w_br_four : p.w_br_mlstm) + (size_t)l * 512 * D; t.dst = p.wt_br + (size_t)br * D * 512; t.lds_ = D; t.ldd = 512; t.k0 = kt * 64; t.ns0 = nb * 256; t.nd0 = t.ns0; }
  else { const int q = j - 1568, kt = q >> 2, nb = q & 3; t.src = p.w_out + (size_t)l * D * D; t.dst = p.wt_out; t.lds_ = D; t.ldd = D; t.k0 = kt * 64; t.ns0 = nb * 256; t.nd0 = t.ns0; }
}
__device__ __forceinline__ void tr_load(const TrJob& t, int tid, f32x4 (&r)[8]) {
#pragma unroll
  for (int i = 0; i < 8; ++i) { const int idx = tid + i * 512, kk = idx >> 6, c4 = idx & 63; r[i] = *(const f32x4*)(t.src + (size_t)(t.k0 + kk) * t.lds_ + t.ns0 + c4 * 4); }
}

__device__ void wf_job(const Params& p, int l, int job, LAS float* sm) {
  const int tid = tid_opaque();
  const int g = job >> 5, kb = (job >> 1) & 15, jh = job & 1; LAS float* W = sm; LAS float* ct = sm + 64 * 129;
  __syncthreads();
  for (int i = tid; i < 64 * 32; i += 512) { const int kk = i >> 5, c4 = i & 31;
    const float4 v = *(const float4*)(p.w_in + ((size_t)l * D + kb * 64 + kk) * PIN + 1536 + g * 128 + c4 * 4);
    LAS float* s = W + kk * 129 + c4 * 4; s[0] = v.x; s[1] = v.y; s[2] = v.z; s[3] = v.w; }
  if (tid < 128) ct[tid] = cospif((float)tid / 64.f);
  __syncthreads();
  const int kk = tid & 63, jg = tid >> 6; float a[16];
#pragma unroll
  for (int q = 0; q < 16; ++q) a[q] = 0.f;
  const int jbase = jh * 128 + jg * 16;
  for (int c = 0; c < 128; ++c) { const float w = W[kk * 129 + c];
#pragma unroll
    for (int q = 0; q < 16; ++q) { const int j = jbase + q; const int idx = jh ? ((c * (j - 128) - 32) & 127) : ((c * j) & 127); a[q] += w * ct[idx]; } }
#pragma unroll
  for (int q = 0; q < 16; ++q) p.wt_big[(size_t)(1536 + g * 256 + jbase + q) * D + kb * 64 + kk] = f2bf(a[q]);
}

__device__ void mods_job(const Params& p, int job, LAS float* sm) {
  const int tid = tid_opaque();
  const int l = job / 72, cb = job % 72; LAS float* sc = sm; LAS float* part = sm + 5 * 1024;
  __syncthreads();
  for (int i = tid; i < 5 * 1024; i += 512) { const int ci = i >> 10, k = i & 1023; const float v = ci == 0 ? p.c_ctx[k] : p.c[(ci - 1) * D + k]; sc[i] = v * sigmoidf_(v); }
  __syncthreads();
  const int cg4 = tid & 31, kp = tid >> 5; f32x4 a[5];
#pragma unroll
  for (int ci = 0; ci < 5; ++ci) a[ci] = (f32x4){0.f, 0.f, 0.f, 0.f};
  const float* wp = p.w_ada + ((size_t)l * D + kp * 64) * 9216 + cb * 128 + cg4 * 4;
#pragma unroll 8
  for (int k = 0; k < 64; ++k) { const f32x4 w = *(const f32x4*)(wp + (size_t)k * 9216);
#pragma unroll
    for (int ci = 0; ci < 5; ++ci) a[ci] += sc[ci * 1024 + kp * 64 + k] * w; }
#pragma unroll
  for (int ci = 0; ci < 5; ++ci)
#pragma unroll
    for (int q = 0; q < 4; ++q) part[(kp * 5 + ci) * 128 + cg4 * 4 + q] = a[ci][q];
  __syncthreads();
  for (int o = tid; o < 640; o += 512) { const int ci = o >> 7, cc = o & 127; float s = p.b_ada[(size_t)l * 9216 + cb * 128 + cc];
    for (int q = 0; q < 16; ++q) s += part[(q * 5 + ci) * 128 + cc];
    p.mods[((size_t)l * 5 + ci) * 9216 + cb * 128 + cc] = s; }
}

__device__ void prep_seg(const Params& p, int l, int seg, LAS unsigned char* lds, volatile LAS int* segdone) {
  if (segdone[l * 2 + seg]) return;
  const int tid = tid_opaque(); LAS float* sm = (LAS float*)lds; LAS int* s_job = (LAS int*)(lds + 131072 - 16);
  const int qi = 8 + l * 2 + seg;
  const int npre = seg ? 129 : (l == 0 ? 144 : 0), trofs = seg ? 528 : 0, ntr = seg ? 1104 : 528;
  const int trbase = npre, njobs = npre + ntr;
  int job;
  for (;;) {
    __syncthreads();
    if (tid == 0) *s_job = (int)atomicAdd(p.ctr + XB_CTR + qi, 1u);
    __syncthreads();
    job = *s_job;
    if (job >= njobs && tid == 0) segdone[l * 2 + seg] = 1;
    if (job >= trbase) break;
    if (seg && job == 128) { for (int i = tid; i < 16 * 1024; i += 512) { const int j = i >> 10, k = i & 1023; p.wt_big[(size_t)(7680 + j) * D + k] = f2bf(p.w_in[((size_t)l * D + k) * PIN + 4096 + j]); } }
    else if (seg) wf_job(p, l, job, sm); else mods_job(p, job, sm);
  }
  if (job >= njobs) return;
  f32x4 r[8]; TrJob t;
  tr_decode(p, l, job - trbase + trofs, t); tr_load(t, tid, r);
  for (;;) {
    __syncthreads();
#pragma unroll
    for (int i = 0; i < 8; ++i) { const int idx = tid + i * 512, kk = idx >> 6, c4 = idx & 63; LAS float* s = sm + kk * 257 + c4 * 4; s[0] = r[i][0]; s[1] = r[i][1]; s[2] = r[i][2]; s[3] = r[i][3]; }
    if (tid == 0) *s_job = (int)atomicAdd(p.ctr + XB_CTR + qi, 1u);
    __syncthreads();
    const int nextjob = *s_job; const TrJob cur = t;
    if (nextjob >= njobs && tid == 0) segdone[l * 2 + seg] = 1;
    if (nextjob < njobs) { tr_decode(p, l, nextjob - trbase + trofs, t); tr_load(t, tid, r); }
#pragma unroll
    for (int i = 0; i < 4; ++i) { const int unit = tid + i * 512, nn = unit >> 3, ch = unit & 7; bf16x8 o;
#pragma unroll
      for (int q = 0; q < 8; ++q) o[q] = (short)f2bf(sm[(ch * 8 + q) * 257 + nn]);
      int drow;
      if (cur.mode == 1) { const int col = cur.ns0 + nn, isg = col >= DFF, hid = col - isg * DFF; drow = (hid >> 7) * 256 + isg * 128 + (hid & 127); } else drow = cur.nd0 + nn;
      *(bf16x8*)(cur.dst + (size_t)drow * cur.ldd + cur.k0 + ch * 8) = o; }
    if (nextjob >= njobs) break;
  }
}

__device__ void phase0(const Params& p, LAS unsigned char* lds) {
  const int tid = tid_opaque(); const int G = gridDim.x;
  if (blockIdx.x == 0 && tid >= 64 && tid < 66) { const int l = tid - 64; const float* lp = p.attn_lambda + l * 256; float s1 = 0.f, s2 = 0.f;
    for (int i = 0; i < 64; ++i) { s1 += lp[i] * lp[64 + i]; s2 += lp[128 + i] * lp[192 + i]; }
    p.lam[l] = expf(s1) - expf(s2) + lam_init_of(l); }
  const int gtid = blockIdx.x * 512 + tid, gn = G * 512;
  for (int i = gtid; i < 1024 * 2048; i += gn) { const int tp = i >> 11, col = i & 2047, t = col & 1023, s = col >> 10; const int r = (t * tp) & 1023; const float x = (float)r / 512.f;
    p.cs1024[i] = f2bf(s ? -sinpif(x) : cospif(x)); }
  for (int i = gtid; i < 256 * 512; i += gn) { const int tp = i >> 9, col = i & 511, t = col & 255, s = col >> 8; const int r = (t * tp) & 255; const float x = (float)r / 128.f;
    p.cs256[i] = f2bf(s ? -sinpif(x) : cospif(x)); }
  for (int i = gtid; i < 1024 * 32; i += gn) { const int t = i >> 5, pp = i & 31; const float pos = pp < 16 ? (float)(t >> 6) : (float)(t & 63);
    const float inv = powf(10000.f, -(float)(pp & 15) / 16.f); float s, c; sincosf(pos * inv, &s, &c); p.rope[2 * i] = c; p.rope[2 * i + 1] = s; }
}

__device__ __forceinline__ float wave_sum(float v) {
#pragma unroll
  for (int o = 32; o >= 1; o >>= 1) v += __shfl_xor(v, o);
  return v;
}
__device__ void norm_phase(const Params& p, int l, int which, LAS unsigned char* lds) {
  const int tid = tid_opaque(), wid = tid >> 6, lane = tid & 63; const bool gates = which == 1;
  LAS float* Wg = (LAS float*)lds; LAS float* ur = Wg + 16384 + wid * 1024;
  if (gates) { __syncthreads();
    for (int i = tid; i < 4096; i += 512) { const int k = i >> 2, q = i & 3; const float4 v = *(const float4*)(p.w_in + ((size_t)l * D + k) * PIN + 4096 + q * 4);
      LAS float* s = Wg + k * 16 + q * 4; s[0] = v.x; s[1] = v.y; s[2] = v.z; s[3] = v.w; }
    __syncthreads(); }
  float* X = p.out; const bool first = (l == 0 && which == 0);
  const float* Xc = first ? p.x_prompt : X; const float* Xl = first ? p.x_sample : X + (size_t)NCTX * D;
#define XROW(r) ((r) < NCTX ? Xc + (size_t)(r) * D : Xl + (size_t)((r) - NCTX) * D)
  f32x4 v[4], vn[4];
  { const int rg0 = blockIdx.x; if (rg0 < NTOK / 8) { const float* xr = XROW(rg0 * 8 + wid);
#pragma unroll
      for (int i = 0; i < 4; ++i) v[i] = *(const f32x4*)(xr + i * 256 + lane * 4); } }
  for (int rg = blockIdx.x; rg < NTOK / 8; rg += gridDim.x) {
    const int row = rg * 8 + wid; float* xr = X + (size_t)row * D;
    const int rgn = rg + gridDim.x;
    if (rgn < NTOK / 8) { const float* xn = XROW(rgn * 8 + wid);
#pragma unroll
      for (int i = 0; i < 4; ++i) vn[i] = *(const f32x4*)(xn + i * 256 + lane * 4); }
    float ss = 0.f;
#pragma unroll
    for (int i = 0; i < 4; ++i) ss += v[i][0] * v[i][0] + v[i][1] * v[i][1] + v[i][2] * v[i][2] + v[i][3] * v[i][3];
    ss = wave_sum(ss); const float rstd = rsqrtf(ss * (1.f / 1024.f) + EPS);
    if (which == 3) {
#pragma unroll
      for (int i = 0; i < 4; ++i) { const f32x4 g = *(const f32x4*)(p.g_final + i * 256 + lane * 4); *(f32x4*)(xr + i * 256 + lane * 4) = v[i] * rstd * g; }
    } else {
      const float* md = p.mods + ((size_t)l * 5 + cond_of(row)) * 9216 + which * 3 * 1024; const float* gn = p.g_norm + ((size_t)l * 3 + which) * D;
#pragma unroll
      for (int i = 0; i < 4; ++i) { const int c = i * 256 + lane * 4; const f32x4 g = *(const f32x4*)(gn + c), sh = *(const f32x4*)(md + c), sc = *(const f32x4*)(md + 1024 + c);
        v[i] = v[i] * rstd * g * (1.f + sc) + sh;
        *(bf16x4*)(p.u + (size_t)row * D + c) = pack4(v[i][0], v[i][1], v[i][2], v[i][3]); }
      if (gates) {
        __syncthreads();
#pragma unroll
        for (int i = 0; i < 4; ++i) { LAS float* s = ur + i * 256 + lane * 4; s[0] = v[i][0]; s[1] = v[i][1]; s[2] = v[i][2]; s[3] = v[i][3]; }
        __syncthreads();
        const int j = lane & 15, kp = lane >> 4; float a = 0.f;
#pragma unroll 8
        for (int kk = 0; kk < 256; ++kk) a += ur[kk * 4 + kp] * Wg[(kk * 4 + kp) * 16 + j];
        a += __shfl_xor(a, 16); a += __shfl_xor(a, 32);
        if (lane < 16) { a += p.b_mgate[l * 16 + j]; if ((j >> 2) & 1) a = fminf(a, 0.f) - log1pf(__expf(-fabsf(a))); p.gate[(size_t)row * 16 + j] = a; }
      }
    }
#pragma unroll
    for (int i = 0; i < 4; ++i) v[i] = vn[i];
  }
}

__device__ void attn_item(const Params& p, int l, int item, LAS unsigned char* lds) {
  const int tid = tid_opaque(), wid = tid >> 6, lane = tid & 63, fr = lane & 15, fq = lane >> 4;
  const bool lat = item < 128; int b, h, qb, seqbase, nkt;
  if (lat) { b = item >> 5; h = (item >> 3) & 3; qb = item & 7; seqbase = NCTX + b * 1024; nkt = 20; }
  else { const int i2 = item - 128; b = i2 >> 3; h = (i2 >> 1) & 3; qb = i2 & 1; seqbase = b * 256; nkt = 4; }
  LAS unsigned char* Ks = lds; LAS unsigned char* VT = lds + 64 * 272;
  const float2* rope = (const float2*)p.rope;
  const int qtok = qb * 128 + wid * 16 + fr;
  bf16x8 Qf[2][2];
  { const u16* qp = p.zA + (size_t)(seqbase + qtok) * ZLD + h * 128;
#pragma unroll
    for (int i = 0; i < 2; ++i)
#pragma unroll
      for (int kk = 0; kk < 2; ++kk) Qf[i][kk] = *(const bf16x8*)(qp + i * 64 + kk * 32 + fq * 8);
    if (lat) {
#pragma unroll
      for (int j = 0; j < 8; ++j) { const float2 cs = rope[qtok * 32 + fq * 8 + j];
#pragma unroll
        for (int i = 0; i < 2; ++i) { const float x1 = bf2f((u16)Qf[i][0][j]), x2 = bf2f((u16)Qf[i][1][j]);
          Qf[i][0][j] = (short)f2bf(x1 * cs.x - x2 * cs.y); Qf[i][1][j] = (short)f2bf(x1 * cs.y + x2 * cs.x); } }
    }
  }
  f32x4 O[2][8];
#pragma unroll
  for (int i = 0; i < 2; ++i)
#pragma unroll
    for (int d = 0; d < 8; ++d) O[i][d] = (f32x4){0.f, 0.f, 0.f, 0.f};
  float mrun[2] = {-1e30f, -1e30f}, lrun[2] = {0.f, 0.f};
  const float sc = 0.125f * 1.4426950408889634f;
  const int skey = tid >> 3, ssub = tid & 7, smap = ssub >> 2, spg = ssub & 3, sd1 = smap * 64 + spg * 8;
  f32x4 kraw[4], vraw[4]; float2 rcs[8];
#define ATT_ISSUE(kt_) do { const int kt__ = (kt_); const int gk = kt__ * 64 + skey, gkv = kt__ * 64 + lane; \
    if (lat && kt__ < 4) { const float* kp = p.cache_k + ((((size_t)(b * 2 + l) * 4 + h) * 256 + gk) * 128) + sd1; \
      kraw[0] = *(const f32x4*)kp; kraw[1] = *(const f32x4*)(kp + 4); kraw[2] = *(const f32x4*)(kp + 32); kraw[3] = *(const f32x4*)(kp + 36); \
      const float* vp = p.cache_v + ((((size_t)(b * 2 + l) * 4 + h) * 256 + gkv) * 128) + wid * 16; \
      vraw[0] = *(const f32x4*)vp; vraw[1] = *(const f32x4*)(vp + 4); vraw[2] = *(const f32x4*)(vp + 8); vraw[3] = *(const f32x4*)(vp + 12); \
    } else { const int tok = lat ? gk - 256 : gk, tokv = lat ? gkv - 256 : gkv; const u16* kp = p.zA + (size_t)(seqbase + tok) * ZLD + 512 + h * 128 + sd1; \
      kraw[0] = *(const f32x4*)kp; kraw[1] = *(const f32x4*)(kp + 32); \
      const u16* vp = p.zA + (size_t)(seqbase + tokv) * ZLD + 1024 + h * 128 + wid * 16; vraw[0] = *(const f32x4*)vp; vraw[1] = *(const f32x4*)(vp + 8); \
      if (lat) { _Pragma("unroll") for (int j = 0; j < 8; ++j) rcs[j] = rope[tok * 32 + spg * 8 + j]; } } } while (0)
  ATT_ISSUE(0);
  for (int kt = 0; kt < nkt; ++kt) {
    __syncthreads();
    { float x1[8], x2[8];
      if (lat && kt < 4) {
#pragma unroll
        for (int j = 0; j < 4; ++j) { x1[j] = kraw[0][j]; x1[j + 4] = kraw[1][j]; x2[j] = kraw[2][j]; x2[j + 4] = kraw[3][j]; }
      } else { const bf16x8 a = __builtin_bit_cast(bf16x8, kraw[0]), bb = __builtin_bit_cast(bf16x8, kraw[1]);
#pragma unroll
        for (int j = 0; j < 8; ++j) { x1[j] = bf2f((u16)a[j]); x2[j] = bf2f((u16)bb[j]); }
        if (lat) {
#pragma unroll
          for (int j = 0; j < 8; ++j) { const float2 cs = rcs[j]; const float o1 = x1[j] * cs.x - x2[j] * cs.y, o2 = x1[j] * cs.y + x2[j] * cs.x; x1[j] = o1; x2[j] = o2; }
        }
      }
      bf16x8 o1, o2;
      { u32x4 t1, t2;
#pragma unroll
        for (int j = 0; j < 4; ++j) { t1[j] = cvt_pk_bf16(x1[2 * j], x1[2 * j + 1]); t2[j] = cvt_pk_bf16(x2[2 * j], x2[2 * j + 1]); }
        o1 = __builtin_bit_cast(bf16x8, t1); o2 = __builtin_bit_cast(bf16x8, t2); }
      *(LAS bf16x8*)(Ks + skey * 272 + sd1 * 2) = o1; *(LAS bf16x8*)(Ks + skey * 272 + (sd1 + 32) * 2) = o2;
    }
    { const int key = lane, d0 = wid * 16; u16 xv[16];
      if (lat && kt < 4) {
#pragma unroll
        for (int q = 0; q < 4; ++q)
#pragma unroll
          for (int j = 0; j < 4; ++j) xv[q * 4 + j] = f2bf(vraw[q][j]);
      } else { const bf16x8 a = __builtin_bit_cast(bf16x8, vraw[0]), bb = __builtin_bit_cast(bf16x8, vraw[1]);
#pragma unroll
        for (int j = 0; j < 8; ++j) { xv[j] = (u16)a[j]; xv[j + 8] = (u16)bb[j]; } }
      const int pos = (key & 32) | (((key >> 2) & 3) << 3) | (((key >> 4) & 1) << 2) | (key & 3);
#pragma unroll
      for (int i = 0; i < 16; ++i) *(LAS u16*)(VT + (d0 + i) * 144 + pos * 2) = xv[i];
    }
    if (kt + 1 < nkt) ATT_ISSUE(kt + 1);
    __syncthreads();
    bf16x8 Pf[2][2];
#pragma unroll
    for (int i = 0; i < 2; ++i) {
      f32x4 S[4];
#pragma unroll
      for (int st = 0; st < 4; ++st) { S[st] = (f32x4){0.f, 0.f, 0.f, 0.f};
#pragma unroll
        for (int kk = 0; kk < 2; ++kk) { const bf16x8 Kf = *(const LAS bf16x8*)(Ks + (st * 16 + fr) * 272 + (i * 64 + kk * 32 + fq * 8) * 2);
          S[st] = __builtin_amdgcn_mfma_f32_16x16x32_bf16(Kf, Qf[i][kk], S[st], 0, 0, 0); } }
      float mx = -1e30f;
#pragma unroll
      for (int st = 0; st < 4; ++st)
#pragma unroll
        for (int j = 0; j < 4; ++j) mx = fmaxf(mx, S[st][j]);
      mx = fmaxf(mx, __shfl_xor(mx, 16)); mx = fmaxf(mx, __shfl_xor(mx, 32));
      const float mnew = fmaxf(mrun[i], mx), alpha = __builtin_amdgcn_exp2f((mrun[i] - mnew) * sc); mrun[i] = mnew;
      float ls = 0.f;
#pragma unroll
      for (int st = 0; st < 4; ++st)
#pragma unroll
        for (int j = 0; j < 4; ++j) { const float pv = __builtin_amdgcn_exp2f((S[st][j] - mnew) * sc); ls += pv; S[st][j] = pv; }
      lrun[i] = lrun[i] * alpha + ls;
#pragma unroll
      for (int d = 0; d < 8; ++d) O[i][d] *= alpha;
#pragma unroll
      for (int ks = 0; ks < 2; ++ks)
#pragma unroll
        for (int j = 0; j < 1; ++j) Pf[i][ks] = pack8(S[2 * ks], S[2 * ks + 1]);
    }
#pragma unroll
    for (int d = 0; d < 8; ++d)
#pragma unroll
      for (int ks = 0; ks < 2; ++ks) { const bf16x8 Vf = *(const LAS bf16x8*)(VT + (d * 16 + fr) * 144 + (ks * 32 + fq * 8) * 2);
        O[0][d] = __builtin_amdgcn_mfma_f32_16x16x32_bf16(Vf, Pf[0][ks], O[0][d], 0, 0, 0);
        O[1][d] = __builtin_amdgcn_mfma_f32_16x16x32_bf16(Vf, Pf[1][ks], O[1][d], 0, 0, 0); }
  }
#undef ATT_ISSUE
  float inv[2];
#pragma unroll
  for (int i = 0; i < 2; ++i) { float lt = lrun[i]; lt += __shfl_xor(lt, 16); lt += __shfl_xor(lt, 32); inv[i] = 1.f / lt; }
  const float lam = p.lam[l], li = lam_init_of(l); const float i0 = inv[0], i1 = inv[1] * lam;
  float ss = 0.f;
#pragma unroll
  for (int d = 0; d < 8; ++d)
#pragma unroll
    for (int j = 0; j < 4; ++j) { const float o = O[0][d][j] * i0 - O[1][d][j] * i1; O[0][d][j] = o; ss += o * o; }
  ss += __shfl_xor(ss, 16); ss += __shfl_xor(ss, 32);
  const float rstd = rsqrtf(ss * (1.f / 128.f) + EPS) * (1.f - li);
  u16* op = p.brin + (size_t)(seqbase + qtok) * 512 + h * 128 + fq * 4; const float* gs = p.g_attn_sub + l * 128 + fq * 4;
#pragma unroll
  for (int d = 0; d < 8; ++d) { const f32x4 g = *(const f32x4*)(gs + d * 16);
    *(bf16x4*)(op + d * 16) = pack4(O[0][d][0] * rstd * g[0], O[0][d][1] * rstd * g[1], O[0][d][2] * rstd * g[2], O[0][d][3] * rstd * g[3]); }
}

__device__ void mlstm_item(const Params& p, int l, int item, LAS unsigned char* lds) {
  const int tid = tid_opaque(), wid = tid >> 6, lane = tid & 63, fr = lane & 15, fq = lane >> 4;
  const bool lat = item < 32; int b, h, dir, seqbase, T;
  if (lat) { b = item >> 3; h = (item >> 1) & 3; dir = item & 1; seqbase = NCTX + b * 1024; T = 1024; }
  else { const int i2 = item - 32; b = i2 >> 3; h = (i2 >> 1) & 3; dir = i2 & 1; seqbase = b * 256; T = 256; }
  const int nch = T >> 6;
  LAS unsigned char* Qs = lds; LAS unsigned char* Ks = lds + 17408; LAS unsigned char* KTs = lds + 34816; LAS unsigned char* VTs = lds + 53248;
  LAS unsigned char* Cs = lds + 71680; LAS unsigned char* Ss = lds + 106496; LAS float* fl = (LAS float*)(lds + 115712);
  LAS float* a_s = fl; LAS float* g_s = fl + 64; LAS float* sp_s = fl + 128; LAS float* wl_s = fl + 192; LAS float* em_s = fl + 256; LAS float* nq_s = fl + 320;
  LAS float* denp = fl + 384; LAS float* nvec = fl + 512; LAS float* scal = fl + 640;
  const size_t sidx = ((size_t)(b * 2 + l) * 2 + dir) * 4 + h;
  f32x4 accC[8];
  __syncthreads();
  if (lat) { const float* cp = p.state_C + sidx * 16384 + (size_t)(wid * 16 + fr) * 128 + fq * 4;
#pragma unroll
    for (int kt = 0; kt < 8; ++kt) accC[kt] = *(const f32x4*)(cp + kt * 16);
    if (tid < 128) nvec[tid] = p.state_n[sidx * 128 + tid];
  } else {
#pragma unroll
    for (int kt = 0; kt < 8; ++kt) accC[kt] = (f32x4){0.f, 0.f, 0.f, 0.f};
    if (tid < 128) nvec[tid] = 0.f;
  }
#pragma unroll
  for (int kt = 0; kt < 8; ++kt) *(LAS bf16x4*)(Cs + (wid * 16 + fr) * 272 + (kt * 16 + fq * 4) * 2) = pack4(accC[kt][0], accC[kt][1], accC[kt][2], accC[kt][3]);
  float mst = lat ? p.state_m[sidx] : 0.f;
  f32x4 qraw[2], kraw[2], vraw[2]; float igr = 0.f, lfr = 0.f;
#define ML_ISSUE(ch_) do { const int ch__ = (ch_); { const int pos = tid >> 3, c16 = (tid & 7) * 16; const int gp_ = ch__ * 64 + pos, tok = dir ? T - 1 - gp_ : gp_; \
      const u16* zp = p.zA + (size_t)(seqbase + tok) * ZLD + h * 128 + c16; \
      qraw[0] = *(const f32x4*)(zp + 1536); qraw[1] = *(const f32x4*)(zp + 1536 + 8); kraw[0] = *(const f32x4*)(zp + 2048); kraw[1] = *(const f32x4*)(zp + 2048 + 8); } \
    { const int gp_ = ch__ * 64 + lane, tok = dir ? T - 1 - gp_ : gp_; const u16* vp = p.zA + (size_t)(seqbase + tok) * ZLD + 2560 + h * 128 + wid * 16; \
      vraw[0] = *(const f32x4*)vp; vraw[1] = *(const f32x4*)(vp + 8); \
      if (wid == 0) { const float* gp = p.gate + (size_t)(seqbase + tok) * 16 + dir * 8 + h; igr = gp[0]; lfr = gp[4]; } } } while (0)
  ML_ISSUE(0);
  for (int ch = 0; ch < nch; ++ch) {
    if (wid == 0) {
      const float ig = igr, lf = lfr; float bs = lf;
#pragma unroll
      for (int o = 1; o < 64; o <<= 1) { const float t = __shfl_up(bs, o); if (lane >= o) bs += t; }
      const float a = ig - bs; float gm = a;
#pragma unroll
      for (int o = 1; o < 64; o <<= 1) { const float t = __shfl_up(gm, o); if (lane >= o) gm = fmaxf(gm, t); }
      gm = fmaxf(gm, mst);
      const float g63 = __shfl(gm, 63), b63 = __shfl(bs, 63);
      a_s[lane] = a; g_s[lane] = gm; sp_s[lane] = __expf(mst - gm); wl_s[lane] = __expf(a - g63); em_s[lane] = __expf(-(bs + gm));
      if (lane == 0) { scal[0] = __expf(mst - g63); scal[1] = b63 + g63; } }
    { const int pos = tid >> 3, c16 = (tid & 7) * 16;
      *(LAS f32x4*)(Qs + pos * 272 + c16 * 2) = qraw[0]; *(LAS f32x4*)(Qs + pos * 272 + c16 * 2 + 16) = qraw[1];
      *(LAS f32x4*)(Ks + pos * 272 + c16 * 2) = kraw[0]; *(LAS f32x4*)(Ks + pos * 272 + c16 * 2 + 16) = kraw[1]; }
    { const bf16x8 v0 = __builtin_bit_cast(bf16x8, vraw[0]), v1 = __builtin_bit_cast(bf16x8, vraw[1]);
#pragma unroll
      for (int i = 0; i < 8; ++i) { *(LAS u16*)(VTs + (wid * 16 + i) * 144 + lane * 2) = (u16)v0[i]; *(LAS u16*)(VTs + (wid * 16 + 8 + i) * 144 + lane * 2) = (u16)v1[i]; } }
    if (ch + 1 < nch) ML_ISSUE(ch + 1);
    __syncthreads();
    { const float wl = wl_s[lane]; const bf16x8 k0 = *(const LAS bf16x8*)(Ks + lane * 272 + wid * 32), k1 = *(const LAS bf16x8*)(Ks + lane * 272 + wid * 32 + 16);
#pragma unroll
      for (int i = 0; i < 8; ++i) { *(LAS u16*)(KTs + (wid * 16 + i) * 144 + lane * 2) = f2bf(bf2f((u16)k0[i]) * wl); *(LAS u16*)(KTs + (wid * 16 + 8 + i) * 144 + lane * 2) = f2bf(bf2f((u16)k1[i]) * wl); } }
    { const int tt = wid & 3, spq = wid >> 2; const int t = tt * 16 + fr; const float gt = g_s[t]; float dsum = 0.f;
      bf16x8 Qf[4];
#pragma unroll
      for (int kk = 0; kk < 4; ++kk) Qf[kk] = *(const LAS bf16x8*)(Qs + t * 272 + (kk * 32 + fq * 8) * 2);
#pragma unroll
      for (int s2 = 0; s2 < 2; ++s2) { const int st = spq * 2 + s2; f32x4 acc = (f32x4){0.f, 0.f, 0.f, 0.f};
        if (st <= tt) {
#pragma unroll
          for (int kk = 0; kk < 4; ++kk) { const bf16x8 Kf = *(const LAS bf16x8*)(Ks + (st * 16 + fr) * 272 + (kk * 32 + fq * 8) * 2); acc = __builtin_amdgcn_mfma_f32_16x16x32_bf16(Kf, Qf[kk], acc, 0, 0, 0); }
        }
        float vv[4];
#pragma unroll
        for (int j = 0; j < 4; ++j) { const int s = st * 16 + fq * 4 + j; const float w = (s <= t) ? __expf(a_s[s] - gt) : 0.f; vv[j] = acc[j] * w; dsum += vv[j]; }
        *(LAS bf16x4*)(Ss + t * 144 + (st * 16 + fq * 4) * 2) = pack4(vv[0], vv[1], vv[2], vv[3]); }
      dsum += __shfl_xor(dsum, 16); dsum += __shfl_xor(dsum, 32);
      if (fq == 0) denp[spq * 64 + t] = dsum; }
    { const int t = tid >> 3, part = tid & 7; const bf16x8 q0 = *(const LAS bf16x8*)(Qs + t * 272 + part * 32), q1 = *(const LAS bf16x8*)(Qs + t * 272 + part * 32 + 16); float s = 0.f;
#pragma unroll
      for (int i = 0; i < 8; ++i) s += nvec[part * 16 + i] * bf2f((u16)q0[i]) + nvec[part * 16 + 8 + i] * bf2f((u16)q1[i]);
      s += __shfl_xor(s, 1); s += __shfl_xor(s, 2); s += __shfl_xor(s, 4);
      if (part == 0) nq_s[t] = s; }
    __syncthreads();
    const float decay = scal[0];
    { const int tt = wid & 3, vh = wid >> 2; const int t = tt * 16 + fr; const float spt = sp_s[t]; const float den = spt * nq_s[t] + denp[t] + denp[64 + t];
      const float rdn = 1.f / fmaxf(fabsf(den), em_s[t]);
      bf16x8 Qf[4], Sf[2];
#pragma unroll
      for (int kk = 0; kk < 4; ++kk) Qf[kk] = *(const LAS bf16x8*)(Qs + t * 272 + (kk * 32 + fq * 8) * 2);
#pragma unroll
      for (int ks = 0; ks < 2; ++ks) Sf[ks] = *(const LAS bf16x8*)(Ss + t * 144 + (ks * 32 + fq * 8) * 2);
      const int gp_ = ch * 64 + t, tok = dir ? T - 1 - gp_ : gp_; u16* hp = p.hdir + ((size_t)dir * NTOK + seqbase + tok) * 512 + h * 128 + fq * 4;
#pragma unroll
      for (int v4 = 0; v4 < 4; ++v4) { const int vt = vh * 4 + v4; f32x4 aS = (f32x4){0.f, 0.f, 0.f, 0.f}, aI = (f32x4){0.f, 0.f, 0.f, 0.f};
#pragma unroll
        for (int kk = 0; kk < 4; ++kk) { const bf16x8 Cf = *(const LAS bf16x8*)(Cs + (vt * 16 + fr) * 272 + (kk * 32 + fq * 8) * 2); aS = __builtin_amdgcn_mfma_f32_16x16x32_bf16(Cf, Qf[kk], aS, 0, 0, 0); }
#pragma unroll
        for (int ks = 0; ks < 2; ++ks) { const bf16x8 Vf = *(const LAS bf16x8*)(VTs + (vt * 16 + fr) * 144 + (ks * 32 + fq * 8) * 2); aI = __builtin_amdgcn_mfma_f32_16x16x32_bf16(Vf, Sf[ks], aI, 0, 0, 0); }
        const bf16x4 hv = pack4((spt * aS[0] + aI[0]) * rdn, (spt * aS[1] + aI[1]) * rdn, (spt * aS[2] + aI[2]) * rdn, (spt * aS[3] + aI[3]) * rdn);
        __hip_atomic_store((unsigned long long*)(hp + vt * 16), __builtin_bit_cast(unsigned long long, hv), __ATOMIC_RELAXED, __HIP_MEMORY_SCOPE_AGENT); } }
    float nsum = 0.f;
    { bf16x8 Vf[2];
#pragma unroll
      for (int ks = 0; ks < 2; ++ks) Vf[ks] = *(const LAS bf16x8*)(VTs + (wid * 16 + fr) * 144 + (ks * 32 + fq * 8) * 2);
#pragma unroll
      for (int kt = 0; kt < 8; ++kt) { accC[kt] *= decay;
#pragma unroll
        for (int ks = 0; ks < 2; ++ks) { const bf16x8 Kf = *(const LAS bf16x8*)(KTs + (kt * 16 + fr) * 144 + (ks * 32 + fq * 8) * 2); accC[kt] = __builtin_amdgcn_mfma_f32_16x16x32_bf16(Kf, Vf[ks], accC[kt], 0, 0, 0); } }
      if (tid < 128) {
#pragma unroll
        for (int q = 0; q < 8; ++q) { const bf16x8 kv = *(const LAS bf16x8*)(KTs + tid * 144 + q * 16);
#pragma unroll
          for (int i = 0; i < 8; ++i) nsum += bf2f((u16)kv[i]); } } }
    mst = scal[1];
    __syncthreads();
#pragma unroll
    for (int kt = 0; kt < 8; ++kt) *(LAS bf16x4*)(Cs + (wid * 16 + fr) * 272 + (kt * 16 + fq * 4) * 2) = pack4(accC[kt][0], accC[kt][1], accC[kt][2], accC[kt][3]);
    if (tid < 128) nvec[tid] = decay * nvec[tid] + nsum;
  }
#undef ML_ISSUE
  if (!lat) {
    float* cpb = p.out + O_SC + sidx * 16384; const unsigned coff = (unsigned)((wid * 16 + fr) * 128 + fq * 4);
#pragma unroll
    for (int kt = 0; kt < 8; ++kt) *(f32x4*)(cpb + (coff + kt * 16)) = accC[kt];
    __syncthreads();
    if (tid < 128) p.out[O_SN + sidx * 128 + tid] = nvec[tid];
    if (tid == 0) p.out[O_SM + sidx] = mst;
  }
  asm volatile("s_waitcnt vmcnt(0)" ::: "memory");
  __syncthreads();
  LAS unsigned* flag = (LAS unsigned*)(fl + 644);
  if (tid == 0) *flag = __hip_atomic_fetch_add(p.ctr + XB_MCNT + l * 144 + (lat ? 32 + b : b) * 4 + h, 1u, __ATOMIC_RELAXED, __HIP_MEMORY_SCOPE_AGENT);
  __syncthreads();
  if (*flag == 1u) {
    const int rsub = tid >> 4, cq = tid & 15; const float* g = p.g_mlstm + l * 128 + cq * 8;
    for (int r0 = 0; r0 < T; r0 += 32) {
      const size_t row = (size_t)(seqbase + r0 + rsub); const int c = h * 128 + cq * 8;
      const unsigned long long* pf = (const unsigned long long*)(p.hdir + row * 512 + c); const unsigned long long* pb = (const unsigned long long*)(p.hdir + ((size_t)NTOK + row) * 512 + c);
      unsigned long long f0 = __hip_atomic_load(pf, __ATOMIC_RELAXED, __HIP_MEMORY_SCOPE_AGENT), f1 = __hip_atomic_load(pf + 1, __ATOMIC_RELAXED, __HIP_MEMORY_SCOPE_AGENT);
      unsigned long long b0 = __hip_atomic_load(pb, __ATOMIC_RELAXED, __HIP_MEMORY_SCOPE_AGENT), b1 = __hip_atomic_load(pb + 1, __ATOMIC_RELAXED, __HIP_MEMORY_SCOPE_AGENT);
      const bf16x8 mo = *(const bf16x8*)(p.zA + row * ZLD + 3072 + c);
      const bf16x4 hf0 = __builtin_bit_cast(bf16x4, f0), hf1 = __builtin_bit_cast(bf16x4, f1), hb0 = __builtin_bit_cast(bf16x4, b0), hb1 = __builtin_bit_cast(bf16x4, b1);
      float s[8], ss = 0.f;
#pragma unroll
      for (int i = 0; i < 4; ++i) { s[i] = bf2f((u16)hf0[i]) + bf2f((u16)hb0[i]); s[i + 4] = bf2f((u16)hf1[i]) + bf2f((u16)hb1[i]); }
#pragma unroll
      for (int i = 0; i < 8; ++i) ss += s[i] * s[i];
      ss += __shfl_xor(ss, 1); ss += __shfl_xor(ss, 2); ss += __shfl_xor(ss, 4); ss += __shfl_xor(ss, 8);
      const float rstd = rsqrtf(ss * (1.f / 128.f) + EPS);
      f32x4 o0, o1;
#pragma unroll
      for (int i = 0; i < 4; ++i) { o0[i] = s[i] * rstd * g[i] * bf2f((u16)mo[i]); o1[i] = s[i + 4] * rstd * g[i + 4] * bf2f((u16)mo[i + 4]); }
      *(bf16x8*)(p.brin + ((size_t)2 * NTOK + row) * 512 + c) = pack8(o0, o1);
    }
  }
}

__device__ void mixers_phase(const Params& p, int ci, int l, LAS unsigned char* lds, int mask = 7) {
  __shared__ int s_item;
  const int tid = tid_opaque();
  for (;;) {
    __syncthreads();
    if (tid == 0) s_item = (int)atomicAdd(p.ctr + XB_CTR + ci, 1u);
    __syncthreads();
    const int item = s_item;
    if (item >= 768) break;
    const int ty = (item < 32 || (item >= 192 && item < 256)) ? 4 : ((item < 64 || (item >= 256 && item < 512)) ? 1 : 2);
    if (!(mask & ty)) continue;
    if (ty == 4) {
      OneSched S; int ld; float scale;
      if (item < 32) { const int b = item >> 3, mt = (item >> 1) & 3, nt = item & 1; ld = 2048; scale = 1.f / sqrtf(1024.f * 128.f);
        S.u.A = (const char*)(p.cs1024 + (size_t)mt * 256 * 2048); S.u.B = (const char*)(p.Yt + (size_t)32 * 512 * 512 + (size_t)b * 512 * 2048 + (size_t)nt * 256 * 2048);
        S.u.pm = NCTX + b * 1024 + mt * 256; S.u.pn = nt; S.u.aux = 0; }
      else { const int i2 = item - 192, b = i2 >> 1, nt = i2 & 1; ld = 512; scale = 1.f / sqrtf(256.f * 128.f);
        S.u.A = (const char*)p.cs256; S.u.B = (const char*)(p.Yt + (size_t)b * 512 * 512 + (size_t)nt * 256 * 512);
        S.u.pm = b * 256; S.u.pn = nt; S.u.aux = 0; }
      EpiFour E{p.brin + (size_t)NTOK * 512, scale};
      gemm_phase<4>(lds, ld, ld, ld, S, E);
    } else if (ty == 1) mlstm_item(p, l, item < 64 ? item - 32 : 32 + (item - 256), lds);
    else attn_item(p, l, item < 192 ? item - 64 : 128 + (item - 512), lds);
  }
}

__device__ void mpost_phase(const Params& p, int l) {
  const int tid = tid_opaque(), wid = tid >> 6, lane = tid & 63;
  for (int row = blockIdx.x * 8 + wid; row < NTOK; row += gridDim.x * 8) {
    const bf16x8 hf = *(const bf16x8*)(p.hdir + (size_t)row * 512 + lane * 8), hb = *(const bf16x8*)(p.hdir + ((size_t)NTOK + row) * 512 + lane * 8);
    const bf16x8 mo = *(const bf16x8*)(p.zA + (size_t)row * ZLD + 3072 + lane * 8);
    float s[8], ss = 0.f;
#pragma unroll
    for (int i = 0; i < 8; ++i) { s[i] = bf2f((u16)hf[i]) + bf2f((u16)hb[i]); ss += s[i] * s[i]; }
    ss += __shfl_xor(ss, 1); ss += __shfl_xor(ss, 2); ss += __shfl_xor(ss, 4); ss += __shfl_xor(ss, 8);
    const float rstd = rsqrtf(ss * (1.f / 128.f) + EPS); const float* g = p.g_mlstm + l * 128 + (lane & 15) * 8; bf16x8 o;
#pragma unroll
    for (int i = 0; i < 8; ++i) o[i] = (short)f2bf(s[i] * rstd * g[i] * bf2f((u16)mo[i]));
    *(bf16x8*)(p.brin + ((size_t)2 * NTOK + row) * 512 + lane * 8) = o;
  }
}

__global__ void __launch_bounds__(512) fwd_megakernel(Params p_) {
  const Params& p = *(const Params*)(const __attribute__((address_space(4))) void*)__builtin_amdgcn_kernarg_segment_ptr();
  extern __shared__ __attribute__((aligned(16))) unsigned char shm_[];
  LAS unsigned char* lds = (LAS unsigned char*)shm_;
  cg::grid_group grid = cg::this_grid();
  const int G = gridDim.x, c = blockIdx.x;
  __shared__ uint4 xb_words; __shared__ int s_segdone[4];
  if (threadIdx.x == 0) xb_words = make_uint4(0u, 0u, 0u, 0u);
  if (threadIdx.x < 4) s_segdone[threadIdx.x] = 0;
  __syncthreads();
  const XcdBarrier xb = xcd_barrier_post(p.ctr, (volatile LAS unsigned*)&xb_words);
#define GSYNC() xcd_barrier(xb)
  if (p.out == nullptr) grid.sync();
  for (int ph = 0; ph < 25; ++ph) {
    const int l = ph == 0 ? 0 : (ph - 1) / 12, kind = ph == 0 ? -1 : (ph - 1) - l * 12;
    if (kind == 3 || kind == 9 || kind == 6 || (kind == 0 && l == 1)) continue;
    const float* md = p.mods + (size_t)l * 5 * 9216;
    int hl = -1, hs = 0;
    if (kind == -1) { phase0(p, lds); hl = 0; hs = 0; }
    else if (kind == 0) norm_phase(p, 0, 0, lds);
    else if (kind == 1 || kind == 10) {
      TileSched S{p.u, kind == 1 ? p.wt_ffn1_in : p.wt_ffn2_in, D, D, 48, 22, G, c, 256}; EpiSwiglu E{p.zA}; gemm_phase<4>(lds, D, D, D, S, E);
      if (kind == 1) { hl = l; hs = 1; } else if (l == 0) { hl = 1; hs = 0; }
    } else if (kind == 2 || kind == 11 || kind == 8) {
      const bool isout = kind == 8; const int Kd = isout ? D : DFF;
      TileSched S{isout ? p.hdir : p.zA, isout ? p.wt_out : (kind == 2 ? p.wt_ffn1_out : p.wt_ffn2_out), Kd, Kd, 64, 4, G, c, 192};
      EpiResidNorm E{p, l, kind};
      gemm_phase<3>(lds, Kd, Kd, Kd, S, E);
      if (kind == 2) { hl = l; hs = 1; }
    } else if (kind == 4) { TileSched S{p.u, p.wt_big, D, D, 48, 31, G, c, 256}; EpiBig E{p.zA, p.gb, p.Yt, p.out, l, p.gate, p.b_mgate}; gemm_phase<4>(lds, D, D, D, S, E); }
    else if (kind == 5) mixers_phase(p, l, l, lds);
    else if (kind == 6) mpost_phase(p, l);
    else { BranchSched S{p.brin, p.wt_br, G, c}; EpiBranch E{p.zA, p.gb, p.hdir}; gemm_phase<3>(lds, 512, 512, 512, S, E); }
    if (hl >= 0) prep_seg(p, hl, hs, lds, (volatile LAS int*)s_segdone);
    GSYNC();
  }
}


extern "C" void kernel_launch(void* const* d_in, const int* in_sizes, int n_in, void* d_out, int out_size, void* d_ws, size_t ws_size, hipStream_t stream) {
  static int grid_blocks = 0;
  if (!grid_blocks) {
    int dev = 0, cus = 0, per_cu = 0;
    hipGetDevice(&dev);
    hipDeviceGetAttribute(&cus, hipDeviceAttributeMultiprocessorCount, dev);
    hipFuncSetAttribute((const void*)fwd_megakernel, hipFuncAttributeMaxDynamicSharedMemorySize, LDS_BYTES);
    hipOccupancyMaxActiveBlocksPerMultiprocessor(&per_cu, (const void*)fwd_megakernel, 512, LDS_BYTES);
    if (per_cu < 1) per_cu = 1;
    grid_blocks = cus * 1;
    (void)hipGetLastError();
  }
  Params p{};
  const float** ip = (const float**)&p;
  for (int i = 0; i < 27; ++i) ip[i] = (const float*)d_in[i];
  p.out = (float*)d_out;
  char* w = (char*)d_ws; size_t off = 0;
  auto take = [&](size_t bytes) { char* r = w + off; off += (bytes + 255) & ~(size_t)255; return r; };
  p.wt_ffn1_in = (u16*)take((size_t)2 * DFF * D * 2); p.wt_ffn1_out = (u16*)take((size_t)D * DFF * 2);
  p.wt_ffn2_in = (u16*)take((size_t)2 * DFF * D * 2); p.wt_ffn2_out = (u16*)take((size_t)D * DFF * 2);
  p.wt_big = (u16*)take((size_t)NBIG * D * 2); p.wt_br = (u16*)take((size_t)3 * D * 512 * 2); p.wt_out = (u16*)take((size_t)D * D * 2);
  p.u = (u16*)take((size_t)NTOK * D * 2);
  p.zA = (u16*)take((size_t)NTOK * ZLD * 2); p.gb = (u16*)take((size_t)NTOK * GBLD * 2);
  p.Yt = (u16*)take((size_t)NTOK * 1024 * 2); p.brin = (u16*)take((size_t)3 * NTOK * 512 * 2); p.hdir = (u16*)take((size_t)2 * NTOK * 512 * 2);
  p.cs1024 = (u16*)take((size_t)1024 * 2048 * 2); p.cs256 = (u16*)take((size_t)256 * 512 * 2);
  p.mods = (float*)take((size_t)2 * 5 * 9216 * 4); p.gate = (float*)take((size_t)NTOK * 16 * 4); p.rope = (float*)take((size_t)1024 * 32 * 2 * 4);
  p.lam = (float*)take(256); p.part = (float*)take((size_t)6 * 48 * 4 * 256 * 4); p.ctr = (unsigned*)take(BAR_TOTAL_WORDS * 4);
  if (off > ws_size) { fprintf(stderr, "kernel_launch: workspace too small: need %zu have %zu\n", off, ws_size); return; }
  if (hipMemsetAsync(p.ctr, 0, BAR_TOTAL_WORDS * 4, stream) != hipSuccess) { fprintf(stderr, "memset failed\n"); return; }
  void* args[] = {&p};
  hipError_t e = hipLaunchCooperativeKernel((const void*)fwd_megakernel, dim3(grid_blocks), dim3(512), args, LDS_BYTES, stream);
  if (e != hipSuccess) fprintf(stderr, "cooperative launch failed: %s (grid %d)\n", hipGetErrorString(e), grid_blocks);
}
```

```cpp
#include <hip/hip_runtime.h>
#include <hip/hip_cooperative_groups.h>
#include <cstdio>
namespace cg = cooperative_groups;

typedef unsigned short u16;
typedef short bf16x8 __attribute__((ext_vector_type(8)));
typedef short bf16x4 __attribute__((ext_vector_type(4)));
typedef float f32x4 __attribute__((ext_vector_type(4)));
#define LAS __attribute__((address_space(3)))

constexpr int D = 1024, NTOK = 12288, NCTX = 8192, DFF = 2816, PIN = 4112, NBIG = 7936, ZLD = 3584, GBLD = 3072;
constexpr int LDS_BYTES = 131072;
#ifndef PROBE
#define PROBE 0
#endif
constexpr float EPS = 1e-6f;
constexpr size_t O_Y = 0, O_CK = 12582912, O_CV = 20971520, O_SC = 29360128, O_SN = 37748736, O_SM = 37814272;

struct Params {
  const float *x_prompt, *x_sample, *cache_k, *cache_v, *state_C, *state_n, *state_m, *c, *c_ctx, *w_ada, *b_ada, *g_norm,
      *w_ffn1_in, *w_ffn1_out, *w_ffn2_in, *w_ffn2_out, *w_in, *b_mgate, *attn_lambda, *g_attn_sub, *g_mlstm, *w_branch_gate,
      *w_br_attn, *w_br_four, *w_br_mlstm, *w_out, *g_final;
  float* out;
  u16 *wt_ffn1_in, *wt_ffn1_out, *wt_ffn2_in, *wt_ffn2_out, *wt_big, *wt_br, *wt_out;
  u16 *u, *zA, *gb, *Yt, *brin, *hdir, *cs1024, *cs256;
  float *mods, *gate, *rope, *lam, *part;
  unsigned* ctr;
};

typedef float f32x2_ __attribute__((ext_vector_type(2)));
typedef __bf16 bf16v2_ __attribute__((ext_vector_type(2)));
__device__ __forceinline__ unsigned cvt_pk_bf16(float lo, float hi) { f32x2_ v = {lo, hi}; bf16v2_ r = __builtin_convertvector(v, bf16v2_); return __builtin_bit_cast(unsigned, r); }
__device__ __forceinline__ u16 f2bf(float f) { return (u16)cvt_pk_bf16(f, 0.f); }
typedef unsigned u32x4 __attribute__((ext_vector_type(4)));
typedef unsigned u32x2 __attribute__((ext_vector_type(2)));
__device__ __forceinline__ float bf2f(u16 h) { return __uint_as_float(((unsigned)h) << 16); }
__device__ __forceinline__ int tid_opaque() { int t = threadIdx.x; asm volatile("" : "+v"(t)); return t; }
__device__ __forceinline__ float sigmoidf_(float x) { return __builtin_amdgcn_rcpf(1.f + __builtin_amdgcn_exp2f(-1.4426950408889634f * x)); }
__device__ __forceinline__ int cond_of(int row) { return row < NCTX ? 0 : 1 + ((row - NCTX) >> 10); }
__device__ __forceinline__ float lam_init_of(int l) { return l == 0 ? 0.2f : (0.8f - 0.6f * 0.74081822068f); }


#define XB_TMO      128
#define XB_XCNT(j)  (256  + 64 * (j))
#define XB_XSUB(j)  (1280 + 64 * (j))
#define XB_XGEN(j)  (2304 + 64 * (j))
#define XB_TOP      3328
#define XB_TOPGEN   3392
#define XCD_BAR_WORDS 3456
#define XB_CTR      3520
#define XB_PCNT     3584
#define XB_MCNT     3968
#define BAR_TOTAL_WORDS 4352
#define XB_SPIN_CAP (1u << 18)
__device__ __forceinline__ unsigned xb_ld(unsigned* p)              { return __hip_atomic_load(p, __ATOMIC_RELAXED, __HIP_MEMORY_SCOPE_AGENT); }
__device__ __forceinline__ unsigned xb_add(unsigned* p, unsigned v) { return __hip_atomic_fetch_add(p, v, __ATOMIC_RELAXED, __HIP_MEMORY_SCOPE_AGENT); }
__device__ __forceinline__ unsigned xb_xcc_id() { return (unsigned)__builtin_amdgcn_s_getreg((3 << 11) | 20) & 0xFu; }
#define XB_SPIN(cond, bar) do { unsigned _sp = 0; while (cond) { __builtin_amdgcn_s_sleep(1); \
    if ((++_sp & 255u) == 0u) { if (xb_ld(&(bar)[XB_TMO])) break; if (_sp > XB_SPIN_CAP) { atomicAdd(&(bar)[XB_TMO], 1u); break; } } } } while (0)
struct XcdBarrier { unsigned* bar; unsigned x; volatile LAS unsigned* st; };
__device__ __forceinline__ XcdBarrier xcd_barrier_post(unsigned* bar, volatile LAS unsigned* st) {
  XcdBarrier b; b.bar = bar; b.x = xb_xcc_id(); b.st = st;
  if (threadIdx.x == 0) (void)xb_add(&bar[XB_XCNT(b.x)], 1u);
  return b;
}
__device__ __forceinline__ void xcd_barrier_complete(unsigned* bar, unsigned x, unsigned& nloc, unsigned& nx) {
  const unsigned G = gridDim.x * gridDim.y * gridDim.z;
  unsigned sum, cnt, mine, sp = 0u;
  for (;;) {
    sum = 0u; cnt = 0u; mine = 0u;
#pragma unroll
    for (unsigned j = 0; j < 16; ++j) { const unsigned c = xb_ld(&bar[XB_XCNT(j)]); sum += c; cnt += (c > 0u) ? 1u : 0u; mine = (j == x) ? c : mine; }
    if (sum == G) break;
    __builtin_amdgcn_s_sleep(1);
    if ((++sp & 255u) == 0u) { if (xb_ld(&bar[XB_TMO])) break; if (sp > XB_SPIN_CAP) { atomicAdd(&bar[XB_TMO], 1u); break; } }
  }
  nloc = mine > 0u ? mine : 1u; nx = cnt > 0u ? cnt : 1u;
}
__device__ __forceinline__ void xcd_barrier(const XcdBarrier& b) {
  asm volatile("s_waitcnt vmcnt(0)" ::: "memory");
  __syncthreads();
  if (threadIdx.x == 0) {
    unsigned* bar = b.bar;
    __builtin_amdgcn_s_waitcnt(0);
    unsigned nloc = b.st[0], nx = b.st[1];
    if (nloc == 0u) { xcd_barrier_complete(bar, b.x, nloc, nx); b.st[0] = nloc; b.st[1] = nx; }
    const unsigned old = xb_add(&bar[XB_XSUB(b.x)], 1u);
    const unsigned gen = old / nloc;
    if (old + 1u == (gen + 1u) * nloc) {
      __builtin_amdgcn_fence(__ATOMIC_RELEASE, "agent");
      asm volatile("s_waitcnt vmcnt(0)" ::: "memory");
      const unsigned og = xb_add(&bar[XB_TOP], 1u);
      const unsigned tg = og / nx;
      if (og + 1u == (tg + 1u) * nx) xb_add(&bar[XB_TOPGEN], 1u);
      else XB_SPIN(xb_ld(&bar[XB_TOPGEN]) == tg, bar);
      __builtin_amdgcn_fence(__ATOMIC_ACQUIRE, "agent");
      xb_add(&bar[XB_XGEN(b.x)], 1u);
      asm volatile("s_waitcnt vmcnt(0)" ::: "memory");
    } else {
      XB_SPIN(xb_ld(&bar[XB_XGEN(b.x)]) == gen, bar);
      __builtin_amdgcn_fence(__ATOMIC_ACQUIRE, "agent");
      asm volatile("s_waitcnt vmcnt(0)" ::: "memory");
    }
  }
  __syncthreads();
}

constexpr int BM = 256, BK = 64, HALF = 128, HTB = HALF * BK * 2;
__device__ __forceinline__ int lds_byte(int r, int c) { const int st = (r >> 4) * 2 + (c >> 5), rr = r & 15, cc = c & 31, ob = rr * 64 + cc * 2; return st * 1024 + (ob ^ (((ob >> 9) & 1) << 5)); }
__device__ __forceinline__ void stage_rc(int b, int& R, int& C) { const int st = b / 1024, sb = b % 1024, swz = sb ^ (((sb >> 9) & 1) << 5); R = (st >> 1) * 16 + swz / 64; C = (st & 1) * 32 + (swz % 64) / 2; }
__device__ __forceinline__ int perm32(int rho) { const int n = rho >> 4, i = rho & 15; return 8 * (i >> 2) + 4 * n + (i & 3); }

struct GUnit { const char* A; const char* B; int pm, pn, aux; };

__device__ __forceinline__ bool tile_order(int L, int nM, int nN, int& pm, int& pn) {
  const int nwg = nM * nN; if (L >= nwg) return false;
  int wgid = L; { const int q = nwg / 8, r = nwg % 8, xcd = wgid % 8, off = wgid / 8; wgid = (xcd < r ? xcd * (q + 1) : r * (q + 1) + (xcd - r) * q) + off; }
  const int nig = 8 * nN, gid = wgid / nig, fm = gid * 8, gsz = (nM - fm) < 8 ? (nM - fm) : 8;
  pm = fm + ((wgid % nig) % gsz); pn = (wgid % nig) / gsz; return true;
}

template <int MT, class Sched, class Epi>
__device__ __forceinline__ void gemm_phase(LAS unsigned char* lds, const int lda, const int ldb, const int K, const Sched& S, const Epi& E) {
  const int tid = tid_opaque(), wid = __builtin_amdgcn_readfirstlane(tid >> 6), lane = tid & 63, wr = wid >> 2, wc = wid & 3, fr = lane & 15, fq = lane >> 4;
  const int nt = K / BK;
  unsigned voffA[2], voffB[2];
#pragma unroll
  for (int i = 0; i < 2; ++i) { int R, C; stage_rc(tid * 16 + i * 8192, R, C); const int Rb = (R & ~31) + perm32(R & 31);
    voffA[i] = (unsigned)(R * lda + C) * 2u; voffB[i] = (unsigned)(Rb * ldb + C) * 2u; }
  const size_t kstep = (size_t)(BK * 2);
  const size_t hstepA = (size_t)(MT * 32) * lda * 2, hstepB = (size_t)HALF * ldb * 2;
  const unsigned ldsw = (unsigned)wid * 1024u;
  const int aoff = lds_byte(wr * (MT * 16) + fr, fq * 8), boff = lds_byte(wc * 32 + fr, fq * 8);
#define PG8_SA(b, h) (((b) * 2 + (h)) * HTB)
#define PG8_SB(b, h) ((4 + (b) * 2 + (h)) * HTB)
#define PG8_STAGE(bufoff, gbase, voff) do { _Pragma("unroll") for (int _i = 0; _i < 2; ++_i) \
    __builtin_amdgcn_global_load_lds((const unsigned*)((const char*)(gbase) + (voff)[_i]), (LAS unsigned*)(lds + (bufoff) + ldsw + _i * 8192), 16, 0, 0); } while (0)
#define PG8_STAGEA(bufoff, gbase, voff) do { _Pragma("unroll") for (int _i = 0; _i < 2; ++_i) if (MT == 4 || _i == 0 || wid < 4) \
    __builtin_amdgcn_global_load_lds((const unsigned*)((const char*)(gbase) + (voff)[_i]), (LAS unsigned*)(lds + (bufoff) + ldsw + _i * 8192), 16, 0, 0); } while (0)
#define PG8_LDA(dst, b, h) do { _Pragma("unroll") for (int m = 0; m < MT; ++m) _Pragma("unroll") for (int k = 0; k < 2; ++k) dst[m][k] = *(const LAS bf16x8*)(lds + PG8_SA(b, h) + aoff + m * 2048 + k * 1024); } while (0)
#define PG8_LDB(dst, b, h) do { _Pragma("unroll") for (int n = 0; n < 2; ++n) _Pragma("unroll") for (int k = 0; k < 2; ++k) dst[n][k] = *(const LAS bf16x8*)(lds + PG8_SB(b, h) + boff + n * 2048 + k * 1024); } while (0)
#define PG8_MMA(ai, bj, At, Bt) do { __builtin_amdgcn_s_setprio(1); _Pragma("unroll") for (int m = 0; m < MT; ++m) _Pragma("unroll") for (int n = 0; n < 2; ++n) _Pragma("unroll") for (int k = 0; k < 2; ++k) \
    acc[ai][bj][m][n] = __builtin_amdgcn_mfma_f32_16x16x32_bf16(Bt[n][k], At[m][k], acc[ai][bj][m][n], 0, 0, 0); __builtin_amdgcn_s_setprio(0); } while (0)
#define PG8_WAIT_V(n) asm volatile("s_waitcnt vmcnt(" #n ")" ::: "memory")
#define PG8_WAIT_L(n) asm volatile("s_waitcnt lgkmcnt(" #n ")" ::: "memory")
#define PG8_WAIT_VA do { if constexpr (MT == 4) asm volatile("s_waitcnt vmcnt(4)" ::: "memory"); else asm volatile("s_waitcnt vmcnt(3)" ::: "memory"); } while (0)
#define PG8_WAIT_VB do { if constexpr (MT == 4) asm volatile("s_waitcnt vmcnt(6)" ::: "memory"); else asm volatile("s_waitcnt vmcnt(5)" ::: "memory"); } while (0)
#define PG8_WAIT_LB do { if constexpr (MT == 4) asm volatile("s_waitcnt lgkmcnt(8)" ::: "memory"); else asm volatile("s_waitcnt lgkmcnt(6)" ::: "memory"); } while (0)
#define PG8_BAR __builtin_amdgcn_s_barrier()
#define PG8_SCHED __builtin_amdgcn_sched_barrier(0)
  GUnit cur, nxt; int ui = 0;
  if (!S.next(0, cur)) return;
  f32x4 acc[2][2][MT][2];
#pragma unroll
  for (int a = 0; a < 2; ++a)
#pragma unroll
    for (int b = 0; b < 2; ++b)
#pragma unroll
      for (int m = 0; m < MT; ++m)
#pragma unroll
        for (int n = 0; n < 2; ++n) acc[a][b][m][n] = (f32x4){0.f, 0.f, 0.f, 0.f};
  bf16x8 At[MT][2], B0[2][2], B1[2][2];
  const char* cA = cur.A; const char* cB = cur.B;
  PG8_STAGE(PG8_SB(0, 0), cB, voffB); PG8_STAGEA(PG8_SA(0, 0), cA, voffA); PG8_STAGE(PG8_SB(0, 1), cB + hstepB, voffB); PG8_STAGEA(PG8_SA(0, 1), cA + hstepA, voffA);
  if (wr == 1) PG8_BAR;
  PG8_WAIT_VA; PG8_BAR;
  PG8_STAGE(PG8_SB(1, 0), cB + kstep, voffB); PG8_STAGEA(PG8_SA(1, 0), cA + kstep, voffA); PG8_STAGE(PG8_SB(1, 1), cB + hstepB + kstep, voffB);
  PG8_WAIT_VB; PG8_BAR;
  for (;;) {
    const bool has_next = S.next(ui + 1, nxt);
    const char* nA = has_next ? nxt.A : cA; const char* nB = has_next ? nxt.B : cB;
    for (int t = 0; t < nt; t += 2) {
      const bool last = (t == nt - 2);
      const char* a1 = cA + (size_t)(t + 1) * kstep;
      const char* a2 = last ? nA : cA + (size_t)(t + 2) * kstep; const char* b2 = last ? nB : cB + (size_t)(t + 2) * kstep;
      const char* a3 = a2 + kstep; const char* b3 = b2 + kstep;
      PG8_LDB(B0, 0, 0); PG8_SCHED; PG8_LDA(At, 0, 0); PG8_STAGEA(PG8_SA(1, 1), a1 + hstepA, voffA);
      PG8_WAIT_LB; PG8_BAR; PG8_WAIT_L(0); PG8_MMA(0, 0, At, B0); PG8_BAR; PG8_SCHED;
      PG8_LDB(B1, 0, 1); PG8_STAGE(PG8_SB(0, 0), b2, voffB);
      PG8_BAR; PG8_WAIT_L(0); PG8_MMA(0, 1, At, B1); PG8_BAR;
      PG8_LDA(At, 0, 1); PG8_STAGEA(PG8_SA(0, 0), a2, voffA);
      PG8_BAR; PG8_WAIT_L(0); PG8_MMA(1, 0, At, B0); PG8_BAR; PG8_SCHED;
      PG8_STAGE(PG8_SB(0, 1), b2 + hstepB, voffB);
      PG8_WAIT_VB; PG8_BAR; PG8_MMA(1, 1, At, B1); PG8_BAR;
      PG8_LDB(B0, 1, 0); PG8_SCHED; PG8_LDA(At, 1, 0); PG8_STAGEA(PG8_SA(0, 1), a2 + hstepA, voffA);
      PG8_WAIT_LB; PG8_BAR; PG8_WAIT_L(0); PG8_MMA(0, 0, At, B0); PG8_BAR; PG8_SCHED;
      PG8_LDB(B1, 1, 1); PG8_STAGE(PG8_SB(1, 0), b3, voffB);
      PG8_BAR; PG8_WAIT_L(0); PG8_MMA(0, 1, At, B1); PG8_BAR;
      PG8_LDA(At, 1, 1); PG8_STAGEA(PG8_SA(1, 0), a3, voffA);
      PG8_BAR; PG8_WAIT_L(0); PG8_MMA(1, 0, At, B0); PG8_BAR; PG8_SCHED;
      PG8_STAGE(PG8_SB(1, 1), b3 + hstepB, voffB);
      PG8_WAIT_VB; PG8_BAR; PG8_MMA(1, 1, At, B1); PG8_BAR;
    }
    if constexpr (!Epi::AFTER_DRAIN) E(acc, cur, wr, wc, fr, fq);
    if (!has_next) break;
#pragma unroll
    for (int a = 0; a < 2; ++a)
#pragma unroll
      for (int b = 0; b < 2; ++b)
#pragma unroll
        for (int m = 0; m < MT; ++m)
#pragma unroll
          for (int n = 0; n < 2; ++n) acc[a][b][m][n] = (f32x4){0.f, 0.f, 0.f, 0.f};
    cur = nxt; cA = nA; cB = nB; ++ui;
  }
  PG8_WAIT_V(0);
  if (wr == 0) PG8_BAR;
  PG8_BAR;
  if constexpr (Epi::AFTER_DRAIN) E.fused(acc, cur, wr, wc, fr, fq, lds);
#undef PG8_SA
#undef PG8_SB
#undef PG8_STAGE
#undef PG8_STAGEA
#undef PG8_WAIT_VA
#undef PG8_WAIT_VB
#undef PG8_WAIT_LB
#undef PG8_LDA
#undef PG8_LDB
#undef PG8_MMA
#undef PG8_WAIT_V
#undef PG8_WAIT_L
#undef PG8_BAR
#undef PG8_SCHED
}

struct TileSched {
  const u16* A; const u16* B; int lda, ldb, nM, nN, G, c, bm;
  __device__ __forceinline__ bool next(int i, GUnit& u) const {
    int pm, pn; if (!tile_order(i * G + c, nM, nN, pm, pn)) return false;
    u.pm = pm; u.pn = pn; u.aux = 0; u.A = (const char*)(A + (size_t)pm * bm * lda); u.B = (const char*)(B + (size_t)pn * BM * ldb); return true;
  }
};
struct BranchSched {
  const u16* brin; const u16* wbr; int G, c;
  __device__ __forceinline__ bool next(int i, GUnit& u) const {
    int pm, pn; const int ti = i / 3, br = i - ti * 3; if (!tile_order(ti * G + c, 64, 4, pm, pn)) return false;
    u.pm = pm; u.pn = pn; u.aux = br; u.A = (const char*)(brin + (size_t)br * NTOK * 512 + (size_t)pm * 192 * 512); u.B = (const char*)(wbr + (size_t)br * D * 512 + (size_t)pn * BM * 512); return true;
  }
};
struct OneSched { GUnit u; __device__ __forceinline__ bool next(int i, GUnit& o) const { if (i != 0) return false; o = u; return true; } };

__device__ __forceinline__ bf16x8 pack8(const f32x4& a, const f32x4& b) {
  u32x4 o; o[0] = cvt_pk_bf16(a[0], a[1]); o[1] = cvt_pk_bf16(a[2], a[3]); o[2] = cvt_pk_bf16(b[0], b[1]); o[3] = cvt_pk_bf16(b[2], b[3]); return __builtin_bit_cast(bf16x8, o);
}
__device__ __forceinline__ bf16x4 pack4(float a, float b, float c, float d) { u32x2 o; o[0] = cvt_pk_bf16(a, b); o[1] = cvt_pk_bf16(c, d); return __builtin_bit_cast(bf16x4, o); }

struct EpiSwiglu {
  static constexpr bool AFTER_DRAIN = false;
  u16* h;
  __device__ __forceinline__ void operator()(const f32x4 (&acc)[2][2][4][2], const GUnit& u, int wr, int wc, int fr, int fq) const {
    const int row0 = u.pm * BM + wr * 64 + fr, col0 = u.pn * 128 + wc * 32 + fq * 8;
#pragma unroll
    for (int ai = 0; ai < 2; ++ai)
#pragma unroll
      for (int m = 0; m < 4; ++m) {
        f32x4 r[2];
#pragma unroll
        for (int n = 0; n < 2; ++n)
#pragma unroll
          for (int j = 0; j < 4; ++j) { const float a = acc[ai][0][m][n][j], g = acc[ai][1][m][n][j]; r[n][j] = a * sigmoidf_(a) * g; }
        *(bf16x8*)(h + (size_t)(row0 + ai * HALF + m * 16) * DFF + col0) = pack8(r[0], r[1]);
      }
  }
};
struct EpiResidNorm {
  static constexpr bool AFTER_DRAIN = true;
  const Params& p; int l, kind;
  __device__ __forceinline__ void fused(f32x4 (&acc)[2][2][3][2], const GUnit& un, int wr, int wc, int fr, int fq, LAS unsigned char* lds) const {
    const bool isout = kind == 8, fin = (kind == 11 && l == 1), firstres = (l == 0 && kind == 2);
    const int use = l * 3 + (kind == 2 ? 0 : (isout ? 1 : 2)), nk = kind == 2 ? 1 : (isout ? 2 : 0), nl = kind == 11 ? l + 1 : l;
    float* x = p.out; const float* xc = firstres ? p.x_prompt : p.out; const float* xl = firstres ? p.x_sample : p.out + (size_t)NCTX * D;
    const float* gatev = p.mods + (size_t)l * 5 * 9216 + (isout ? 5 : (kind == 2 ? 2 : 8)) * 1024; const float coef = isout ? 1.0f : 0.5f;
    u16* u = p.u; const float* gn = fin ? p.g_final : p.g_norm + ((size_t)nl * 3 + nk) * D; const float* mdn = fin ? p.mods : p.mods + (size_t)nl * 5 * 9216 + nk * 3 * 1024;
    float* part = p.part + (size_t)use * 64 * 4 * 192; unsigned* cnt = p.ctr + XB_PCNT + use * 64;
    const int tid = tid_opaque();
    const int col0 = un.pn * BM + wc * 32 + fq * 8;
    LAS float* rp = (LAS float*)lds; LAS float* rs = rp + 1024;
#pragma unroll
    for (int ai = 0; ai < 2; ++ai)
#pragma unroll
      for (int m = 0; m < 3; ++m) {
        const int rl = ai * 96 + wr * 48 + m * 16 + fr; const int row = un.pm * 192 + rl;
        const float* xs = (row < NCTX ? xc + (size_t)row * D : xl + (size_t)(row - NCTX) * D) + col0;
        const float* gp = gatev + cond_of(row) * 9216 + col0;
        f32x4 xv[2][2], g[2][2];
#pragma unroll
        for (int bj = 0; bj < 2; ++bj)
#pragma unroll
          for (int n = 0; n < 2; ++n) { xv[bj][n] = *(const f32x4*)(xs + bj * HALF + n * 4); g[bj][n] = *(const f32x4*)(gp + bj * HALF + n * 4); }
        float s = 0.f;
#pragma unroll
        for (int bj = 0; bj < 2; ++bj)
#pragma unroll
          for (int n = 0; n < 2; ++n) { const f32x4 xn = xv[bj][n] + coef * g[bj][n] * acc[ai][bj][m][n]; acc[ai][bj][m][n] = xn;
            s += xn[0] * xn[0] + xn[1] * xn[1] + xn[2] * xn[2] + xn[3] * xn[3];
            if (!fin) *(f32x4*)(x + (size_t)row * D + col0 + bj * HALF + n * 4) = xn; }
        s += __shfl_xor(s, 16); s += __shfl_xor(s, 32);
        if (fq == 0) rp[rl * 4 + wc] = s;
      }
    __syncthreads();
    float* slot = part + (size_t)(un.pm * 4) * 192;
    if (tid < 192) { const float t = (rp[tid * 4] + rp[tid * 4 + 1]) + (rp[tid * 4 + 2] + rp[tid * 4 + 3]);
      __hip_atomic_store(slot + un.pn * 192 + tid, t, __ATOMIC_RELAXED, __HIP_MEMORY_SCOPE_AGENT); }
    asm volatile("s_waitcnt vmcnt(0)" ::: "memory");
    __syncthreads();
    if (tid == 0) {
      __hip_atomic_fetch_add(cnt + un.pm, 1u, __ATOMIC_RELAXED, __HIP_MEMORY_SCOPE_AGENT);
      unsigned sp = 0;
      while (__hip_atomic_load(cnt + un.pm, __ATOMIC_RELAXED, __HIP_MEMORY_SCOPE_AGENT) < 4u) { __builtin_amdgcn_s_sleep(1); if (++sp > (1u << 22)) break; }
    }
    __syncthreads();
    if (tid < 192) { float t = 0.f;
#pragma unroll
      for (int q = 0; q < 4; ++q) t += __hip_atomic_load(slot + q * 192 + tid, __ATOMIC_RELAXED, __HIP_MEMORY_SCOPE_AGENT);
      rs[tid] = rsqrtf(t * (1.f / 1024.f) + EPS); }
    __syncthreads();
    const float* gnp = gn + col0;
    f32x4 gw0[2][2];
#pragma unroll
    for (int bj = 0; bj < 2; ++bj)
#pragma unroll
      for (int n = 0; n < 2; ++n) gw0[bj][n] = *(const f32x4*)(gnp + bj * HALF + n * 4);
#pragma unroll
    for (int ai = 0; ai < 2; ++ai)
#pragma unroll
      for (int m = 0; m < 3; ++m) { const int rl = ai * 96 + wr * 48 + m * 16 + fr; const float rstd = rs[rl]; const int row = un.pm * 192 + rl; const unsigned eo = (unsigned)(row * D + col0);
        if (fin) {
#pragma unroll
          for (int bj = 0; bj < 2; ++bj) { *(f32x4*)(x + (eo + bj * HALF)) = acc[ai][bj][m][0] * rstd * gw0[bj][0]; *(f32x4*)(x + (eo + bj * HALF + 4)) = acc[ai][bj][m][1] * rstd * gw0[bj][1]; }
        } else { const float* md = mdn + cond_of(row) * 9216 + col0;
#pragma unroll
          for (int bj = 0; bj < 2; ++bj) { f32x4 o[2];
#pragma unroll
            for (int n = 0; n < 2; ++n) o[n] = acc[ai][bj][m][n] * rstd * gw0[bj][n] * (1.f + *(const f32x4*)(md + 1024 + bj * HALF + n * 4)) + *(const f32x4*)(md + bj * HALF + n * 4);
            *(bf16x8*)(u + (eo + bj * HALF)) = pack8(o[0], o[1]); } } }
  }
};
struct EpiBig {
  static constexpr bool AFTER_DRAIN = false;
  u16 *zA, *gb, *Yt; float* out; int l; float* gate; const float* bmg;
  __device__ __forceinline__ void operator()(const f32x4 (&acc)[2][2][4][2], const GUnit& u, int wr, int wc, int fr, int fq) const {
    const int row0 = u.pm * BM + wr * 64 + fr; const int pn = u.pn; const int colw = wc * 32 + fq * 8;
#pragma unroll
    for (int ai = 0; ai < 2; ++ai)
#pragma unroll
      for (int m = 0; m < 4; ++m) {
        const int row = row0 + ai * HALF + m * 16;
#pragma unroll
        for (int bj = 0; bj < 2; ++bj) {
          const int c = pn * BM + bj * HALF + colw;
          f32x4 v0 = acc[ai][bj][m][0], v1 = acc[ai][bj][m][1];
          if (pn < 6) {
            *(bf16x8*)(zA + (size_t)row * ZLD + c) = pack8(v0, v1);
            if (pn >= 2 && row < NCTX) {
              const int cc = (c - 512) & 511, hh = cc >> 7, d = cc & 127, b = row >> 8, t = row & 255;
              float* o = out + (pn < 4 ? O_CK : O_CV) + ((((size_t)(b * 2 + l) * 4 + hh) * 256 + t) * 128 + d);
              *(f32x4*)o = v0; *(f32x4*)(o + 4) = v1;
            }
          } else if (pn < 10) {
            const int cp = c - 1536, g = cp >> 8, j = cp & 255, cs = j >> 7, np = j & 127;
            u16* base;
            if (row < NCTX) { const int b = row >> 8, t = row & 255; base = Yt + (size_t)b * 512 * 512 + (size_t)(g * 128 + np) * 512 + cs * 256 + t;
#pragma unroll
              for (int q = 0; q < 4; ++q) { base[(size_t)q * 512] = f2bf(v0[q]); base[(size_t)(q + 4) * 512] = f2bf(v1[q]); }
            } else { const int rr = row - NCTX, b = rr >> 10, t = rr & 1023; base = Yt + (size_t)32 * 512 * 512 + (size_t)b * 512 * 2048 + (size_t)(g * 128 + np) * 2048 + cs * 1024 + t;
#pragma unroll
              for (int q = 0; q < 4; ++q) { base[(size_t)q * 2048] = f2bf(v0[q]); base[(size_t)(q + 4) * 2048] = f2bf(v1[q]); }
            }
          } else if (pn < 18) {
            if (pn == 12 || pn == 13) { v0 *= 0.08838834764831845f; v1 *= 0.08838834764831845f; }
            if (pn >= 16) {
#pragma unroll
              for (int q = 0; q < 4; ++q) { v0[q] = sigmoidf_(v0[q]); v1[q] = sigmoidf_(v1[q]); }
            }
            *(bf16x8*)(zA + (size_t)row * ZLD + (c - 1024)) = pack8(v0, v1);
          } else if (pn < 30) {
#pragma unroll
            for (int q = 0; q < 4; ++q) { v0[q] = sigmoidf_(v0[q]); v1[q] = sigmoidf_(v1[q]); }
            { unsigned w0 = 0u, w1 = 0u;
#pragma unroll
              for (int q = 0; q < 4; ++q) { w0 |= ((unsigned)(v0[q] * 255.f + 0.5f)) << (8 * q); w1 |= ((unsigned)(v1[q] * 255.f + 0.5f)) << (8 * q); }
              u32x2 w; w[0] = w0; w[1] = w1; *(u32x2*)((unsigned char*)gb + (size_t)row * GBLD + (c - 4608)) = w; }
          } else if (bj == 0 && wc == 0 && fq < 2) {
#pragma unroll
            for (int q = 0; q < 8; ++q) { const int j = fq * 8 + q; float a = (q < 4 ? v0[q] : v1[q - 4]) + bmg[l * 16 + j];
              if ((j >> 2) & 1) a = fminf(a, 0.f) - log1pf(__expf(-fabsf(a)));
              gate[(size_t)row * 16 + j] = a; }
          }
        }
      }
  }
};
struct EpiBranch {
  static constexpr bool AFTER_DRAIN = false;
  u16* tmp; const u16* gb; u16* merged;
  __device__ __forceinline__ void operator()(const f32x4 (&acc)[2][2][3][2], const GUnit& u, int wr, int wc, int fr, int fq) const {
    const int row0 = u.pm * 192 + wr * 48 + fr, col0 = u.pn * BM + wc * 32 + fq * 8; const int br = u.aux;
    u16* dst = br < 2 ? tmp : merged;
#pragma unroll
    for (int ai = 0; ai < 2; ++ai) {
      u32x2 g8[3][2]; bf16x8 t8[3][2];
#pragma unroll
      for (int m = 0; m < 3; ++m)
#pragma unroll
        for (int bj = 0; bj < 2; ++bj) { const int row = row0 + ai * 96 + m * 16, c = col0 + bj * HALF;
          g8[m][bj] = *(const u32x2*)((const unsigned char*)gb + (size_t)row * GBLD + br * D + c);
          if (br > 0) t8[m][bj] = *(const bf16x8*)(tmp + (size_t)row * D + c); }
#pragma unroll
      for (int m = 0; m < 3; ++m)
#pragma unroll
        for (int bj = 0; bj < 2; ++bj) { const int row = row0 + ai * 96 + m * 16, c = col0 + bj * HALF;
          f32x4 r0, r1;
#pragma unroll
          for (int q = 0; q < 4; ++q) { r0[q] = (float)((g8[m][bj][0] >> (8 * q)) & 0xffu) * (1.f / 255.f) * acc[ai][bj][m][0][q]; r1[q] = (float)((g8[m][bj][1] >> (8 * q)) & 0xffu) * (1.f / 255.f) * acc[ai][bj][m][1][q]; }
          if (br > 0) {
#pragma unroll
            for (int q = 0; q < 4; ++q) { r0[q] += bf2f((u16)t8[m][bj][q]); r1[q] += bf2f((u16)t8[m][bj][q + 4]); } }
          *(bf16x8*)(dst + (size_t)row * D + c) = pack8(r0, r1); }
    }
  }
};
struct EpiFour {
  static constexpr bool AFTER_DRAIN = false;
  u16* fo; float scale;
  __device__ __forceinline__ void operator()(const f32x4 (&acc)[2][2][4][2], const GUnit& u, int wr, int wc, int fr, int fq) const {
    const int row0 = u.pm + wr * 64 + fr, col0 = u.pn * BM + wc * 32 + fq * 8;
#pragma unroll
    for (int ai = 0; ai < 2; ++ai)
#pragma unroll
      for (int m = 0; m < 4; ++m)
#pragma unroll
        for (int bj = 0; bj < 2; ++bj)
          *(bf16x8*)(fo + (size_t)(row0 + ai * HALF + m * 16) * 512 + col0 + bj * HALF) = pack8(acc[ai][bj][m][0] * scale, acc[ai][bj][m][1] * scale);
  }
};

struct TrJob { const float* src; u16* dst; int lds_, ldd, k0, ns0, nd0, mode; };
__device__ __forceinline__ void tr_decode(const Params& p, int l, int j, TrJob& t) {
  t.mode = 0;
  if (j < 352 || (j >= 528 && j < 880)) { const bool second = j >= 528; const int q = second ? j - 528 : j; const int kt = q / 22, nb = q % 22;
    t.src = (second ? p.w_ffn2_in : p.w_ffn1_in) + (size_t)l * D * 2 * DFF; t.dst = second ? p.wt_ffn2_in : p.wt_ffn1_in; t.lds_ = 2 * DFF; t.ldd = D; t.k0 = kt * 64; t.ns0 = nb * 256; t.nd0 = 0; t.mode = 1; }
  else if (j < 528 || (j >= 880 && j < 1056)) { const bool second = j >= 880; const int q = second ? j - 880 : j - 352; const int kt = q >> 2, nb = q & 3;
    t.src = (second ? p.w_ffn2_out : p.w_ffn1_out) + (size_t)l * DFF * D; t.dst = second ? p.wt_ffn2_out : p.wt_ffn1_out; t.lds_ = D; t.ldd = DFF; t.k0 = kt * 64; t.ns0 = nb * 256; t.nd0 = t.ns0; }
  else if (j < 1280) { const int q = j - 1056, kt = q / 14, nb = q % 14; t.src = p.w_in + (size_t)l * D * PIN; t.dst = p.wt_big; t.lds_ = PIN; t.ldd = D; t.k0 = kt * 64;
    if (nb < 6) { t.ns0 = nb * 256; t.nd0 = t.ns0; } else { t.ns0 = 2048 + (nb - 6) * 256; t.nd0 = t.ns0 + 512; } }
  else if (j < 1472) { const int q = j - 1280, kt = q / 12, nb = q % 12; t.src = p.w_branch_gate + (size_t)l * D * 3 * D; t.dst = p.wt_big; t.lds_ = 3 * D; t.ldd = D; t.k0 = kt * 64; t.ns0 = nb * 256; t.nd0 = 4608 + t.ns0; }
  else if (j < 1568) { const int q = j - 1472, br = q >> 5, jj = q & 31, kt = jj >> 2, nb = jj & 3;
    t.src = (br == 0 ? p.w_br_attn : br == 1 ? p.w_br_four : p.w_br_mlstm) + (size_t)l * 512 * D; t.dst = p.wt_br + (size_t)br * D * 512; t.lds_ = D; t.ldd = 512; t.k0 = kt * 64; t.ns0 = nb * 256; t.nd0 = t.ns0; }
  else { const int q = j - 1568, kt = q >> 2, nb = q & 3; t.src = p.w_out + (size_t)l * D * D; t.dst = p.wt_out; t.lds_ = D; t.ldd = D; t.k0 = kt * 64; t.ns0 = nb * 256; t.nd0 = t.ns0; }
}
__device__ __forceinline__ void tr_load(const TrJob& t, int tid, f32x4 (&r)[8]) {
#pragma unroll
  for (int i = 0; i < 8; ++i) { const int idx = tid + i * 512, kk = idx >> 6, c4 = idx & 63; r[i] = *(const f32x4*)(t.src + (size_t)(t.k0 + kk) * t.lds_ + t.ns0 + c4 * 4); }
}

__device__ void wf_job(const Params& p, int l, int job, LAS float* sm) {
  const int tid = tid_opaque();
  const int g = job >> 5, kb = (job >> 1) & 15, jh = job & 1; LAS float* W = sm; LAS float* ct = sm + 64 * 129;
  __syncthreads();
  for (int i = tid; i < 64 * 32; i += 512) { const int kk = i >> 5, c4 = i & 31;
    const float4 v = *(const float4*)(p.w_in + ((size_t)l * D + kb * 64 + kk) * PIN + 1536 + g * 128 + c4 * 4);
    LAS float* s = W + kk * 129 + c4 * 4; s[0] = v.x; s[1] = v.y; s[2] = v.z; s[3] = v.w; }
  if (tid < 128) ct[tid] = cospif((float)tid / 64.f);
  __syncthreads();
  const int kk = tid & 63, jg = tid >> 6; float a[16];
#pragma unroll
  for (int q = 0; q < 16; ++q) a[q] = 0.f;
  const int jbase = jh * 128 + jg * 16;
  for (int c = 0; c < 128; ++c) { const float w = W[kk * 129 + c];
#pragma unroll
    for (int q = 0; q < 16; ++q) { const int j = jbase + q; const int idx = jh ? ((c * (j - 128) - 32) & 127) : ((c * j) & 127); a[q] += w * ct[idx]; } }
#pragma unroll
  for (int q = 0; q < 16; ++q) p.wt_big[(size_t)(1536 + g * 256 + jbase + q) * D + kb * 64 + kk] = f2bf(a[q]);
}

__device__ void mods_job(const Params& p, int job, LAS float* sm) {
  const int tid = tid_opaque();
  const int l = job / 72, cb = job % 72; LAS float* sc = sm; LAS float* part = sm + 5 * 1024;
  __syncthreads();
  for (int i = tid; i < 5 * 1024; i += 512) { const int ci = i >> 10, k = i & 1023; const float v = ci == 0 ? p.c_ctx[k] : p.c[(ci - 1) * D + k]; sc[i] = v * sigmoidf_(v); }
  __syncthreads();
  const int cg4 = tid & 31, kp = tid >> 5; f32x4 a[5];
#pragma unroll
  for (int ci = 0; ci < 5; ++ci) a[ci] = (f32x4){0.f, 0.f, 0.f, 0.f};
  const float* wp = p.w_ada + ((size_t)l * D + kp * 64) * 9216 + cb * 128 + cg4 * 4;
#pragma unroll 8
  for (int k = 0; k < 64; ++k) { const f32x4 w = *(const f32x4*)(wp + (size_t)k * 9216);
#pragma unroll
    for (int ci = 0; ci < 5; ++ci) a[ci] += sc[ci * 1024 + kp * 64 + k] * w; }
#pragma unroll
  for (int ci = 0; ci < 5; ++ci)
#pragma unroll
    for (int q = 0; q < 4; ++q) part[(kp * 5 + ci) * 128 + cg4 * 4 + q] = a[ci][q];
  __syncthreads();
  for (int o = tid; o < 640; o += 512) { const int ci = o >> 7, cc = o & 127; float s = p.b_ada[(size_t)l * 9216 + cb * 128 + cc];
    for (int q = 0; q < 16; ++q) s += part[(q * 5 + ci) * 128 + cc];
    p.mods[((size_t)l * 5 + ci) * 9216 + cb * 128 + cc] = s; }
}

__device__ void prep_seg(const Params& p, int l, int seg, LAS unsigned char* lds, volatile LAS int* segdone) {
  if (segdone[l * 2 + seg]) return;
  const int tid = tid_opaque(); LAS float* sm = (LAS float*)lds; LAS int* s_job = (LAS int*)(lds + 131072 - 16);
  const int qi = 8 + l * 2 + seg;
  const int npre = seg ? 129 : (l == 0 ? 144 : 0), trofs = seg ? 528 : 0, ntr = seg ? 1104 : 528;
  const int trbase = npre, njobs = npre + ntr;
  int job;
  for (;;) {
    __syncthreads();
    if (tid == 0) *s_job = (int)atomicAdd(p.ctr + XB_CTR + qi, 1u);
    __syncthreads();
    job = *s_job;
    if (job >= njobs && tid == 0) segdone[l * 2 + seg] = 1;
    if (job >= trbase) break;
    if (seg && job == 128) { for (int i = tid; i < 16 * 1024; i += 512) { const int j = i >> 10, k = i & 1023; p.wt_big[(size_t)(7680 + j) * D + k] = f2bf(p.w_in[((size_t)l * D + k) * PIN + 4096 + j]); } }
    else if (seg) wf_job(p, l, job, sm); else mods_job(p, job, sm);
  }
  if (job >= njobs) return;
  f32x4 r[8]; TrJob t;
  tr_decode(p, l, job - trbase + trofs, t); tr_load(t, tid, r);
  for (;;) {
    __syncthreads();
#pragma unroll
    for (int i = 0; i < 8; ++i) { const int idx = tid + i * 512, kk = idx >> 6, c4 = idx & 63; LAS float* s = sm + kk * 257 + c4 * 4; s[0] = r[i][0]; s[1] = r[i][1]; s[2] = r[i][2]; s[3] = r[i][3]; }
    if (tid == 0) *s_job = (int)atomicAdd(p.ctr + XB_CTR + qi, 1u);
    __syncthreads();
    const int nextjob = *s_job; const TrJob cur = t;
    if (nextjob >= njobs && tid == 0) segdone[l * 2 + seg] = 1;
    if (nextjob < njobs) { tr_decode(p, l, nextjob - trbase + trofs, t); tr_load(t, tid, r); }
#pragma unroll
    for (int i = 0; i < 4; ++i) { const int unit = tid + i * 512, nn = unit >> 3, ch = unit & 7; bf16x8 o;
#pragma unroll
      for (int q = 0; q < 8; ++q) o[q] = (short)f2bf(sm[(ch * 8 + q) * 257 + nn]);
      int drow;
      if (cur.mode == 1) { const int col = cur.ns0 + nn, isg = col >= DFF, hid = col - isg * DFF; drow = (hid >> 7) * 256 + isg * 128 + (hid & 127); } else drow = cur.nd0 + nn;
      *(bf16x8*)(cur.dst + (size_t)drow * cur.ldd + cur.k0 + ch * 8) = o; }
    if (nextjob >= njobs) break;
  }
}

__device__ void phase0(const Params& p, LAS unsigned char* lds) {
  const int tid = tid_opaque(); const int G = gridDim.x;
  if (blockIdx.x == 0 && tid >= 64 && tid < 66) { const int l = tid - 64; const float* lp = p.attn_lambda + l * 256; float s1 = 0.f, s2 = 0.f;
    for (int i = 0; i < 64; ++i) { s1 += lp[i] * lp[64 + i]; s2 += lp[128 + i] * lp[192 + i]; }
    p.lam[l] = expf(s1) - expf(s2) + lam_init_of(l); }
  const int gtid = blockIdx.x * 512 + tid, gn = G * 512;
  for (int i = gtid; i < 1024 * 2048; i += gn) { const int tp = i >> 11, col = i & 2047, t = col & 1023, s = col >> 10; const int r = (t * tp) & 1023; const float x = (float)r / 512.f;
    p.cs1024[i] = f2bf(s ? -sinpif(x) : cospif(x)); }
  for (int i = gtid; i < 256 * 512; i += gn) { const int tp = i >> 9, col = i & 511, t = col & 255, s = col >> 8; const int r = (t * tp) & 255; const float x = (float)r / 128.f;
    p.cs256[i] = f2bf(s ? -sinpif(x) : cospif(x)); }
  for (int i = gtid; i < 1024 * 32; i += gn) { const int t = i >> 5, pp = i & 31; const float pos = pp < 16 ? (float)(t >> 6) : (float)(t & 63);
    const float inv = powf(10000.f, -(float)(pp & 15) / 16.f); float s, c; sincosf(pos * inv, &s, &c); p.rope[2 * i] = c; p.rope[2 * i + 1] = s; }
}

__device__ __forceinline__ float wave_sum(float v) {
#pragma unroll
  for (int o = 32; o >= 1; o >>= 1) v += __shfl_xor(v, o);
  return v;
}
__device__ void norm_phase(const Params& p, int l, int which, LAS unsigned char* lds) {
  const int tid = tid_opaque(), wid = tid >> 6, lane = tid & 63; const bool gates = which == 1;
  LAS float* Wg = (LAS float*)lds; LAS float* ur = Wg + 16384 + wid * 1024;
  if (gates) { __syncthreads();
    for (int i = tid; i < 4096; i += 512) { const int k = i >> 2, q = i & 3; const float4 v = *(const float4*)(p.w_in + ((size_t)l * D + k) * PIN + 4096 + q * 4);
      LAS float* s = Wg + k * 16 + q * 4; s[0] = v.x; s[1] = v.y; s[2] = v.z; s[3] = v.w; }
    __syncthreads(); }
  float* X = p.out; const bool first = (l == 0 && which == 0);
  const float* Xc = first ? p.x_prompt : X; const float* Xl = first ? p.x_sample : X + (size_t)NCTX * D;
#define XROW(r) ((r) < NCTX ? Xc + (size_t)(r) * D : Xl + (size_t)((r) - NCTX) * D)
  f32x4 v[4], vn[4];
  { const int rg0 = blockIdx.x; if (rg0 < NTOK / 8) { const float* xr = XROW(rg0 * 8 + wid);
#pragma unroll
      for (int i = 0; i < 4; ++i) v[i] = *(const f32x4*)(xr + i * 256 + lane * 4); } }
  for (int rg = blockIdx.x; rg < NTOK / 8; rg += gridDim.x) {
    const int row = rg * 8 + wid; float* xr = X + (size_t)row * D;
    const int rgn = rg + gridDim.x;
    if (rgn < NTOK / 8) { const float* xn = XROW(rgn * 8 + wid);
#pragma unroll
      for (int i = 0; i < 4; ++i) vn[i] = *(const f32x4*)(xn + i * 256 + lane * 4); }
    float ss = 0.f;
#pragma unroll
    for (int i = 0; i < 4; ++i) ss += v[i][0] * v[i][0] + v[i][1] * v[i][1] + v[i][2] * v[i][2] + v[i][3] * v[i][3];
    ss = wave_sum(ss); const float rstd = rsqrtf(ss * (1.f / 1024.f) + EPS);
    if (which == 3) {
#pragma unroll
      for (int i = 0; i < 4; ++i) { const f32x4 g = *(const f32x4*)(p.g_final + i * 256 + lane * 4); *(f32x4*)(xr + i * 256 + lane * 4) = v[i] * rstd * g; }
    } else {
      const float* md = p.mods + ((size_t)l * 5 + cond_of(row)) * 9216 + which * 3 * 1024; const float* gn = p.g_norm + ((size_t)l * 3 + which) * D;
#pragma unroll
      for (int i = 0; i < 4; ++i) { const int c = i * 256 + lane * 4; const f32x4 g = *(const f32x4*)(gn + c), sh = *(const f32x4*)(md + c), sc = *(const f32x4*)(md + 1024 + c);
        v[i] = v[i] * rstd * g * (1.f + sc) + sh;
        *(bf16x4*)(p.u + (size_t)row * D + c) = pack4(v[i][0], v[i][1], v[i][2], v[i][3]); }
      if (gates) {
        __syncthreads();
#pragma unroll
        for (int i = 0; i < 4; ++i) { LAS float* s = ur + i * 256 + lane * 4; s[0] = v[i][0]; s[1] = v[i][1]; s[2] = v[i][2]; s[3] = v[i][3]; }
        __syncthreads();
        const int j = lane & 15, kp = lane >> 4; float a = 0.f;
#pragma unroll 8
        for (int kk = 0; kk < 256; ++kk) a += ur[kk * 4 + kp] * Wg[(kk * 4 + kp) * 16 + j];
        a += __shfl_xor(a, 16); a += __shfl_xor(a, 32);
        if (lane < 16) { a += p.b_mgate[l * 16 + j]; if ((j >> 2) & 1) a = fminf(a, 0.f) - log1pf(__expf(-fabsf(a))); p.gate[(size_t)row * 16 + j] = a; }
      }
    }
#pragma unroll
    for (int i = 0; i < 4; ++i) v[i] = vn[i];
  }
}

__device__ void attn_item(const Params& p, int l, int item, LAS unsigned char* lds) {
  const int tid = tid_opaque(), wid = tid >> 6, lane = tid & 63, fr = lane & 15, fq = lane >> 4;
  const bool lat = item < 128; int b, h, qb, seqbase, nkt;
  if (lat) { b = item >> 5; h = (item >> 3) & 3; qb = item & 7; seqbase = NCTX + b * 1024; nkt = 20; }
  else { const int i2 = item - 128; b = i2 >> 3; h = (i2 >> 1) & 3; qb = i2 & 1; seqbase = b * 256; nkt = 4; }
  LAS unsigned char* Ks = lds; LAS unsigned char* VT = lds + 64 * 272;
  const float2* rope = (const float2*)p.rope;
  const int qtok = qb * 128 + wid * 16 + fr;
  bf16x8 Qf[2][2];
  { const u16* qp = p.zA + (size_t)(seqbase + qtok) * ZLD + h * 128;
#pragma unroll
    for (int i = 0; i < 2; ++i)
#pragma unroll
      for (int kk = 0; kk < 2; ++kk) Qf[i][kk] = *(const bf16x8*)(qp + i * 64 + kk * 32 + fq * 8);
    if (lat) {
#pragma unroll
      for (int j = 0; j < 8; ++j) { const float2 cs = rope[qtok * 32 + fq * 8 + j];
#pragma unroll
        for (int i = 0; i < 2; ++i) { const float x1 = bf2f((u16)Qf[i][0][j]), x2 = bf2f((u16)Qf[i][1][j]);
          Qf[i][0][j] = (short)f2bf(x1 * cs.x - x2 * cs.y); Qf[i][1][j] = (short)f2bf(x1 * cs.y + x2 * cs.x); } }
    }
  }
  f32x4 O[2][8];
#pragma unroll
  for (int i = 0; i < 2; ++i)
#pragma unroll
    for (int d = 0; d < 8; ++d) O[i][d] = (f32x4){0.f, 0.f, 0.f, 0.f};
  float mrun[2] = {-1e30f, -1e30f}, lrun[2] = {0.f, 0.f};
  const float sc = 0.125f * 1.4426950408889634f;
  const int skey = tid >> 3, ssub = tid & 7, smap = ssub >> 2, spg = ssub & 3, sd1 = smap * 64 + spg * 8;
  f32x4 kraw[4], vraw[4]; float2 rcs[8];
#define ATT_ISSUE(kt_) do { const int kt__ = (kt_); const int gk = kt__ * 64 + skey, gkv = kt__ * 64 + lane; \
    if (lat && kt__ < 4) { const float* kp = p.cache_k + ((((size_t)(b * 2 + l) * 4 + h) * 256 + gk) * 128) + sd1; \
      kraw[0] = *(const f32x4*)kp; kraw[1] = *(const f32x4*)(kp + 4); kraw[2] = *(const f32x4*)(kp + 32); kraw[3] = *(const f32x4*)(kp + 36); \
      const float* vp = p.cache_v + ((((size_t)(b * 2 + l) * 4 + h) * 256 + gkv) * 128) + wid * 16; \
      vraw[0] = *(const f32x4*)vp; vraw[1] = *(const f32x4*)(vp + 4); vraw[2] = *(const f32x4*)(vp + 8); vraw[3] = *(const f32x4*)(vp + 12); \
    } else { const int tok = lat ? gk - 256 : gk, tokv = lat ? gkv - 256 : gkv; const u16* kp = p.zA + (size_t)(seqbase + tok) * ZLD + 512 + h * 128 + sd1; \
      kraw[0] = *(const f32x4*)kp; kraw[1] = *(const f32x4*)(kp + 32); \
      const u16* vp = p.zA + (size_t)(seqbase + tokv) * ZLD + 1024 + h * 128 + wid * 16; vraw[0] = *(const f32x4*)vp; vraw[1] = *(const f32x4*)(vp + 8); \
      if (lat) { _Pragma("unroll") for (int j = 0; j < 8; ++j) rcs[j] = rope[tok * 32 + spg * 8 + j]; } } } while (0)
  ATT_ISSUE(0);
  for (int kt = 0; kt < nkt; ++kt) {
    __syncthreads();
    { float x1[8], x2[8];
      if (lat && kt < 4) {
#pragma unroll
        for (int j = 0; j < 4; ++j) { x1[j] = kraw[0][j]; x1[j + 4] = kraw[1][j]; x2[j] = kraw[2][j]; x2[j + 4] = kraw[3][j]; }
      } else { const bf16x8 a = __builtin_bit_cast(bf16x8, kraw[0]), bb = __builtin_bit_cast(bf16x8, kraw[1]);
#pragma unroll
        for (int j = 0; j < 8; ++j) { x1[j] = bf2f((u16)a[j]); x2[j] = bf2f((u16)bb[j]); }
        if (lat) {
#pragma unroll
          for (int j = 0; j < 8; ++j) { const float2 cs = rcs[j]; const float o1 = x1[j] * cs.x - x2[j] * cs.y, o2 = x1[j] * cs.y + x2[j] * cs.x; x1[j] = o1; x2[j] = o2; }
        }
      }
      bf16x8 o1, o2;
      { u32x4 t1, t2;
#pragma unroll
        for (int j = 0; j < 4; ++j) { t1[j] = cvt_pk_bf16(x1[2 * j], x1[2 * j + 1]); t2[j] = cvt_pk_bf16(x2[2 * j], x2[2 * j + 1]); }
        o1 = __builtin_bit_cast(bf16x8, t1); o2 = __builtin_bit_cast(bf16x8, t2); }
      *(LAS bf16x8*)(Ks + skey * 272 + sd1 * 2) = o1; *(LAS bf16x8*)(Ks + skey * 272 + (sd1 + 32) * 2) = o2;
    }
    { const int key = lane, d0 = wid * 16; u16 xv[16];
      if (lat && kt < 4) {
#pragma unroll
        for (int q = 0; q < 4; ++q)
#pragma unroll
          for (int j = 0; j < 4; ++j) xv[q * 4 + j] = f2bf(vraw[q][j]);
      } else { const bf16x8 a = __builtin_bit_cast(bf16x8, vraw[0]), bb = __builtin_bit_cast(bf16x8, vraw[1]);
#pragma unroll
        for (int j = 0; j < 8; ++j) { xv[j] = (u16)a[j]; xv[j + 8] = (u16)bb[j]; } }
      const int pos = (key & 32) | (((key >> 2) & 3) << 3) | (((key >> 4) & 1) << 2) | (key & 3);
#pragma unroll
      for (int i = 0; i < 16; ++i) *(LAS u16*)(VT + (d0 + i) * 144 + pos * 2) = xv[i];
    }
    if (kt + 1 < nkt) ATT_ISSUE(kt + 1);
    __syncthreads();
    bf16x8 Pf[2][2];
#pragma unroll
    for (int i = 0; i < 2; ++i) {
      f32x4 S[4];
#pragma unroll
      for (int st = 0; st < 4; ++st) { S[st] = (f32x4){0.f, 0.f, 0.f, 0.f};
#pragma unroll
        for (int kk = 0; kk < 2; ++kk) { const bf16x8 Kf = *(const LAS bf16x8*)(Ks + (st * 16 + fr) * 272 + (i * 64 + kk * 32 + fq * 8) * 2);
          S[st] = __builtin_amdgcn_mfma_f32_16x16x32_bf16(Kf, Qf[i][kk], S[st], 0, 0, 0); } }
      float mx = -1e30f;
#pragma unroll
      for (int st = 0; st < 4; ++st)
#pragma unroll
        for (int j = 0; j < 4; ++j) mx = fmaxf(mx, S[st][j]);
      mx = fmaxf(mx, __shfl_xor(mx, 16)); mx = fmaxf(mx, __shfl_xor(mx, 32));
      const float mnew = fmaxf(mrun[i], mx), alpha = __builtin_amdgcn_exp2f((mrun[i] - mnew) * sc); mrun[i] = mnew;
      float ls = 0.f;
#pragma unroll
      for (int st = 0; st < 4; ++st)
#pragma unroll
        for (int j = 0; j < 4; ++j) { const float pv = __builtin_amdgcn_exp2f((S[st][j] - mnew) * sc); ls += pv; S[st][j] = pv; }
      lrun[i] = lrun[i] * alpha + ls;
#pragma unroll
      for (int d = 0; d < 8; ++d) O[i][d] *= alpha;
#pragma unroll
      for (int ks = 0; ks < 2; ++ks)
#pragma unroll
        for (int j = 0; j < 1; ++j) Pf[i][ks] = pack8(S[2 * ks], S[2 * ks + 1]);
    }
#pragma unroll
    for (int d = 0; d < 8; ++d)
#pragma unroll
      for (int ks = 0; ks < 2; ++ks) { const bf16x8 Vf = *(const LAS bf16x8*)(VT + (d * 16 + fr) * 144 + (ks * 32 + fq * 8) * 2);
        O[0][d] = __builtin_amdgcn_mfma_f32_16x16x32_bf16(Vf, Pf[0][ks], O[0][d], 0, 0, 0);
        O[1][d] = __builtin_amdgcn_mfma_f32_16x16x32_bf16(Vf, Pf[1][ks], O[1][d], 0, 0, 0); }
  }
#undef ATT_ISSUE
  float inv[2];
#pragma unroll
  for (int i = 0; i < 2; ++i) { float lt = lrun[i]; lt += __shfl_xor(lt, 16); lt += __shfl_xor(lt, 32); inv[i] = 1.f / lt; }
  const float lam = p.lam[l], li = lam_init_of(l); const float i0 = inv[0], i1 = inv[1] * lam;
  float ss = 0.f;
#pragma unroll
  for (int d = 0; d < 8; ++d)
#pragma unroll
    for (int j = 0; j < 4; ++j) { const float o = O[0][d][j] * i0 - O[1][d][j] * i1; O[0][d][j] = o; ss += o * o; }
  ss += __shfl_xor(ss, 16); ss += __shfl_xor(ss, 32);
  const float rstd = rsqrtf(ss * (1.f / 128.f) + EPS) * (1.f - li);
  u16* op = p.brin + (size_t)(seqbase + qtok) * 512 + h * 128 + fq * 4; const float* gs = p.g_attn_sub + l * 128 + fq * 4;
#pragma unroll
  for (int d = 0; d < 8; ++d) { const f32x4 g = *(const f32x4*)(gs + d * 16);
    *(bf16x4*)(op + d * 16) = pack4(O[0][d][0] * rstd * g[0], O[0][d][1] * rstd * g[1], O[0][d][2] * rstd * g[2], O[0][d][3] * rstd * g[3]); }
}

__device__ void mlstm_item(const Params& p, int l, int item, LAS unsigned char* lds) {
  const int tid = tid_opaque(), wid = tid >> 6, lane = tid & 63, fr = lane & 15, fq = lane >> 4;
  const bool lat = item < 32; int b, h, dir, seqbase, T;
  if (lat) { b = item >> 3; h = (item >> 1) & 3; dir = item & 1; seqbase = NCTX + b * 1024; T = 1024; }
  else { const int i2 = item - 32; b = i2 >> 3; h = (i2 >> 1) & 3; dir = i2 & 1; seqbase = b * 256; T = 256; }
  const int nch = T >> 6;
  LAS unsigned char* Qs = lds; LAS unsigned char* Ks = lds + 17408; LAS unsigned char* KTs = lds + 34816; LAS unsigned char* VTs = lds + 53248;
  LAS unsigned char* Cs = lds + 71680; LAS unsigned char* Ss = lds + 106496; LAS float* fl = (LAS float*)(lds + 115712);
  LAS float* a_s = fl; LAS float* g_s = fl + 64; LAS float* sp_s = fl + 128; LAS float* wl_s = fl + 192; LAS float* em_s = fl + 256; LAS float* nq_s = fl + 320;
  LAS float* denp = fl + 384; LAS float* nvec = fl + 512; LAS float* scal = fl + 640;
  const size_t sidx = ((size_t)(b * 2 + l) * 2 + dir) * 4 + h;
  f32x4 accC[8];
  __syncthreads();
  if (lat) { const float* cp = p.state_C + sidx * 16384 + (size_t)(wid * 16 + fr) * 128 + fq * 4;
#pragma unroll
    for (int kt = 0; kt < 8; ++kt) accC[kt] = *(const f32x4*)(cp + kt * 16);
    if (tid < 128) nvec[tid] = p.state_n[sidx * 128 + tid];
  } else {
#pragma unroll
    for (int kt = 0; kt < 8; ++kt) accC[kt] = (f32x4){0.f, 0.f, 0.f, 0.f};
    if (tid < 128) nvec[tid] = 0.f;
  }
#pragma unroll
  for (int kt = 0; kt < 8; ++kt) *(LAS bf16x4*)(Cs + (wid * 16 + fr) * 272 + (kt * 16 + fq * 4) * 2) = pack4(accC[kt][0], accC[kt][1], accC[kt][2], accC[kt][3]);
  float mst = lat ? p.state_m[sidx] : 0.f;
  f32x4 qraw[2], kraw[2], vraw[2]; float igr = 0.f, lfr = 0.f;
#define ML_ISSUE(ch_) do { const int ch__ = (ch_); { const int pos = tid >> 3, c16 = (tid & 7) * 16; const int gp_ = ch__ * 64 + pos, tok = dir ? T - 1 - gp_ : gp_; \
      const u16* zp = p.zA + (size_t)(seqbase + tok) * ZLD + h * 128 + c16; \
      qraw[0] = *(const f32x4*)(zp + 1536); qraw[1] = *(const f32x4*)(zp + 1536 + 8); kraw[0] = *(const f32x4*)(zp + 2048); kraw[1] = *(const f32x4*)(zp + 2048 + 8); } \
    { const int gp_ = ch__ * 64 + lane, tok = dir ? T - 1 - gp_ : gp_; const u16* vp = p.zA + (size_t)(seqbase + tok) * ZLD + 2560 + h * 128 + wid * 16; \
      vraw[0] = *(const f32x4*)vp; vraw[1] = *(const f32x4*)(vp + 8); \
      if (wid == 0) { const float* gp = p.gate + (size_t)(seqbase + tok) * 16 + dir * 8 + h; igr = gp[0]; lfr = gp[4]; } } } while (0)
  ML_ISSUE(0);
  for (int ch = 0; ch < nch; ++ch) {
    if (wid == 0) {
      const float ig = igr, lf = lfr; float bs = lf;
#pragma unroll
      for (int o = 1; o < 64; o <<= 1) { const float t = __shfl_up(bs, o); if (lane >= o) bs += t; }
      const float a = ig - bs; float gm = a;
#pragma unroll
      for (int o = 1; o < 64; o <<= 1) { const float t = __shfl_up(gm, o); if (lane >= o) gm = fmaxf(gm, t); }
      gm = fmaxf(gm, mst);
      const float g63 = __shfl(gm, 63), b63 = __shfl(bs, 63);
      a_s[lane] = a; g_s[lane] = gm; sp_s[lane] = __expf(mst - gm); wl_s[lane] = __expf(a - g63); em_s[lane] = __expf(-(bs + gm));
      if (lane == 0) { scal[0] = __expf(mst - g63); scal[1] = b63 + g63; } }
    { const int pos = tid >> 3, c16 = (tid & 7) * 16;
      *(LAS f32x4*)(Qs + pos * 272 + c16 * 2) = qraw[0]; *(LAS f32x4*)(Qs + pos * 272 + c16 * 2 + 16) = qraw[1];
      *(LAS f32x4*)(Ks + pos * 272 + c16 * 2) = kraw[0]; *(LAS f32x4*)(Ks + pos * 272 + c16 * 2 + 16) = kraw[1]; }
    { const bf16x8 v0 = __builtin_bit_cast(bf16x8, vraw[0]), v1 = __builtin_bit_cast(bf16x8, vraw[1]);
#pragma unroll
      for (int i = 0; i < 8; ++i) { *(LAS u16*)(VTs + (wid * 16 + i) * 144 + lane * 2) = (u16)v0[i]; *(LAS u16*)(VTs + (wid * 16 + 8 + i) * 144 + lane * 2) = (u16)v1[i]; } }
    if (ch + 1 < nch) ML_ISSUE(ch + 1);
    __syncthreads();
    { const float wl = wl_s[lane]; const bf16x8 k0 = *(const LAS bf16x8*)(Ks + lane * 272 + wid * 32), k1 = *(const LAS bf16x8*)(Ks + lane * 272 + wid * 32 + 16);
#pragma unroll
      for (int i = 0; i < 8; ++i) { *(LAS u16*)(KTs + (wid * 16 + i) * 144 + lane * 2) = f2bf(bf2f((u16)k0[i]) * wl); *(LAS u16*)(KTs + (wid * 16 + 8 + i) * 144 + lane * 2) = f2bf(bf2f((u16)k1[i]) * wl); } }
    { const int tt = wid & 3, spq = wid >> 2; const int t = tt * 16 + fr; const float gt = g_s[t]; float dsum = 0.f;
      bf16x8 Qf[4];
#pragma unroll
      for (int kk = 0; kk < 4; ++kk) Qf[kk] = *(const LAS bf16x8*)(Qs + t * 272 + (kk * 32 + fq * 8) * 2);
#pragma unroll
      for (int s2 = 0; s2 < 2; ++s2) { const int st = spq * 2 + s2; f32x4 acc = (f32x4){0.f, 0.f, 0.f, 0.f};
        if (st <= tt) {
#pragma unroll
          for (int kk = 0; kk < 4; ++kk) { const bf16x8 Kf = *(const LAS bf16x8*)(Ks + (st * 16 + fr) * 272 + (kk * 32 + fq * 8) * 2); acc = __builtin_amdgcn_mfma_f32_16x16x32_bf16(Kf, Qf[kk], acc, 0, 0, 0); }
        }
        float vv[4];
#pragma unroll
        for (int j = 0; j < 4; ++j) { const int s = st * 16 + fq * 4 + j; const float w = (s <= t) ? __expf(a_s[s] - gt) : 0.f; vv[j] = acc[j] * w; dsum += vv[j]; }
        *(LAS bf16x4*)(Ss + t * 144 + (st * 16 + fq * 4) * 2) = pack4(vv[0], vv[1], vv[2], vv[3]); }
      dsum += __shfl_xor(dsum, 16); dsum += __shfl_xor(dsum, 32);
      if (fq == 0) denp[spq * 64 + t] = dsum; }
    { const int t = tid >> 3, part = tid & 7; const bf16x8 q0 = *(const LAS bf16x8*)(Qs + t * 272 + part * 32), q1 = *(const LAS bf16x8*)(Qs + t * 272 + part * 32 + 16); float s = 0.f;
#pragma unroll
      for (int i = 0; i < 8; ++i) s += nvec[part * 16 + i] * bf2f((u16)q0[i]) + nvec[part * 16 + 8 + i] * bf2f((u16)q1[i]);
      s += __shfl_xor(s, 1); s += __shfl_xor(s, 2); s += __shfl_xor(s, 4);
      if (part == 0) nq_s[t] = s; }
    __syncthreads();
    const float decay = scal[0];
    { const int tt = wid & 3, vh = wid >> 2; const int t = tt * 16 + fr; const float spt = sp_s[t]; const float den = spt * nq_s[t] + denp[t] + denp[64 + t];
      const float rdn = 1.f / fmaxf(fabsf(den), em_s[t]);
      bf16x8 Qf[4], Sf[2];
#pragma unroll
      for (int kk = 0; kk < 4; ++kk) Qf[kk] = *(const LAS bf16x8*)(Qs + t * 272 + (kk * 32 + fq * 8) * 2);
#pragma unroll
      for (int ks = 0; ks < 2; ++ks) Sf[ks] = *(const LAS bf16x8*)(Ss + t * 144 + (ks * 32 + fq * 8) * 2);
      const int gp_ = ch * 64 + t, tok = dir ? T - 1 - gp_ : gp_; u16* hp = p.hdir + ((size_t)dir * NTOK + seqbase + tok) * 512 + h * 128 + fq * 4;
#pragma unroll
      for (int v4 = 0; v4 < 4; ++v4) { const int vt = vh * 4 + v4; f32x4 aS = (f32x4){0.f, 0.f, 0.f, 0.f}, aI = (f32x4){0.f, 0.f, 0.f, 0.f};
#pragma unroll
        for (int kk = 0; kk < 4; ++kk) { const bf16x8 Cf = *(const LAS bf16x8*)(Cs + (vt * 16 + fr) * 272 + (kk * 32 + fq * 8) * 2); aS = __builtin_amdgcn_mfma_f32_16x16x32_bf16(Cf, Qf[kk], aS, 0, 0, 0); }
#pragma unroll
        for (int ks = 0; ks < 2; ++ks) { const bf16x8 Vf = *(const LAS bf16x8*)(VTs + (vt * 16 + fr) * 144 + (ks * 32 + fq * 8) * 2); aI = __builtin_amdgcn_mfma_f32_16x16x32_bf16(Vf, Sf[ks], aI, 0, 0, 0); }
        const bf16x4 hv = pack4((spt * aS[0] + aI[0]) * rdn, (spt * aS[1] + aI[1]) * rdn, (spt * aS[2] + aI[2]) * rdn, (spt * aS[3] + aI[3]) * rdn);
        __hip_atomic_store((unsigned long long*)(hp + vt * 16), __builtin_bit_cast(unsigned long long, hv), __ATOMIC_RELAXED, __HIP_MEMORY_SCOPE_AGENT); } }
    float nsum = 0.f;
    { bf16x8 Vf[2];
#pragma unroll
      for (int ks = 0; ks < 2; ++ks) Vf[ks] = *(const LAS bf16x8*)(VTs + (wid * 16 + fr) * 144 + (ks * 32 + fq * 8) * 2);
#pragma unroll
      for (int kt = 0; kt < 8; ++kt) { accC[kt] *= decay;
#pragma unroll
        for (int ks = 0; ks < 2; ++ks) { const bf16x8 Kf = *(const LAS bf16x8*)(KTs + (kt * 16 + fr) * 144 + (ks * 32 + fq * 8) * 2); accC[kt] = __builtin_amdgcn_mfma_f32_16x16x32_bf16(Kf, Vf[ks], accC[kt], 0, 0, 0); } }
      if (tid < 128) {
#pragma unroll
        for (int q = 0; q < 8; ++q) { const bf16x8 kv = *(const LAS bf16x8*)(KTs + tid * 144 + q * 16);
#pragma unroll
          for (int i = 0; i < 8; ++i) nsum += bf2f((u16)kv[i]); } } }
    mst = scal[1];
    __syncthreads();
#pragma unroll
    for (int kt = 0; kt < 8; ++kt) *(LAS bf16x4*)(Cs + (wid * 16 + fr) * 272 + (kt * 16 + fq * 4) * 2) = pack4(accC[kt][0], accC[kt][1], accC[kt][2], accC[kt][3]);
    if (tid < 128) nvec[tid] = decay * nvec[tid] + nsum;
  }
#undef ML_ISSUE
  if (!lat) {
    float* cpb = p.out + O_SC + sidx * 16384; const unsigned coff = (unsigned)((wid * 16 + fr) * 128 + fq * 4);
#pragma unroll
    for (int kt = 0; kt < 8; ++kt) *(f32x4*)(cpb + (coff + kt * 16)) = accC[kt];
    __syncthreads();
    if (tid < 128) p.out[O_SN + sidx * 128 + tid] = nvec[tid];
    if (tid == 0) p.out[O_SM + sidx] = mst;
  }
  asm volatile("s_waitcnt vmcnt(0)" ::: "memory");
  __syncthreads();
  LAS unsigned* flag = (LAS unsigned*)(fl + 644);
  if (tid == 0) *flag = __hip_atomic_fetch_add(p.ctr + XB_MCNT + l * 144 + (lat ? 32 + b : b) * 4 + h, 1u, __ATOMIC_RELAXED, __HIP_MEMORY_SCOPE_AGENT);
  __syncthreads();
  if (*flag == 1u) {
    const int rsub = tid >> 4, cq = tid & 15; const float* g = p.g_mlstm + l * 128 + cq * 8;
    for (int r0 = 0; r0 < T; r0 += 32) {
      const size_t row = (size_t)(seqbase + r0 + rsub); const int c = h * 128 + cq * 8;
      const unsigned long long* pf = (const unsigned long long*)(p.hdir + row * 512 + c); const unsigned long long* pb = (const unsigned long long*)(p.hdir + ((size_t)NTOK + row) * 512 + c);
      unsigned long long f0 = __hip_atomic_load(pf, __ATOMIC_RELAXED, __HIP_MEMORY_SCOPE_AGENT), f1 = __hip_atomic_load(pf + 1, __ATOMIC_RELAXED, __HIP_MEMORY_SCOPE_AGENT);
      unsigned long long b0 = __hip_atomic_load(pb, __ATOMIC_RELAXED, __HIP_MEMORY_SCOPE_AGENT), b1 = __hip_atomic_load(pb + 1, __ATOMIC_RELAXED, __HIP_MEMORY_SCOPE_AGENT);
      const bf16x8 mo = *(const bf16x8*)(p.zA + row * ZLD + 3072 + c);
      const bf16x4 hf0 = __builtin_bit_cast(bf16x4, f0), hf1 = __builtin_bit_cast(bf16x4, f1), hb0 = __builtin_bit_cast(bf16x4, b0), hb1 = __builtin_bit_cast(bf16x4, b1);
      float s[8], ss = 0.f;
#pragma unroll
      for (int i = 0; i < 4; ++i) { s[i] = bf2f((u16)hf0[i]) + bf2f((u16)hb0[i]); s[i + 4] = bf2f((u16)hf1[i]) + bf2f((u16)hb1[i]); }
#pragma unroll
      for (int i = 0; i < 8; ++i) ss += s[i] * s[i];
      ss += __shfl_xor(ss, 1); ss += __shfl_xor(ss, 2); ss += __shfl_xor(ss, 4); ss += __shfl_xor(ss, 8);
      const float rstd = rsqrtf(ss * (1.f / 128.f) + EPS);
      f32x4 o0, o1;
#pragma unroll
      for (int i = 0; i < 4; ++i) { o0[i] = s[i] * rstd * g[i] * bf2f((u16)mo[i]); o1[i] = s[i + 4] * rstd * g[i + 4] * bf2f((u16)mo[i + 4]); }
      *(bf16x8*)(p.brin + ((size_t)2 * NTOK + row) * 512 + c) = pack8(o0, o1);
    }
  }
}

__device__ void mixers_phase(const Params& p, int ci, int l, LAS unsigned char* lds, int mask = 7) {
  __shared__ int s_item;
  const int tid = tid_opaque();
  for (;;) {
    __syncthreads();
    if (tid == 0) s_item = (int)atomicAdd(p.ctr + XB_CTR + ci, 1u);
    __syncthreads();
    const int item = s_item;
    if (item >= 768) break;
    const int ty = (item < 32 || (item >= 192 && item < 256)) ? 4 : ((item < 64 || (item >= 256 && item < 512)) ? 1 : 2);
    if (!(mask & ty)) continue;
    if (ty == 4) {
      OneSched S; int ld; float scale;
      if (item < 32) { const int b = item >> 3, mt = (item >> 1) & 3, nt = item & 1; ld = 2048; scale = 1.f / sqrtf(1024.f * 128.f);
        S.u.A = (const char*)(p.cs1024 + (size_t)mt * 256 * 2048); S.u.B = (const char*)(p.Yt + (size_t)32 * 512 * 512 + (size_t)b * 512 * 2048 + (size_t)nt * 256 * 2048);
        S.u.pm = NCTX + b * 1024 + mt * 256; S.u.pn = nt; S.u.aux = 0; }
      else { const int i2 = item - 192, b = i2 >> 1, nt = i2 & 1; ld = 512; scale = 1.f / sqrtf(256.f * 128.f);
        S.u.A = (const char*)p.cs256; S.u.B = (const char*)(p.Yt + (size_t)b * 512 * 512 + (size_t)nt * 256 * 512);
        S.u.pm = b * 256; S.u.pn = nt; S.u.aux = 0; }
      EpiFour E{p.brin + (size_t)NTOK * 512, scale};
      gemm_phase<4>(lds, ld, ld, ld, S, E);
    } else if (ty == 1) mlstm_item(p, l, item < 64 ? item - 32 : 32 + (item - 256), lds);
    else attn_item(p, l, item < 192 ? item - 64 : 128 + (item - 512), lds);
  }
}

__device__ void mpost_phase(const Params& p, int l) {
  const int tid = tid_opaque(), wid = tid >> 6, lane = tid & 63;
  for (int row = blockIdx.x * 8 + wid; row < NTOK; row += gridDim.x * 8) {
    const bf16x8 hf = *(const bf16x8*)(p.hdir + (size_t)row * 512 + lane * 8), hb = *(const bf16x8*)(p.hdir + ((size_t)NTOK + row) * 512 + lane * 8);
    const bf16x8 mo = *(const bf16x8*)(p.zA + (size_t)row * ZLD + 3072 + lane * 8);
    float s[8], ss = 0.f;
#pragma unroll
    for (int i = 0; i < 8; ++i) { s[i] = bf2f((u16)hf[i]) + bf2f((u16)hb[i]); ss += s[i] * s[i]; }
    ss += __shfl_xor(ss, 1); ss += __shfl_xor(ss, 2); ss += __shfl_xor(ss, 4); ss += __shfl_xor(ss, 8);
    const float rstd = rsqrtf(ss * (1.f / 128.f) + EPS); const float* g = p.g_mlstm + l * 128 + (lane & 15) * 8; bf16x8 o;
#pragma unroll
    for (int i = 0; i < 8; ++i) o[i] = (short)f2bf(s[i] * rstd * g[i] * bf2f((u16)mo[i]));
    *(bf16x8*)(p.brin + ((size_t)2 * NTOK + row) * 512 + lane * 8) = o;
  }
}

__global__ void __launch_bounds__(512) fwd_megakernel(Params p_) {
  const Params& p = *(const Params*)(const __attribute__((address_space(4))) void*)__builtin_amdgcn_kernarg_segment_ptr();
  extern __shared__ __attribute__((aligned(16))) unsigned char shm_[];
  LAS unsigned char* lds = (LAS unsigned char*)shm_;
  cg::grid_group grid = cg::this_grid();
  const int G = gridDim.x, c = blockIdx.x;
  __shared__ uint4 xb_words; __shared__ int s_segdone[4];
  if (threadIdx.x == 0) xb_words = make_uint4(0u, 0u, 0u, 0u);
  if (threadIdx.x < 4) s_segdone[threadIdx.x] = 0;
  __syncthreads();
  const XcdBarrier xb = xcd_barrier_post(p.ctr, (volatile LAS unsigned*)&xb_words);
#define GSYNC() xcd_barrier(xb)
  if (p.out == nullptr) grid.sync();
  for (int ph = 0; ph < 25; ++ph) {
    const int l = ph == 0 ? 0 : (ph - 1) / 12, kind = ph == 0 ? -1 : (ph - 1) - l * 12;
    if (kind == 3 || kind == 9 || kind == 6 || (kind == 0 && l == 1)) continue;
    const float* md = p.mods + (size_t)l * 5 * 9216;
    int hl = -1, hs = 0;
    if (kind == -1) { phase0(p, lds); hl = 0; hs = 0; }
    else if (kind == 0) norm_phase(p, 0, 0, lds);
    else if (kind == 1 || kind == 10) {
      TileSched S{p.u, kind == 1 ? p.wt_ffn1_in : p.wt_ffn2_in, D, D, 48, 22, G, c, 256}; EpiSwiglu E{p.zA}; gemm_phase<4>(lds, D, D, D, S, E);
      if (kind == 1) { hl = l; hs = 1; } else if (l == 0) { hl = 1; hs = 0; }
    } else if (kind == 2 || kind == 11 || kind == 8) {
      const bool isout = kind == 8; const int Kd = isout ? D : DFF;
      TileSched S{isout ? p.hdir : p.zA, isout ? p.wt_out : (kind == 2 ? p.wt_ffn1_out : p.wt_ffn2_out), Kd, Kd, 64, 4, G, c, 192};
      EpiResidNorm E{p, l, kind};
      gemm_phase<3>(lds, Kd, Kd, Kd, S, E);
      if (kind == 2) { hl = l; hs = 1; }
    } else if (kind == 4) { TileSched S{p.u, p.wt_big, D, D, 48, 31, G, c, 256}; EpiBig E{p.zA, p.gb, p.Yt, p.out, l, p.gate, p.b_mgate}; gemm_phase<4>(lds, D, D, D, S, E); }
    else if (kind == 5) mixers_phase(p, l, l, lds);
    else if (kind == 6) mpost_phase(p, l);
    else { BranchSched S{p.brin, p.wt_br, G, c}; EpiBranch E{p.zA, p.gb, p.hdir}; gemm_phase<3>(lds, 512, 512, 512, S, E); }
    if (hl >= 0) prep_seg(p, hl, hs, lds, (volatile LAS int*)s_segdone);
    GSYNC();
  }
}


extern "C" void kernel_launch(void* const* d_in, const int* in_sizes, int n_in, void* d_out, int out_size, void* d_ws, size_t ws_size, hipStream_t stream) {
  static int grid_blocks = 0;
  if (!grid_blocks) {
    int dev = 0, cus = 0, per_cu = 0;
    hipGetDevice(&dev);
    hipDeviceGetAttribute(&cus, hipDeviceAttributeMultiprocessorCount, dev);
    hipFuncSetAttribute((const void*)fwd_megakernel, hipFuncAttributeMaxDynamicSharedMemorySize, LDS_BYTES);
    hipOccupancyMaxActiveBlocksPerMultiprocessor(&per_cu, (const void*)fwd_megakernel, 512, LDS_BYTES);
    if (per_cu < 1) per_cu = 1;
    grid_blocks = cus * 1;
    (void)hipGetLastError();
  }
  Params p{};
  const float** ip = (const float**)&p;
  for (int i = 0; i < 27; ++i) ip[i] = (const float*)d_in[i];
  p.out = (float*)d_out;
  char* w = (char*)d_ws; size_t off = 0;
  auto take = [&](size_t bytes) { char* r = w + off; off += (bytes + 255) & ~(size_t)255; return r; };
  p.wt_ffn1_in = (u16*)take((size_t)2 * DFF * D * 2); p.wt_ffn1_out = (u16*)take((size_t)D * DFF * 2);
  p.wt_ffn2_in = (u16*)take((size_t)2 * DFF * D * 2); p.wt_ffn2_out = (u16*)take((size_t)D * DFF * 2);
  p.wt_big = (u16*)take((size_t)NBIG * D * 2); p.wt_br = (u16*)take((size_t)3 * D * 512 * 2); p.wt_out = (u16*)take((size_t)D * D * 2);
  p.u = (u16*)take((size_t)NTOK * D * 2);
  p.zA = (u16*)take((size_t)NTOK * ZLD * 2); p.gb = (u16*)take((size_t)NTOK * GBLD * 2);
  p.Yt = (u16*)take((size_t)NTOK * 1024 * 2); p.brin = (u16*)take((size_t)3 * NTOK * 512 * 2); p.hdir = (u16*)take((size_t)2 * NTOK * 512 * 2);
  p.cs1024 = (u16*)take((size_t)1024 * 2048 * 2); p.cs256 = (u16*)take((size_t)256 * 512 * 2);
  p.mods = (float*)take((size_t)2 * 5 * 9216 * 4); p.gate = (float*)take((size_t)NTOK * 16 * 4); p.rope = (float*)take((size_t)1024 * 32 * 2 * 4);
  p.lam = (float*)take(256); p.part = (float*)take((size_t)6 * 48 * 4 * 256 * 4); p.ctr = (unsigned*)take(BAR_TOTAL_WORDS * 4);
  if (off > ws_size) { fprintf(stderr, "kernel_launch: workspace too small: need %zu have %zu\n", off, ws_size); return; }
  if (hipMemsetAsync(p.ctr, 0, BAR_TOTAL_WORDS * 4, stream) != hipSuccess) { fprintf(stderr, "memset failed\n"); return; }
  void* args[] = {&p};
  hipError_t e = hipLaunchCooperativeKernel((const void*)fwd_megakernel, dim3(grid_blocks), dim3(512), args, LDS_BYTES, stream);
  if (e != hipSuccess) fprintf(stderr, "cooperative launch failed: %s (grid %d)\n", hipGetErrorString(e), grid_blocks);
}
```

```cpp
#include <hip/hip_runtime.h>
#include <hip/hip_cooperative_groups.h>
#include <cstdio>
namespace cg = cooperative_groups;

typedef unsigned short u16;
typedef short bf16x8 __attribute__((ext_vector_type(8)));
typedef short bf16x4 __attribute__((ext_vector_type(4)));
typedef float f32x4 __attribute__((ext_vector_type(4)));
#define LAS __attribute__((address_space(3)))

constexpr int D = 1024, NTOK = 12288, NCTX = 8192, DFF = 2816, PIN = 4112, NBIG = 7936, ZLD = 3584, GBLD = 3072;
constexpr int LDS_BYTES = 131072;
#ifndef PROBE
#define PROBE 0
#endif
constexpr float EPS = 1e-6f;
constexpr size_t O_Y = 0, O_CK = 12582912, O_CV = 20971520, O_SC = 29360128, O_SN = 37748736, O_SM = 37814272;

struct Params {
  const float *x_prompt, *x_sample, *cache_k, *cache_v, *state_C, *state_n, *state_m, *c, *c_ctx, *w_ada, *b_ada, *g_norm,
      *w_ffn1_in, *w_ffn1_out, *w_ffn2_in, *w_ffn2_out, *w_in, *b_mgate, *attn_lambda, *g_attn_sub, *g_mlstm, *w_branch_gate,
      *w_br_attn, *w_br_four, *w_br_mlstm, *w_out, *g_final;
  float* out;
  u16 *wt_ffn1_in, *wt_ffn1_out, *wt_ffn2_in, *wt_ffn2_out, *wt_big, *wt_br, *wt_out;
  u16 *u, *zA, *gb, *Yt, *brin, *hdir, *cs1024, *cs256;
  float *mods, *gate, *rope, *lam, *part;
  unsigned* ctr;
};

typedef float f32x2_ __attribute__((ext_vector_type(2)));
typedef __bf16 bf16v2_ __attribute__((ext_vector_type(2)));
__device__ __forceinline__ unsigned cvt_pk_bf16(float lo, float hi) { f32x2_ v = {lo, hi}; bf16v2_ r = __builtin_convertvector(v, bf16v2_); return __builtin_bit_cast(unsigned, r); }
__device__ __forceinline__ u16 f2bf(float f) { return (u16)cvt_pk_bf16(f, 0.f); }
typedef unsigned u32x4 __attribute__((ext_vector_type(4)));
typedef unsigned u32x2 __attribute__((ext_vector_type(2)));
__device__ __forceinline__ float bf2f(u16 h) { return __uint_as_float(((unsigned)h) << 16); }
__device__ __forceinline__ int tid_opaque() { int t = threadIdx.x; asm volatile("" : "+v"(t)); return t; }
__device__ __forceinline__ float sigmoidf_(float x) { return __builtin_amdgcn_rcpf(1.f + __builtin_amdgcn_exp2f(-1.4426950408889634f * x)); }
__device__ __forceinline__ int cond_of(int row) { return row < NCTX ? 0 : 1 + ((row - NCTX) >> 10); }
__device__ __forceinline__ float lam_init_of(int l) { return l == 0 ? 0.2f : (0.8f - 0.6f * 0.74081822068f); }


#define XB_TMO      128
#define XB_XCNT(j)  (256  + 64 * (j))
#define XB_XSUB(j)  (1280 + 64 * (j))
#define XB_XGEN(j)  (2304 + 64 * (j))
#define XB_TOP      3328
#define XB_TOPGEN   3392
#define XCD_BAR_WORDS 3456
#define XB_CTR      3520
#define XB_PCNT     3584
#define XB_MCNT     3968
#define BAR_TOTAL_WORDS 4352
#define XB_SPIN_CAP (1u << 18)
__device__ __forceinline__ unsigned xb_ld(unsigned* p)              { return __hip_atomic_load(p, __ATOMIC_RELAXED, __HIP_MEMORY_SCOPE_AGENT); }
__device__ __forceinline__ unsigned xb_add(unsigned* p, unsigned v) { return __hip_atomic_fetch_add(p, v, __ATOMIC_RELAXED, __HIP_MEMORY_SCOPE_AGENT); }
__device__ __forceinline__ unsigned xb_xcc_id() { return (unsigned)__builtin_amdgcn_s_getreg((3 << 11) | 20) & 0xFu; }
#define XB_SPIN(cond, bar) do { unsigned _sp = 0; while (cond) { __builtin_amdgcn_s_sleep(1); \
    if ((++_sp & 255u) == 0u) { if (xb_ld(&(bar)[XB_TMO])) break; if (_sp > XB_SPIN_CAP) { atomicAdd(&(bar)[XB_TMO], 1u); break; } } } } while (0)
struct XcdBarrier { unsigned* bar; unsigned x; volatile LAS unsigned* st; };
__device__ __forceinline__ XcdBarrier xcd_barrier_post(unsigned* bar, volatile LAS unsigned* st) {
  XcdBarrier b; b.bar = bar; b.x = xb_xcc_id(); b.st = st;
  if (threadIdx.x == 0) (void)xb_add(&bar[XB_XCNT(b.x)], 1u);
  return b;
}
__device__ __forceinline__ void xcd_barrier_complete(unsigned* bar, unsigned x, unsigned& nloc, unsigned& nx) {
  const unsigned G = gridDim.x * gridDim.y * gridDim.z;
  unsigned sum, cnt, mine, sp = 0u;
  for (;;) {
    sum = 0u; cnt = 0u; mine = 0u;
#pragma unroll
    for (unsigned j = 0; j < 16; ++j) { const unsigned c = xb_ld(&bar[XB_XCNT(j)]); sum += c; cnt += (c > 0u) ? 1u : 0u; mine = (j == x) ? c : mine; }
    if (sum == G) break;
    __builtin_amdgcn_s_sleep(1);
    if ((++sp & 255u) == 0u) { if (xb_ld(&bar[XB_TMO])) break; if (sp > XB_SPIN_CAP) { atomicAdd(&bar[XB_TMO], 1u); break; } }
  }
  nloc = mine > 0u ? mine : 1u; nx = cnt > 0u ? cnt : 1u;
}
__device__ __forceinline__ void xcd_barrier(const XcdBarrier& b) {
  asm volatile("s_waitcnt vmcnt(0)" ::: "memory");
  __syncthreads();
  if (threadIdx.x == 0) {
    unsigned* bar = b.bar;
    __builtin_amdgcn_s_waitcnt(0);
    unsigned nloc = b.st[0], nx = b.st[1];
    if (nloc == 0u) { xcd_barrier_complete(bar, b.x, nloc, nx); b.st[0] = nloc; b.st[1] = nx; }
    const unsigned old = xb_add(&bar[XB_XSUB(b.x)], 1u);
    const unsigned gen = old / nloc;
    if (old + 1u == (gen + 1u) * nloc) {
      __builtin_amdgcn_fence(__ATOMIC_RELEASE, "agent");
      asm volatile("s_waitcnt vmcnt(0)" ::: "memory");
      const unsigned og = xb_add(&bar[XB_TOP], 1u);
      const unsigned tg = og / nx;
      if (og + 1u == (tg + 1u) * nx) xb_add(&bar[XB_TOPGEN], 1u);
      else XB_SPIN(xb_ld(&bar[XB_TOPGEN]) == tg, bar);
      __builtin_amdgcn_fence(__ATOMIC_ACQUIRE, "agent");
      xb_add(&bar[XB_XGEN(b.x)], 1u);
      asm volatile("s_waitcnt vmcnt(0)" ::: "memory");
    } else {
      XB_SPIN(xb_ld(&bar[XB_XGEN(b.x)]) == gen, bar);
      __builtin_amdgcn_fence(__ATOMIC_ACQUIRE, "agent");
      asm volatile("s_waitcnt vmcnt(0)" ::: "memory");
    }
  }
  __syncthreads();
}

constexpr int BM = 256, BK = 64, HALF = 128, HTB = HALF * BK * 2;
__device__ __forceinline__ int lds_byte(int r, int c) { const int st = (r >> 4) * 2 + (c >> 5), rr = r & 15, cc = c & 31, ob = rr * 64 + cc * 2; return st * 1024 + (ob ^ (((ob >> 9) & 1) << 5)); }
__device__ __forceinline__ void stage_rc(int b, int& R, int& C) { const int st = b / 1024, sb = b % 1024, swz = sb ^ (((sb >> 9) & 1) << 5); R = (st >> 1) * 16 + swz / 64; C = (st & 1) * 32 + (swz % 64) / 2; }
__device__ __forceinline__ int perm32(int rho) { const int n = rho >> 4, i = rho & 15; return 8 * (i >> 2) + 4 * n + (i & 3); }

struct GUnit { const char* A; const char* B; int pm, pn, aux; };

__device__ __forceinline__ bool tile_order(int L, int nM, int nN, int& pm, int& pn) {
  const int nwg = nM * nN; if (L >= nwg) return false;
  int wgid = L; { const int q = nwg / 8, r = nwg % 8, xcd = wgid % 8, off = wgid / 8; wgid = (xcd < r ? xcd * (q + 1) : r * (q + 1) + (xcd - r) * q) + off; }
  const int nig = 8 * nN, gid = wgid / nig, fm = gid * 8, gsz = (nM - fm) < 8 ? (nM - fm) : 8;
  pm = fm + ((wgid % nig) % gsz); pn = (wgid % nig) / gsz; return true;
}

template <int MT, class Sched, class Epi>
__device__ __forceinline__ void gemm_phase(LAS unsigned char* lds, const int lda, const int ldb, const int K, const Sched& S, const Epi& E) {
  const int tid = tid_opaque(), wid = __builtin_amdgcn_readfirstlane(tid >> 6), lane = tid & 63, wr = wid >> 2, wc = wid & 3, fr = lane & 15, fq = lane >> 4;
  const int nt = K / BK;
  unsigned voffA[2], voffB[2];
#pragma unroll
  for (int i = 0; i < 2; ++i) { int R, C; stage_rc(tid * 16 + i * 8192, R, C); const int Rb = (R & ~31) + perm32(R & 31);
    voffA[i] = (unsigned)(R * lda + C) * 2u; voffB[i] = (unsigned)(Rb * ldb + C) * 2u; }
  const size_t kstep = (size_t)(BK * 2);
  const size_t hstepA = (size_t)(MT * 32) * lda * 2, hstepB = (size_t)HALF * ldb * 2;
  const unsigned ldsw = (unsigned)wid * 1024u;
  const int aoff = lds_byte(wr * (MT * 16) + fr, fq * 8), boff = lds_byte(wc * 32 + fr, fq * 8);
#define PG8_SA(b, h) (((b) * 2 + (h)) * HTB)
#define PG8_SB(b, h) ((4 + (b) * 2 + (h)) * HTB)
#define PG8_STAGE(bufoff, gbase, voff) do { _Pragma("unroll") for (int _i = 0; _i < 2; ++_i) \
    __builtin_amdgcn_global_load_lds((const unsigned*)((const char*)(gbase) + (voff)[_i]), (LAS unsigned*)(lds + (bufoff) + ldsw + _i * 8192), 16, 0, 0); } while (0)
#define PG8_STAGEA(bufoff, gbase, voff) do { _Pragma("unroll") for (int _i = 0; _i < 2; ++_i) if (MT == 4 || _i == 0 || wid < 4) \
    __builtin_amdgcn_global_load_lds((const unsigned*)((const char*)(gbase) + (voff)[_i]), (LAS unsigned*)(lds + (bufoff) + ldsw + _i * 8192), 16, 0, 0); } while (0)
#define PG8_LDA(dst, b, h) do { _Pragma("unroll") for (int m = 0; m < MT; ++m) _Pragma("unroll") for (int k = 0; k < 2; ++k) dst[m][k] = *(const LAS bf16x8*)(lds + PG8_SA(b, h) + aoff + m * 2048 + k * 1024); } while (0)
#define PG8_LDB(dst, b, h) do { _Pragma("unroll") for (int n = 0; n < 2; ++n) _Pragma("unroll") for (int k = 0; k < 2; ++k) dst[n][k] = *(const LAS bf16x8*)(lds + PG8_SB(b, h) + boff + n * 2048 + k * 1024); } while (0)
#define PG8_MMA(ai, bj, At, Bt) do { __builtin_amdgcn_s_setprio(1); _Pragma("unroll") for (int m = 0; m < MT; ++m) _Pragma("unroll") for (int n = 0; n < 2; ++n) _Pragma("unroll") for (int k = 0; k < 2; ++k) \
    acc[ai][bj][m][n] = __builtin_amdgcn_mfma_f32_16x16x32_bf16(Bt[n][k], At[m][k], acc[ai][bj][m][n], 0, 0, 0); __builtin_amdgcn_s_setprio(0); } while (0)
#define PG8_WAIT_V(n) asm volatile("s_waitcnt vmcnt(" #n ")" ::: "memory")
#define PG8_WAIT_L(n) asm volatile("s_waitcnt lgkmcnt(" #n ")" ::: "memory")
#define PG8_WAIT_VA do { if constexpr (MT == 4) asm volatile("s_waitcnt vmcnt(4)" ::: "memory"); else asm volatile("s_waitcnt vmcnt(3)" ::: "memory"); } while (0)
#define PG8_WAIT_VB do { if constexpr (MT == 4) asm volatile("s_waitcnt vmcnt(6)" ::: "memory"); else asm volatile("s_waitcnt vmcnt(5)" ::: "memory"); } while (0)
#define PG8_WAIT_LB do { if constexpr (MT == 4) asm volatile("s_waitcnt lgkmcnt(8)" ::: "memory"); else asm volatile("s_waitcnt lgkmcnt(6)" ::: "memory"); } while (0)
#define PG8_BAR __builtin_amdgcn_s_barrier()
#define PG8_SCHED __builtin_amdgcn_sched_barrier(0)
  GUnit cur, nxt; int ui = 0;
  if (!S.next(0, cur)) return;
  f32x4 acc[2][2][MT][2];
#pragma unroll
  for (int a = 0; a < 2; ++a)
#pragma unroll
    for (int b = 0; b < 2; ++b)
#pragma unroll
      for (int m = 0; m < MT; ++m)
#pragma unroll
        for (int n = 0; n < 2; ++n) acc[a][b][m][n] = (f32x4){0.f, 0.f, 0.f, 0.f};
  bf16x8 At[MT][2], B0[2][2], B1[2][2];
  const char* cA = cur.A; const char* cB = cur.B;
  PG8_STAGE(PG8_SB(0, 0), cB, voffB); PG8_STAGEA(PG8_SA(0, 0), cA, voffA); PG8_STAGE(PG8_SB(0, 1), cB + hstepB, voffB); PG8_STAGEA(PG8_SA(0, 1), cA + hstepA, voffA);
  if (wr == 1) PG8_BAR;
  PG8_WAIT_VA; PG8_BAR;
  PG8_STAGE(PG8_SB(1, 0), cB + kstep, voffB); PG8_STAGEA(PG8_SA(1, 0), cA + kstep, voffA); PG8_STAGE(PG8_SB(1, 1), cB + hstepB + kstep, voffB);
  PG8_WAIT_VB; PG8_BAR;
  for (;;) {
    const bool has_next = S.next(ui + 1, nxt);
    const char* nA = has_next ? nxt.A : cA; const char* nB = has_next ? nxt.B : cB;
    for (int t = 0; t < nt; t += 2) {
      const bool last = (t == nt - 2);
      const char* a1 = cA + (size_t)(t + 1) * kstep;
      const char* a2 = last ? nA : cA + (size_t)(t + 2) * kstep; const char* b2 = last ? nB : cB + (size_t)(t + 2) * kstep;
      const char* a3 = a2 + kstep; const char* b3 = b2 + kstep;
      PG8_LDB(B0, 0, 0); PG8_SCHED; PG8_LDA(At, 0, 0); PG8_STAGEA(PG8_SA(1, 1), a1 + hstepA, voffA);
      PG8_WAIT_LB; PG8_BAR; PG8_WAIT_L(0); PG8_MMA(0, 0, At, B0); PG8_BAR; PG8_SCHED;
      PG8_LDB(B1, 0, 1); PG8_STAGE(PG8_SB(0, 0), b2, voffB);
      PG8_BAR; PG8_WAIT_L(0); PG8_MMA(0, 1, At, B1); PG8_BAR;
      PG8_LDA(At, 0, 1); PG8_STAGEA(PG8_SA(0, 0), a2, voffA);
      PG8_BAR; PG8_WAIT_L(0); PG8_MMA(1, 0, At, B0); PG8_BAR; PG8_SCHED;
      PG8_STAGE(PG8_SB(0, 1), b2 + hstepB, voffB);
      PG8_WAIT_VB; PG8_BAR; PG8_MMA(1, 1, At, B1); PG8_BAR;
      PG8_LDB(B0, 1, 0); PG8_SCHED; PG8_LDA(At, 1, 0); PG8_STAGEA(PG8_SA(0, 1), a2 + hstepA, voffA);
      PG8_WAIT_LB; PG8_BAR; PG8_WAIT_L(0); PG8_MMA(0, 0, At, B0); PG8_BAR; PG8_SCHED;
      PG8_LDB(B1, 1, 1); PG8_STAGE(PG8_SB(1, 0), b3, voffB);
      PG8_BAR; PG8_WAIT_L(0); PG8_MMA(0, 1, At, B1); PG8_BAR;
      PG8_LDA(At, 1, 1); PG8_STAGEA(PG8_SA(1, 0), a3, voffA);
      PG8_BAR; PG8_WAIT_L(0); PG8_MMA(1, 0, At, B0); PG8_BAR; PG8_SCHED;
      PG8_STAGE(PG8_SB(1, 1), b3 + hstepB, voffB);
      PG8_WAIT_VB; PG8_BAR; PG8_MMA(1, 1, At, B1); PG8_BAR;
    }
    if constexpr (!Epi::AFTER_DRAIN) E(acc, cur, wr, wc, fr, fq);
    if (!has_next) break;
#pragma unroll
    for (int a = 0; a < 2; ++a)
#pragma unroll
      for (int b = 0; b < 2; ++b)
#pragma unroll
        for (int m = 0; m < MT; ++m)
#pragma unroll
          for (int n = 0; n < 2; ++n) acc[a][b][m][n] = (f32x4){0.f, 0.f, 0.f, 0.f};
    cur = nxt; cA = nA; cB = nB; ++ui;
  }
  PG8_WAIT_V(0);
  if (wr == 0) PG8_BAR;
  PG8_BAR;
  if constexpr (Epi::AFTER_DRAIN) E.fused(acc, cur, wr, wc, fr, fq, lds);
#undef PG8_SA
#undef PG8_SB
#undef PG8_STAGE
#undef PG8_STAGEA
#undef PG8_WAIT_VA
#undef PG8_WAIT_VB
#undef PG8_WAIT_LB
#undef PG8_LDA
#undef PG8_LDB
#undef PG8_MMA
#undef PG8_WAIT_V
#undef PG8_WAIT_L
#undef PG8_BAR
#undef PG8_SCHED
}

struct TileSched {
  const u16* A; const u16* B; int lda, ldb, nM, nN, G, c, bm;
  __device__ __forceinline__ bool next(int i, GUnit& u) const {
    int pm, pn; if (!tile_order(i * G + c, nM, nN, pm, pn)) return false;
    u.pm = pm; u.pn = pn; u.aux = 0; u.A = (const char*)(A + (size_t)pm * bm * lda); u.B = (const char*)(B + (size_t)pn * BM * ldb); return true;
  }
};
struct BranchSched {
  const u16* brin; const u16* wbr; int G, c;
  __device__ __forceinline__ bool next(int i, GUnit& u) const {
    int pm, pn; const int ti = i / 3, br = i - ti * 3; if (!tile_order(ti * G + c, 64, 4, pm, pn)) return false;
    u.pm = pm; u.pn = pn; u.aux = br; u.A = (const char*)(brin + (size_t)br * NTOK * 512 + (size_t)pm * 192 * 512); u.B = (const char*)(wbr + (size_t)br * D * 512 + (size_t)pn * BM * 512); return true;
  }
};
struct OneSched { GUnit u; __device__ __forceinline__ bool next(int i, GUnit& o) const { if (i != 0) return false; o = u; return true; } };

__device__ __forceinline__ bf16x8 pack8(const f32x4& a, const f32x4& b) {
  u32x4 o; o[0] = cvt_pk_bf16(a[0], a[1]); o[1] = cvt_pk_bf16(a[2], a[3]); o[2] = cvt_pk_bf16(b[0], b[1]); o[3] = cvt_pk_bf16(b[2], b[3]); return __builtin_bit_cast(bf16x8, o);
}
__device__ __forceinline__ bf16x4 pack4(float a, float b, float c, float d) { u32x2 o; o[0] = cvt_pk_bf16(a, b); o[1] = cvt_pk_bf16(c, d); return __builtin_bit_cast(bf16x4, o); }

struct EpiSwiglu {
  static constexpr bool AFTER_DRAIN = false;
  u16* h;
  __device__ __forceinline__ void operator()(const f32x4 (&acc)[2][2][4][2], const GUnit& u, int wr, int wc, int fr, int fq) const {
    const int row0 = u.pm * BM + wr * 64 + fr, col0 = u.pn * 128 + wc * 32 + fq * 8;
#pragma unroll
    for (int ai = 0; ai < 2; ++ai)
#pragma unroll
      for (int m = 0; m < 4; ++m) {
        f32x4 r[2];
#pragma unroll
        for (int n = 0; n < 2; ++n)
#pragma unroll
          for (int j = 0; j < 4; ++j) { const float a = acc[ai][0][m][n][j], g = acc[ai][1][m][n][j]; r[n][j] = a * sigmoidf_(a) * g; }
        *(bf16x8*)(h + (size_t)(row0 + ai * HALF + m * 16) * DFF + col0) = pack8(r[0], r[1]);
      }
  }
};
struct EpiResidNorm {
  static constexpr bool AFTER_DRAIN = true;
  const Params& p; int l, kind;
  __device__ __forceinline__ void fused(f32x4 (&acc)[2][2][3][2], const GUnit& un, int wr, int wc, int fr, int fq, LAS unsigned char* lds) const {
    const bool isout = kind == 8, fin = (kind == 11 && l == 1), firstres = (l == 0 && kind == 2);
    const int use = l * 3 + (kind == 2 ? 0 : (isout ? 1 : 2)), nk = kind == 2 ? 1 : (isout ? 2 : 0), nl = kind == 11 ? l + 1 : l;
    float* x = p.out; u16* xb = p.gb + (size_t)NTOK * 1536;
    const float* gatev = p.mods + (size_t)l * 5 * 9216 + (isout ? 5 : (kind == 2 ? 2 : 8)) * 1024; const float coef = isout ? 1.0f : 0.5f;
    u16* u = p.u; const float* gn = fin ? p.g_final : p.g_norm + ((size_t)nl * 3 + nk) * D; const float* mdn = fin ? p.mods : p.mods + (size_t)nl * 5 * 9216 + nk * 3 * 1024;
    float* part = p.part + (size_t)use * 64 * 4 * 192; unsigned* cnt = p.ctr + XB_PCNT + use * 64;
    const int tid = tid_opaque();
    const int col0 = un.pn * BM + wc * 32 + fq * 8;
    LAS float* rp = (LAS float*)lds; LAS float* rs = rp + 1024;
#pragma unroll
    for (int ai = 0; ai < 2; ++ai)
#pragma unroll
      for (int m = 0; m < 3; ++m) {
        const int rl = ai * 96 + wr * 48 + m * 16 + fr; const int row = un.pm * 192 + rl;
        u16* xs = xb + (size_t)row * D + col0;
        const float* gp = gatev + cond_of(row) * 9216 + col0;
        bf16x8 xr[2]; f32x4 g[2][2];
#pragma unroll
        for (int bj = 0; bj < 2; ++bj) { xr[bj] = *(const bf16x8*)(xs + bj * HALF);
#pragma unroll
          for (int n = 0; n < 2; ++n) g[bj][n] = *(const f32x4*)(gp + bj * HALF + n * 4); }
        float s = 0.f;
#pragma unroll
        for (int bj = 0; bj < 2; ++bj) {
#pragma unroll
          for (int n = 0; n < 2; ++n) { f32x4 xo;
#pragma unroll
            for (int q = 0; q < 4; ++q) xo[q] = bf2f((u16)xr[bj][n * 4 + q]);
            const f32x4 xn = xo + coef * g[bj][n] * acc[ai][bj][m][n]; acc[ai][bj][m][n] = xn;
            s += xn[0] * xn[0] + xn[1] * xn[1] + xn[2] * xn[2] + xn[3] * xn[3]; }
          if (!fin) *(bf16x8*)(xs + bj * HALF) = pack8(acc[ai][bj][m][0], acc[ai][bj][m][1]); }
        s += __shfl_xor(s, 16); s += __shfl_xor(s, 32);
        if (fq == 0) rp[rl * 4 + wc] = s;
      }
    __syncthreads();
    float* slot = part + (size_t)(un.pm * 4) * 192;
    if (tid < 192) { const float t = (rp[tid * 4] + rp[tid * 4 + 1]) + (rp[tid * 4 + 2] + rp[tid * 4 + 3]);
      __hip_atomic_store(slot + un.pn * 192 + tid, t, __ATOMIC_RELAXED, __HIP_MEMORY_SCOPE_AGENT); }
    asm volatile("s_waitcnt vmcnt(0)" ::: "memory");
    __syncthreads();
    if (tid == 0) {
      __hip_atomic_fetch_add(cnt + un.pm, 1u, __ATOMIC_RELAXED, __HIP_MEMORY_SCOPE_AGENT);
      unsigned sp = 0;
      while (__hip_atomic_load(cnt + un.pm, __ATOMIC_RELAXED, __HIP_MEMORY_SCOPE_AGENT) < 4u) { __builtin_amdgcn_s_sleep(1); if (++sp > (1u << 22)) break; }
    }
    __syncthreads();
    if (tid < 192) { float t = 0.f;
#pragma unroll
      for (int q = 0; q < 4; ++q) t += __hip_atomic_load(slot + q * 192 + tid, __ATOMIC_RELAXED, __HIP_MEMORY_SCOPE_AGENT);
      rs[tid] = rsqrtf(t * (1.f / 1024.f) + EPS); }
    __syncthreads();
    const float* gnp = gn + col0;
    f32x4 gw0[2][2];
#pragma unroll
    for (int bj = 0; bj < 2; ++bj)
#pragma unroll
      for (int n = 0; n < 2; ++n) gw0[bj][n] = *(const f32x4*)(gnp + bj * HALF + n * 4);
#pragma unroll
    for (int ai = 0; ai < 2; ++ai)
#pragma unroll
      for (int m = 0; m < 3; ++m) { const int rl = ai * 96 + wr * 48 + m * 16 + fr; const float rstd = rs[rl]; const int row = un.pm * 192 + rl; const unsigned eo = (unsigned)(row * D + col0);
        if (fin) {
#pragma unroll
          for (int bj = 0; bj < 2; ++bj) { *(f32x4*)(x + (eo + bj * HALF)) = acc[ai][bj][m][0] * rstd * gw0[bj][0]; *(f32x4*)(x + (eo + bj * HALF + 4)) = acc[ai][bj][m][1] * rstd * gw0[bj][1]; }
        } else { const float* md = mdn + cond_of(row) * 9216 + col0;
#pragma unroll
          for (int bj = 0; bj < 2; ++bj) { f32x4 o[2];
#pragma unroll
            for (int n = 0; n < 2; ++n) o[n] = acc[ai][bj][m][n] * rstd * gw0[bj][n] * (1.f + *(const f32x4*)(md + 1024 + bj * HALF + n * 4)) + *(const f32x4*)(md + bj * HALF + n * 4);
            *(bf16x8*)(u + (eo + bj * HALF)) = pack8(o[0], o[1]); } } }
  }
};
struct EpiBig {
  static constexpr bool AFTER_DRAIN = false;
  u16 *zA, *gb, *Yt; float* out; int l; float* gate; const float* bmg;
  __device__ __forceinline__ void operator()(const f32x4 (&acc)[2][2][4][2], const GUnit& u, int wr, int wc, int fr, int fq) const {
    const int row0 = u.pm * BM + wr * 64 + fr; const int pn = u.pn; const int colw = wc * 32 + fq * 8;
#pragma unroll
    for (int ai = 0; ai < 2; ++ai)
#pragma unroll
      for (int m = 0; m < 4; ++m) {
        const int row = row0 + ai * HALF + m * 16;
#pragma unroll
        for (int bj = 0; bj < 2; ++bj) {
          const int c = pn * BM + bj * HALF + colw;
          f32x4 v0 = acc[ai][bj][m][0], v1 = acc[ai][bj][m][1];
          if (pn < 6) {
            *(bf16x8*)(zA + (size_t)row * ZLD + c) = pack8(v0, v1);
            if (pn >= 2 && row < NCTX) {
              const int cc = (c - 512) & 511, hh = cc >> 7, d = cc & 127, b = row >> 8, t = row & 255;
              float* o = out + (pn < 4 ? O_CK : O_CV) + ((((size_t)(b * 2 + l) * 4 + hh) * 256 + t) * 128 + d);
              *(f32x4*)o = v0; *(f32x4*)(o + 4) = v1;
            }
          } else if (pn < 10) {
            const int cp = c - 1536, g = cp >> 8, j = cp & 255, cs = j >> 7, np = j & 127;
            u16* base;
            if (row < NCTX) { const int b = row >> 8, t = row & 255; base = Yt + (size_t)b * 512 * 512 + (size_t)(g * 128 + np) * 512 + cs * 256 + t;
#pragma unroll
              for (int q = 0; q < 4; ++q) { base[(size_t)q * 512] = f2bf(v0[q]); base[(size_t)(q + 4) * 512] = f2bf(v1[q]); }
            } else { const int rr = row - NCTX, b = rr >> 10, t = rr & 1023; base = Yt + (size_t)32 * 512 * 512 + (size_t)b * 512 * 2048 + (size_t)(g * 128 + np) * 2048 + cs * 1024 + t;
#pragma unroll
              for (int q = 0; q < 4; ++q) { base[(size_t)q * 2048] = f2bf(v0[q]); base[(size_t)(q + 4) * 2048] = f2bf(v1[q]); }
            }
          } else if (pn < 18) {
            if (pn == 12 || pn == 13) { v0 *= 0.08838834764831845f; v1 *= 0.08838834764831845f; }
            if (pn >= 16) {
#pragma unroll
              for (int q = 0; q < 4; ++q) { v0[q] = sigmoidf_(v0[q]); v1[q] = sigmoidf_(v1[q]); }
            }
            *(bf16x8*)(zA + (size_t)row * ZLD + (c - 1024)) = pack8(v0, v1);
          } else if (pn < 30) {
#pragma unroll
            for (int q = 0; q < 4; ++q) { v0[q] = sigmoidf_(v0[q]); v1[q] = sigmoidf_(v1[q]); }
            { unsigned w0 = 0u, w1 = 0u;
#pragma unroll
              for (int q = 0; q < 4; ++q) { w0 |= ((unsigned)(v0[q] * 255.f + 0.5f)) << (8 * q); w1 |= ((unsigned)(v1[q] * 255.f + 0.5f)) << (8 * q); }
              u32x2 w; w[0] = w0; w[1] = w1; *(u32x2*)((unsigned char*)gb + (size_t)row * GBLD + (c - 4608)) = w; }
          } else if (bj == 0 && wc == 0 && fq < 2) {
#pragma unroll
            for (int q = 0; q < 8; ++q) { const int j = fq * 8 + q; float a = (q < 4 ? v0[q] : v1[q - 4]) + bmg[l * 16 + j];
              if ((j >> 2) & 1) a = fminf(a, 0.f) - log1pf(__expf(-fabsf(a)));
              gate[(size_t)row * 16 + j] = a; }
          }
        }
      }
  }
};
struct EpiBranch {
  static constexpr bool AFTER_DRAIN = false;
  u16* tmp; const u16* gb; u16* merged;
  __device__ __forceinline__ void operator()(const f32x4 (&acc)[2][2][3][2], const GUnit& u, int wr, int wc, int fr, int fq) const {
    const int row0 = u.pm * 192 + wr * 48 + fr, col0 = u.pn * BM + wc * 32 + fq * 8; const int br = u.aux;
    u16* dst = br < 2 ? tmp : merged;
#pragma unroll
    for (int ai = 0; ai < 2; ++ai) {
      u32x2 g8[3][2]; bf16x8 t8[3][2];
#pragma unroll
      for (int m = 0; m < 3; ++m)
#pragma unroll
        for (int bj = 0; bj < 2; ++bj) { const int row = row0 + ai * 96 + m * 16, c = col0 + bj * HALF;
          g8[m][bj] = *(const u32x2*)((const unsigned char*)gb + (size_t)row * GBLD + br * D + c);
          if (br > 0) t8[m][bj] = *(const bf16x8*)(tmp + (size_t)row * D + c); }
#pragma unroll
      for (int m = 0; m < 3; ++m)
#pragma unroll
        for (int bj = 0; bj < 2; ++bj) { const int row = row0 + ai * 96 + m * 16, c = col0 + bj * HALF;
          f32x4 r0, r1;
#pragma unroll
          for (int q = 0; q < 4; ++q) { r0[q] = (float)((g8[m][bj][0] >> (8 * q)) & 0xffu) * (1.f / 255.f) * acc[ai][bj][m][0][q]; r1[q] = (float)((g8[m][bj][1] >> (8 * q)) & 0xffu) * (1.f / 255.f) * acc[ai][bj][m][1][q]; }
          if (br > 0) {
#pragma unroll
            for (int q = 0; q < 4; ++q) { r0[q] += bf2f((u16)t8[m][bj][q]); r1[q] += bf2f((u16)t8[m][bj][q + 4]); } }
          *(bf16x8*)(dst + (size_t)row * D + c) = pack8(r0, r1); }
    }
  }
};
struct EpiFour {
  static constexpr bool AFTER_DRAIN = false;
  u16* fo; float scale;
  __device__ __forceinline__ void operator()(const f32x4 (&acc)[2][2][4][2], const GUnit& u, int wr, int wc, int fr, int fq) const {
    const int row0 = u.pm + wr * 64 + fr, col0 = u.pn * BM + wc * 32 + fq * 8;
#pragma unroll
    for (int ai = 0; ai < 2; ++ai)
#pragma unroll
      for (int m = 0; m < 4; ++m)
#pragma unroll
        for (int bj = 0; bj < 2; ++bj)
          *(bf16x8*)(fo + (size_t)(row0 + ai * HALF + m * 16) * 512 + col0 + bj * HALF) = pack8(acc[ai][bj][m][0] * scale, acc[ai][bj][m][1] * scale);
  }
};

struct TrJob { const float* src; u16* dst; int lds_, ldd, k0, ns0, nd0, mode; };
__device__ __forceinline__ void tr_decode(const Params& p, int l, int j, TrJob& t) {
  t.mode = 0;
  if (j < 352 || (j >= 528 && j < 880)) { const bool second = j >= 528; const int q = second ? j - 528 : j; const int kt = q / 22, nb = q % 22;
    t.src = (second ? p.w_ffn2_in : p.w_ffn1_in) + (size_t)l * D * 2 * DFF; t.dst = second ? p.wt_ffn2_in : p.wt_ffn1_in; t.lds_ = 2 * DFF; t.ldd = D; t.k0 = kt * 64; t.ns0 = nb * 256; t.nd0 = 0; t.mode = 1; }
  else if (j < 528 || (j >= 880 && j < 1056)) { const bool second = j >= 880; const int q = second ? j - 880 : j - 352; const int kt = q >> 2, nb = q & 3;
    t.src = (second ? p.w_ffn2_out : p.w_ffn1_out) + (size_t)l * DFF * D; t.dst = second ? p.wt_ffn2_out : p.wt_ffn1_out; t.lds_ = D; t.ldd = DFF; t.k0 = kt * 64; t.ns0 = nb * 256; t.nd0 = t.ns0; }
  else if (j < 1280) { const int q = j - 1056, kt = q / 14, nb = q % 14; t.src = p.w_in + (size_t)l * D * PIN; t.dst = p.wt_big; t.lds_ = PIN; t.ldd = D; t.k0 = kt * 64;
    if (nb < 6) { t.ns0 = nb * 256; t.nd0 = t.ns0; } else { t.ns0 = 2048 + (nb - 6) * 256; t.nd0 = t.ns0 + 512; } }
  else if (j < 1472) { const int q = j - 1280, kt = q / 12, nb = q % 12; t.src = p.w_branch_gate + (size_t)l * D * 3 * D; t.dst = p.wt_big; t.lds_ = 3 * D; t.ldd = D; t.k0 = kt * 64; t.ns0 = nb * 256; t.nd0 = 4608 + t.ns0; }
  else if (j < 1568) { const int q = j - 1472, br = q >> 5, jj = q & 31, kt = jj >> 2, nb = jj & 3;
    t.src = (br == 0 ? p.w_br_attn : br == 1 ? p.w_br_four : p.w_br_mlstm) + (size_t)l * 512 * D; t.dst = p.wt_br + (size_t)br * D * 512; t.lds_ = D; t.ldd = 512; t.k0 = kt * 64; t.ns0 = nb * 256; t.nd0 = t.ns0; }
  else { const int q = j - 1568, kt = q >> 2, nb = q & 3; t.src = p.w_out + (size_t)l * D * D; t.dst = p.wt_out; t.lds_ = D; t.ldd = D; t.k0 = kt * 64; t.ns0 = nb * 256; t.nd0 = t.ns0; }
}
__device__ __forceinline__ void tr_load(const TrJob& t, int tid, f32x4 (&r)[8]) {
#pragma unroll
  for (int i = 0; i < 8; ++i) { const int idx = tid + i * 512, kk = idx >> 6, c4 = idx & 63; r[i] = *(const f32x4*)(t.src + (size_t)(t.k0 + kk) * t.lds_ + t.ns0 + c4 * 4); }
}

__device__ void wf_job(const Params& p, int l, int job, LAS float* sm) {
  const int tid = tid_opaque();
  const int g = job >> 5, kb = (job >> 1) & 15, jh = job & 1; LAS float* W = sm; LAS float* ct = sm + 64 * 129;
  __syncthreads();
  for (int i = tid; i < 64 * 32; i += 512) { const int kk = i >> 5, c4 = i & 31;
    const float4 v = *(const float4*)(p.w_in + ((size_t)l * D + kb * 64 + kk) * PIN + 1536 + g * 128 + c4 * 4);
    LAS float* s = W + kk * 129 + c4 * 4; s[0] = v.x; s[1] = v.y; s[2] = v.z; s[3] = v.w; }
  if (tid < 128) ct[tid] = cospif((float)tid / 64.f);
  __syncthreads();
  const int kk = tid & 63, jg = tid >> 6; float a[16];
#pragma unroll
  for (int q = 0; q < 16; ++q) a[q] = 0.f;
  const int jbase = jh * 128 + jg * 16;
  for (int c = 0; c < 128; ++c) { const float w = W[kk * 129 + c];
#pragma unroll
    for (int q = 0; q < 16; ++q) { const int j = jbase + q; const int idx = jh ? ((c * (j - 128) - 32) & 127) : ((c * j) & 127); a[q] += w * ct[idx]; } }
#pragma unroll
  for (int q = 0; q < 16; ++q) p.wt_big[(size_t)(1536 + g * 256 + jbase + q) * D + kb * 64 + kk] = f2bf(a[q]);
}

__device__ void mods_job(const Params& p, int job, LAS float* sm) {
  const int tid = tid_opaque();
  const int l = job / 72, cb = job % 72; LAS float* sc = sm; LAS float* part = sm + 5 * 1024;
  __syncthreads();
  for (int i = tid; i < 5 * 1024; i += 512) { const int ci = i >> 10, k = i & 1023; const float v = ci == 0 ? p.c_ctx[k] : p.c[(ci - 1) * D + k]; sc[i] = v * sigmoidf_(v); }
  __syncthreads();
  const int cg4 = tid & 31, kp = tid >> 5; f32x4 a[5];
#pragma unroll
  for (int ci = 0; ci < 5; ++ci) a[ci] = (f32x4){0.f, 0.f, 0.f, 0.f};
  const float* wp = p.w_ada + ((size_t)l * D + kp * 64) * 9216 + cb * 128 + cg4 * 4;
#pragma unroll 8
  for (int k = 0; k < 64; ++k) { const f32x4 w = *(const f32x4*)(wp + (size_t)k * 9216);
#pragma unroll
    for (int ci = 0; ci < 5; ++ci) a[ci] += sc[ci * 1024 + kp * 64 + k] * w; }
#pragma unroll
  for (int ci = 0; ci < 5; ++ci)
#pragma unroll
    for (int q = 0; q < 4; ++q) part[(kp * 5 + ci) * 128 + cg4 * 4 + q] = a[ci][q];
  __syncthreads();
  for (int o = tid; o < 640; o += 512) { const int ci = o >> 7, cc = o & 127; float s = p.b_ada[(size_t)l * 9216 + cb * 128 + cc];
    for (int q = 0; q < 16; ++q) s += part[(q * 5 + ci) * 128 + cc];
    p.mods[((size_t)l * 5 + ci) * 9216 + cb * 128 + cc] = s; }
}

__device__ void prep_seg(const Params& p, int l, int seg, LAS unsigned char* lds, volatile LAS int* segdone) {
  if (segdone[l * 2 + seg]) return;
  const int tid = tid_opaque(); LAS float* sm = (LAS float*)lds; LAS int* s_job = (LAS int*)(lds + 131072 - 16);
  const int qi = 8 + l * 2 + seg;
  const int npre = seg ? 129 : (l == 0 ? 144 : 0), trofs = seg ? 528 : 0, ntr = seg ? 1104 : 528;
  const int trbase = npre, njobs = npre + ntr;
  int job;
  for (;;) {
    __syncthreads();
    if (tid == 0) *s_job = (int)atomicAdd(p.ctr + XB_CTR + qi, 1u);
    __syncthreads();
    job = *s_job;
    if (job >= njobs && tid == 0) segdone[l * 2 + seg] = 1;
    if (job >= trbase) break;
    if (seg && job == 128) { for (int i = tid; i < 16 * 1024; i += 512) { const int j = i >> 10, k = i & 1023; p.wt_big[(size_t)(7680 + j) * D + k] = f2bf(p.w_in[((size_t)l * D + k) * PIN + 4096 + j]); } }
    else if (seg) wf_job(p, l, job, sm); else mods_job(p, job, sm);
  }
  if (job >= njobs) return;
  f32x4 r[8]; TrJob t;
  tr_decode(p, l, job - trbase + trofs, t); tr_load(t, tid, r);
  for (;;) {
    __syncthreads();
#pragma unroll
    for (int i = 0; i < 8; ++i) { const int idx = tid + i * 512, kk = idx >> 6, c4 = idx & 63; LAS float* s = sm + kk * 257 + c4 * 4; s[0] = r[i][0]; s[1] = r[i][1]; s[2] = r[i][2]; s[3] = r[i][3]; }
    if (tid == 0) *s_job = (int)atomicAdd(p.ctr + XB_CTR + qi, 1u);
    __syncthreads();
    const int nextjob = *s_job; const TrJob cur = t;
    if (nextjob >= njobs && tid == 0) segdone[l * 2 + seg] = 1;
    if (nextjob < njobs) { tr_decode(p, l, nextjob - trbase + trofs, t); tr_load(t, tid, r); }
#pragma unroll
    for (int i = 0; i < 4; ++i) { const int unit = tid + i * 512, nn = unit >> 3, ch = unit & 7; bf16x8 o;
#pragma unroll
      for (int q = 0; q < 8; ++q) o[q] = (short)f2bf(sm[(ch * 8 + q) * 257 + nn]);
      int drow;
      if (cur.mode == 1) { const int col = cur.ns0 + nn, isg = col >= DFF, hid = col - isg * DFF; drow = (hid >> 7) * 256 + isg * 128 + (hid & 127); } else drow = cur.nd0 + nn;
      *(bf16x8*)(cur.dst + (size_t)drow * cur.ldd + cur.k0 + ch * 8) = o; }
    if (nextjob >= njobs) break;
  }
}

__device__ void phase0(const Params& p, LAS unsigned char* lds) {
  const int tid = tid_opaque(); const int G = gridDim.x;
  if (blockIdx.x == 0 && tid >= 64 && tid < 66) { const int l = tid - 64; const float* lp = p.attn_lambda + l * 256; float s1 = 0.f, s2 = 0.f;
    for (int i = 0; i < 64; ++i) { s1 += lp[i] * lp[64 + i]; s2 += lp[128 + i] * lp[192 + i]; }
    p.lam[l] = expf(s1) - expf(s2) + lam_init_of(l); }
  const int gtid = blockIdx.x * 512 + tid, gn = G * 512;
  for (int i = gtid; i < 1024 * 2048; i += gn) { const int tp = i >> 11, col = i & 2047, t = col & 1023, s = col >> 10; const int r = (t * tp) & 1023; const float x = (float)r / 512.f;
    p.cs1024[i] = f2bf(s ? -sinpif(x) : cospif(x)); }
  for (int i = gtid; i < 256 * 512; i += gn) { const int tp = i >> 9, col = i & 511, t = col & 255, s = col >> 8; const int r = (t * tp) & 255; const float x = (float)r / 128.f;
    p.cs256[i] = f2bf(s ? -sinpif(x) : cospif(x)); }
  for (int i = gtid; i < 1024 * 32; i += gn) { const int t = i >> 5, pp = i & 31; const float pos = pp < 16 ? (float)(t >> 6) : (float)(t & 63);
    const float inv = powf(10000.f, -(float)(pp & 15) / 16.f); float s, c; sincosf(pos * inv, &s, &c); p.rope[2 * i] = c; p.rope[2 * i + 1] = s; }
}

__device__ __forceinline__ float wave_sum(float v) {
#pragma unroll
  for (int o = 32; o >= 1; o >>= 1) v += __shfl_xor(v, o);
  return v;
}
__device__ void norm_phase(const Params& p, int l, int which, LAS unsigned char* lds) {
  const int tid = tid_opaque(), wid = tid >> 6, lane = tid & 63; const bool gates = which == 1;
  LAS float* Wg = (LAS float*)lds; LAS float* ur = Wg + 16384 + wid * 1024;
  if (gates) { __syncthreads();
    for (int i = tid; i < 4096; i += 512) { const int k = i >> 2, q = i & 3; const float4 v = *(const float4*)(p.w_in + ((size_t)l * D + k) * PIN + 4096 + q * 4);
      LAS float* s = Wg + k * 16 + q * 4; s[0] = v.x; s[1] = v.y; s[2] = v.z; s[3] = v.w; }
    __syncthreads(); }
  float* X = p.out; const bool first = (l == 0 && which == 0);
  const float* Xc = first ? p.x_prompt : X; const float* Xl = first ? p.x_sample : X + (size_t)NCTX * D;
#define XROW(r) ((r) < NCTX ? Xc + (size_t)(r) * D : Xl + (size_t)((r) - NCTX) * D)
  f32x4 v[4], vn[4];
  { const int rg0 = blockIdx.x; if (rg0 < NTOK / 8) { const float* xr = XROW(rg0 * 8 + wid);
#pragma unroll
      for (int i = 0; i < 4; ++i) v[i] = *(const f32x4*)(xr + i * 256 + lane * 4); } }
  for (int rg = blockIdx.x; rg < NTOK / 8; rg += gridDim.x) {
    const int row = rg * 8 + wid; float* xr = X + (size_t)row * D;
    const int rgn = rg + gridDim.x;
    if (rgn < NTOK / 8) { const float* xn = XROW(rgn * 8 + wid);
#pragma unroll
      for (int i = 0; i < 4; ++i) vn[i] = *(const f32x4*)(xn + i * 256 + lane * 4); }
    float ss = 0.f;
#pragma unroll
    for (int i = 0; i < 4; ++i) ss += v[i][0] * v[i][0] + v[i][1] * v[i][1] + v[i][2] * v[i][2] + v[i][3] * v[i][3];
    ss = wave_sum(ss); const float rstd = rsqrtf(ss * (1.f / 1024.f) + EPS);
    if (which == 3) {
#pragma unroll
      for (int i = 0; i < 4; ++i) { const f32x4 g = *(const f32x4*)(p.g_final + i * 256 + lane * 4); *(f32x4*)(xr + i * 256 + lane * 4) = v[i] * rstd * g; }
    } else {
      const float* md = p.mods + ((size_t)l * 5 + cond_of(row)) * 9216 + which * 3 * 1024; const float* gn = p.g_norm + ((size_t)l * 3 + which) * D;
#pragma unroll
      for (int i = 0; i < 4; ++i) { const int c = i * 256 + lane * 4; const f32x4 g = *(const f32x4*)(gn + c), sh = *(const f32x4*)(md + c), sc = *(const f32x4*)(md + 1024 + c);
        if (first) *(bf16x4*)(p.gb + (size_t)NTOK * 1536 + (size_t)row * D + c) = pack4(v[i][0], v[i][1], v[i][2], v[i][3]);
        v[i] = v[i] * rstd * g * (1.f + sc) + sh;
        *(bf16x4*)(p.u + (size_t)row * D + c) = pack4(v[i][0], v[i][1], v[i][2], v[i][3]); }
      if (gates) {
        __syncthreads();
#pragma unroll
        for (int i = 0; i < 4; ++i) { LAS float* s = ur + i * 256 + lane * 4; s[0] = v[i][0]; s[1] = v[i][1]; s[2] = v[i][2]; s[3] = v[i][3]; }
        __syncthreads();
        const int j = lane & 15, kp = lane >> 4; float a = 0.f;
#pragma unroll 8
        for (int kk = 0; kk < 256; ++kk) a += ur[kk * 4 + kp] * Wg[(kk * 4 + kp) * 16 + j];
        a += __shfl_xor(a, 16); a += __shfl_xor(a, 32);
        if (lane < 16) { a += p.b_mgate[l * 16 + j]; if ((j >> 2) & 1) a = fminf(a, 0.f) - log1pf(__expf(-fabsf(a))); p.gate[(size_t)row * 16 + j] = a; }
      }
    }
#pragma unroll
    for (int i = 0; i < 4; ++i) v[i] = vn[i];
  }
}

__device__ void attn_item(const Params& p, int l, int item, LAS unsigned char* lds) {
  const int tid = tid_opaque(), wid = tid >> 6, lane = tid & 63, fr = lane & 15, fq = lane >> 4;
  const bool lat = item < 128; int b, h, qb, seqbase, nkt;
  if (lat) { b = item >> 5; h = (item >> 3) & 3; qb = item & 7; seqbase = NCTX + b * 1024; nkt = 20; }
  else { const int i2 = item - 128; b = i2 >> 3; h = (i2 >> 1) & 3; qb = i2 & 1; seqbase = b * 256; nkt = 4; }
  LAS unsigned char* Ks = lds; LAS unsigned char* VT = lds + 64 * 272;
  const float2* rope = (const float2*)p.rope;
  const int qtok = qb * 128 + wid * 16 + fr;
  bf16x8 Qf[2][2];
  { const u16* qp = p.zA + (size_t)(seqbase + qtok) * ZLD + h * 128;
#pragma unroll
    for (int i = 0; i < 2; ++i)
#pragma unroll
      for (int kk = 0; kk < 2; ++kk) Qf[i][kk] = *(const bf16x8*)(qp + i * 64 + kk * 32 + fq * 8);
    if (lat) {
#pragma unroll
      for (int j = 0; j < 8; ++j) { const float2 cs = rope[qtok * 32 + fq * 8 + j];
#pragma unroll
        for (int i = 0; i < 2; ++i) { const float x1 = bf2f((u16)Qf[i][0][j]), x2 = bf2f((u16)Qf[i][1][j]);
          Qf[i][0][j] = (short)f2bf(x1 * cs.x - x2 * cs.y); Qf[i][1][j] = (short)f2bf(x1 * cs.y + x2 * cs.x); } }
    }
  }
  f32x4 O[2][8];
#pragma unroll
  for (int i = 0; i < 2; ++i)
#pragma unroll
    for (int d = 0; d < 8; ++d) O[i][d] = (f32x4){0.f, 0.f, 0.f, 0.f};
  float mrun[2] = {-1e30f, -1e30f}, lrun[2] = {0.f, 0.f};
  const float sc = 0.125f * 1.4426950408889634f;
  const int skey = tid >> 3, ssub = tid & 7, smap = ssub >> 2, spg = ssub & 3, sd1 = smap * 64 + spg * 8;
  f32x4 kraw[4], vraw[4]; float2 rcs[8];
#define ATT_ISSUE(kt_) do { const int kt__ = (kt_); const int gk = kt__ * 64 + skey, gkv = kt__ * 64 + lane; \
    if (lat && kt__ < 4) { const float* kp = p.cache_k + ((((size_t)(b * 2 + l) * 4 + h) * 256 + gk) * 128) + sd1; \
      kraw[0] = *(const f32x4*)kp; kraw[1] = *(const f32x4*)(kp + 4); kraw[2] = *(const f32x4*)(kp + 32); kraw[3] = *(const f32x4*)(kp + 36); \
      const float* vp = p.cache_v + ((((size_t)(b * 2 + l) * 4 + h) * 256 + gkv) * 128) + wid * 16; \
      vraw[0] = *(const f32x4*)vp; vraw[1] = *(const f32x4*)(vp + 4); vraw[2] = *(const f32x4*)(vp + 8); vraw[3] = *(const f32x4*)(vp + 12); \
    } else { const int tok = lat ? gk - 256 : gk, tokv = lat ? gkv - 256 : gkv; const u16* kp = p.zA + (size_t)(seqbase + tok) * ZLD + 512 + h * 128 + sd1; \
      kraw[0] = *(const f32x4*)kp; kraw[1] = *(const f32x4*)(kp + 32); \
      const u16* vp = p.zA + (size_t)(seqbase + tokv) * ZLD + 1024 + h * 128 + wid * 16; vraw[0] = *(const f32x4*)vp; vraw[1] = *(const f32x4*)(vp + 8); \
      if (lat) { _Pragma("unroll") for (int j = 0; j < 8; ++j) rcs[j] = rope[tok * 32 + spg * 8 + j]; } } } while (0)
  ATT_ISSUE(0);
  for (int kt = 0; kt < nkt; ++kt) {
    __syncthreads();
    { float x1[8], x2[8];
      if (lat && kt < 4) {
#pragma unroll
        for (int j = 0; j < 4; ++j) { x1[j] = kraw[0][j]; x1[j + 4] = kraw[1][j]; x2[j] = kraw[2][j]; x2[j + 4] = kraw[3][j]; }
      } else { const bf16x8 a = __builtin_bit_cast(bf16x8, kraw[0]), bb = __builtin_bit_cast(bf16x8, kraw[1]);
#pragma unroll
        for (int j = 0; j < 8; ++j) { x1[j] = bf2f((u16)a[j]); x2[j] = bf2f((u16)bb[j]); }
        if (lat) {
#pragma unroll
          for (int j = 0; j < 8; ++j) { const float2 cs = rcs[j]; const float o1 = x1[j] * cs.x - x2[j] * cs.y, o2 = x1[j] * cs.y + x2[j] * cs.x; x1[j] = o1; x2[j] = o2; }
        }
      }
      bf16x8 o1, o2;
      { u32x4 t1, t2;
#pragma unroll
        for (int j = 0; j < 4; ++j) { t1[j] = cvt_pk_bf16(x1[2 * j], x1[2 * j + 1]); t2[j] = cvt_pk_bf16(x2[2 * j], x2[2 * j + 1]); }
        o1 = __builtin_bit_cast(bf16x8, t1); o2 = __builtin_bit_cast(bf16x8, t2); }
      *(LAS bf16x8*)(Ks + skey * 272 + sd1 * 2) = o1; *(LAS bf16x8*)(Ks + skey * 272 + (sd1 + 32) * 2) = o2;
    }
    { const int key = lane, d0 = wid * 16; u16 xv[16];
      if (lat && kt < 4) {
#pragma unroll
        for (int q = 0; q < 4; ++q)
#pragma unroll
          for (int j = 0; j < 4; ++j) xv[q * 4 + j] = f2bf(vraw[q][j]);
      } else { const bf16x8 a = __builtin_bit_cast(bf16x8, vraw[0]), bb = __builtin_bit_cast(bf16x8, vraw[1]);
#pragma unroll
        for (int j = 0; j < 8; ++j) { xv[j] = (u16)a[j]; xv[j + 8] = (u16)bb[j]; } }
      const int pos = (key & 32) | (((key >> 2) & 3) << 3) | (((key >> 4) & 1) << 2) | (key & 3);
#pragma unroll
      for (int i = 0; i < 16; ++i) *(LAS u16*)(VT + (d0 + i) * 144 + pos * 2) = xv[i];
    }
    if (kt + 1 < nkt) ATT_ISSUE(kt + 1);
    __syncthreads();
    bf16x8 Pf[2][2];
#pragma unroll
    for (int i = 0; i < 2; ++i) {
      f32x4 S[4];
#pragma unroll
      for (int st = 0; st < 4; ++st) { S[st] = (f32x4){0.f, 0.f, 0.f, 0.f};
#pragma unroll
        for (int kk = 0; kk < 2; ++kk) { const bf16x8 Kf = *(const LAS bf16x8*)(Ks + (st * 16 + fr) * 272 + (i * 64 + kk * 32 + fq * 8) * 2);
          S[st] = __builtin_amdgcn_mfma_f32_16x16x32_bf16(Kf, Qf[i][kk], S[st], 0, 0, 0); } }
      float mx = -1e30f;
#pragma unroll
      for (int st = 0; st < 4; ++st)
#pragma unroll
        for (int j = 0; j < 4; ++j) mx = fmaxf(mx, S[st][j]);
      mx = fmaxf(mx, __shfl_xor(mx, 16)); mx = fmaxf(mx, __shfl_xor(mx, 32));
      const float mnew = fmaxf(mrun[i], mx), alpha = __builtin_amdgcn_exp2f((mrun[i] - mnew) * sc); mrun[i] = mnew;
      float ls = 0.f;
#pragma unroll
      for (int st = 0; st < 4; ++st)
#pragma unroll
        for (int j = 0; j < 4; ++j) { const float pv = __builtin_amdgcn_exp2f((S[st][j] - mnew) * sc); ls += pv; S[st][j] = pv; }
      lrun[i] = lrun[i] * alpha + ls;
#pragma unroll
      for (int d = 0; d < 8; ++d) O[i][d] *= alpha;
#pragma unroll
      for (int ks = 0; ks < 2; ++ks)
#pragma unroll
        for (int j = 0; j < 1; ++j) Pf[i][ks] = pack8(S[2 * ks], S[2 * ks + 1]);
    }
#pragma unroll
    for (int d = 0; d < 8; ++d)
#pragma unroll
      for (int ks = 0; ks < 2; ++ks) { const bf16x8 Vf = *(const LAS bf16x8*)(VT + (d * 16 + fr) * 144 + (ks * 32 + fq * 8) * 2);
        O[0][d] = __builtin_amdgcn_mfma_f32_16x16x32_bf16(Vf, Pf[0][ks], O[0][d], 0, 0, 0);
        O[1][d] = __builtin_amdgcn_mfma_f32_16x16x32_bf16(Vf, Pf[1][ks], O[1][d], 0, 0, 0); }
  }
#undef ATT_ISSUE
  float inv[2];
#pragma unroll
  for (int i = 0; i < 2; ++i) { float lt = lrun[i]; lt += __shfl_xor(lt, 16); lt += __shfl_xor(lt, 32); inv[i] = 1.f / lt; }
  const float lam = p.lam[l], li = lam_init_of(l); const float i0 = inv[0], i1 = inv[1] * lam;
  float ss = 0.f;
#pragma unroll
  for (int d = 0; d < 8; ++d)
#pragma unroll
    for (int j = 0; j < 4; ++j) { const float o = O[0][d][j] * i0 - O[1][d][j] * i1; O[0][d][j] = o; ss += o * o; }
  ss += __shfl_xor(ss, 16); ss += __shfl_xor(ss, 32);
  const float rstd = rsqrtf(ss * (1.f / 128.f) + EPS) * (1.f - li);
  u16* op = p.brin + (size_t)(seqbase + qtok) * 512 + h * 128 + fq * 4; const float* gs = p.g_attn_sub + l * 128 + fq * 4;
#pragma unroll
  for (int d = 0; d < 8; ++d) { const f32x4 g = *(const f32x4*)(gs + d * 16);
    *(bf16x4*)(op + d * 16) = pack4(O[0][d][0] * rstd * g[0], O[0][d][1] * rstd * g[1], O[0][d][2] * rstd * g[2], O[0][d][3] * rstd * g[3]); }
}

__device__ void mlstm_item(const Params& p, int l, int item, LAS unsigned char* lds) {
  const int tid = tid_opaque(), wid = tid >> 6, lane = tid & 63, fr = lane & 15, fq = lane >> 4;
  const bool lat = item < 32; int b, h, dir, seqbase, T;
  if (lat) { b = item >> 3; h = (item >> 1) & 3; dir = item & 1; seqbase = NCTX + b * 1024; T = 1024; }
  else { const int i2 = item - 32; b = i2 >> 3; h = (i2 >> 1) & 3; dir = i2 & 1; seqbase = b * 256; T = 256; }
  const int nch = T >> 6;
  LAS unsigned char* Qs = lds; LAS unsigned char* Ks = lds + 17408; LAS unsigned char* KTs = lds + 34816; LAS unsigned char* VTs = lds + 53248;
  LAS unsigned char* Cs = lds + 71680; LAS unsigned char* Ss = lds + 106496; LAS float* fl = (LAS float*)(lds + 115712);
  LAS float* a_s = fl; LAS float* g_s = fl + 64; LAS float* sp_s = fl + 128; LAS float* wl_s = fl + 192; LAS float* em_s = fl + 256; LAS float* nq_s = fl + 320;
  LAS float* denp = fl + 384; LAS float* nvec = fl + 512; LAS float* scal = fl + 640;
  const size_t sidx = ((size_t)(b * 2 + l) * 2 + dir) * 4 + h;
  f32x4 accC[8];
  __syncthreads();
  if (lat) { const float* cp = p.state_C + sidx * 16384 + (size_t)(wid * 16 + fr) * 128 + fq * 4;
#pragma unroll
    for (int kt = 0; kt < 8; ++kt) accC[kt] = *(const f32x4*)(cp + kt * 16);
    if (tid < 128) nvec[tid] = p.state_n[sidx * 128 + tid];
  } else {
#pragma unroll
    for (int kt = 0; kt < 8; ++kt) accC[kt] = (f32x4){0.f, 0.f, 0.f, 0.f};
    if (tid < 128) nvec[tid] = 0.f;
  }
#pragma unroll
  for (int kt = 0; kt < 8; ++kt) *(LAS bf16x4*)(Cs + (wid * 16 + fr) * 272 + (kt * 16 + fq * 4) * 2) = pack4(accC[kt][0], accC[kt][1], accC[kt][2], accC[kt][3]);
  float mst = lat ? p.state_m[sidx] : 0.f;
  f32x4 qraw[2], kraw[2], vraw[2]; float igr = 0.f, lfr = 0.f;
#define ML_ISSUE(ch_) do { const int ch__ = (ch_); { const int pos = tid >> 3, c16 = (tid & 7) * 16; const int gp_ = ch__ * 64 + pos, tok = dir ? T - 1 - gp_ : gp_; \
      const u16* zp = p.zA + (size_t)(seqbase + tok) * ZLD + h * 128 + c16; \
      qraw[0] = *(const f32x4*)(zp + 1536); qraw[1] = *(const f32x4*)(zp + 1536 + 8); kraw[0] = *(const f32x4*)(zp + 2048); kraw[1] = *(const f32x4*)(zp + 2048 + 8); } \
    { const int gp_ = ch__ * 64 + lane, tok = dir ? T - 1 - gp_ : gp_; const u16* vp = p.zA + (size_t)(seqbase + tok) * ZLD + 2560 + h * 128 + wid * 16; \
      vraw[0] = *(const f32x4*)vp; vraw[1] = *(const f32x4*)(vp + 8); \
      if (wid == 0) { const float* gp = p.gate + (size_t)(seqbase + tok) * 16 + dir * 8 + h; igr = gp[0]; lfr = gp[4]; } } } while (0)
  ML_ISSUE(0);
  for (int ch = 0; ch < nch; ++ch) {
    if (wid == 0) {
      const float ig = igr, lf = lfr; float bs = lf;
#pragma unroll
      for (int o = 1; o < 64; o <<= 1) { const float t = __shfl_up(bs, o); if (lane >= o) bs += t; }
      const float a = ig - bs; float gm = a;
#pragma unroll
      for (int o = 1; o < 64; o <<= 1) { const float t = __shfl_up(gm, o); if (lane >= o) gm = fmaxf(gm, t); }
      gm = fmaxf(gm, mst);
      const float g63 = __shfl(gm, 63), b63 = __shfl(bs, 63);
      a_s[lane] = a; g_s[lane] = gm; sp_s[lane] = __expf(mst - gm); wl_s[lane] = __expf(a - g63); em_s[lane] = __expf(-(bs + gm));
      if (lane == 0) { scal[0] = __expf(mst - g63); scal[1] = b63 + g63; } }
    { const int pos = tid >> 3, c16 = (tid & 7) * 16;
      *(LAS f32x4*)(Qs + pos * 272 + c16 * 2) = qraw[0]; *(LAS f32x4*)(Qs + pos * 272 + c16 * 2 + 16) = qraw[1];
      *(LAS f32x4*)(Ks + pos * 272 + c16 * 2) = kraw[0]; *(LAS f32x4*)(Ks + pos * 272 + c16 * 2 + 16) = kraw[1]; }
    { const bf16x8 v0 = __builtin_bit_cast(bf16x8, vraw[0]), v1 = __builtin_bit_cast(bf16x8, vraw[1]);
#pragma unroll
      for (int i = 0; i < 8; ++i) { *(LAS u16*)(VTs + (wid * 16 + i) * 144 + lane * 2) = (u16)v0[i]; *(LAS u16*)(VTs + (wid * 16 + 8 + i) * 144 + lane * 2) = (u16)v1[i]; } }
    if (ch + 1 < nch) ML_ISSUE(ch + 1);
    __syncthreads();
    { const float wl = wl_s[lane]; const bf16x8 k0 = *(const LAS bf16x8*)(Ks + lane * 272 + wid * 32), k1 = *(const LAS bf16x8*)(Ks + lane * 272 + wid * 32 + 16);
#pragma unroll
      for (int i = 0; i < 8; ++i) { *(LAS u16*)(KTs + (wid * 16 + i) * 144 + lane * 2) = f2bf(bf2f((u16)k0[i]) * wl); *(LAS u16*)(KTs + (wid * 16 + 8 + i) * 144 + lane * 2) = f2bf(bf2f((u16)k1[i]) * wl); } }
    { const int tt = wid & 3, spq = wid >> 2; const int t = tt * 16 + fr; const float gt = g_s[t]; float dsum = 0.f;
      bf16x8 Qf[4];
#pragma unroll
      for (int kk = 0; kk < 4; ++kk) Qf[kk] = *(const LAS bf16x8*)(Qs + t * 272 + (kk * 32 + fq * 8) * 2);
#pragma unroll
      for (int s2 = 0; s2 < 2; ++s2) { const int st = spq * 2 + s2; f32x4 acc = (f32x4){0.f, 0.f, 0.f, 0.f};
        if (st <= tt) {
#pragma unroll
          for (int kk = 0; kk < 4; ++kk) { const bf16x8 Kf = *(const LAS bf16x8*)(Ks + (st * 16 + fr) * 272 + (kk * 32 + fq * 8) * 2); acc = __builtin_amdgcn_mfma_f32_16x16x32_bf16(Kf, Qf[kk], acc, 0, 0, 0); }
        }
        float vv[4];
#pragma unroll
        for (int j = 0; j < 4; ++j) { const int s = st * 16 + fq * 4 + j; const float w = (s <= t) ? __expf(a_s[s] - gt) : 0.f; vv[j] = acc[j] * w; dsum += vv[j]; }
        *(LAS bf16x4*)(Ss + t * 144 + (st * 16 + fq * 4) * 2) = pack4(vv[0], vv[1], vv[2], vv[3]); }
      dsum += __shfl_xor(dsum, 16); dsum += __shfl_xor(dsum, 32);
      if (fq == 0) denp[spq * 64 + t] = dsum; }
    { const int t = tid >> 3, part = tid & 7; const bf16x8 q0 = *(const LAS bf16x8*)(Qs + t * 272 + part * 32), q1 = *(const LAS bf16x8*)(Qs + t * 272 + part * 32 + 16); float s = 0.f;
#pragma unroll
      for (int i = 0; i < 8; ++i) s += nvec[part * 16 + i] * bf2f((u16)q0[i]) + nvec[part * 16 + 8 + i] * bf2f((u16)q1[i]);
      s += __shfl_xor(s, 1); s += __shfl_xor(s, 2); s += __shfl_xor(s, 4);
      if (part == 0) nq_s[t] = s; }
    __syncthreads();
    const float decay = scal[0];
    { const int tt = wid & 3, vh = wid >> 2; const int t = tt * 16 + fr; const float spt = sp_s[t]; const float den = spt * nq_s[t] + denp[t] + denp[64 + t];
      const float rdn = 1.f / fmaxf(fabsf(den), em_s[t]);
      bf16x8 Qf[4], Sf[2];
#pragma unroll
      for (int kk = 0; kk < 4; ++kk) Qf[kk] = *(const LAS bf16x8*)(Qs + t * 272 + (kk * 32 + fq * 8) * 2);
#pragma unroll
      for (int ks = 0; ks < 2; ++ks) Sf[ks] = *(const LAS bf16x8*)(Ss + t * 144 + (ks * 32 + fq * 8) * 2);
      const int gp_ = ch * 64 + t, tok = dir ? T - 1 - gp_ : gp_; u16* hp = p.hdir + ((size_t)dir * NTOK + seqbase + tok) * 512 + h * 128 + fq * 4;
#pragma unroll
      for (int v4 = 0; v4 < 4; ++v4) { const int vt = vh * 4 + v4; f32x4 aS = (f32x4){0.f, 0.f, 0.f, 0.f}, aI = (f32x4){0.f, 0.f, 0.f, 0.f};
#pragma unroll
        for (int kk = 0; kk < 4; ++kk) { const bf16x8 Cf = *(const LAS bf16x8*)(Cs + (vt * 16 + fr) * 272 + (kk * 32 + fq * 8) * 2); aS = __builtin_amdgcn_mfma_f32_16x16x32_bf16(Cf, Qf[kk], aS, 0, 0, 0); }
#pragma unroll
        for (int ks = 0; ks < 2; ++ks) { const bf16x8 Vf = *(const LAS bf16x8*)(VTs + (vt * 16 + fr) * 144 + (ks * 32 + fq * 8) * 2); aI = __builtin_amdgcn_mfma_f32_16x16x32_bf16(Vf, Sf[ks], aI, 0, 0, 0); }
        const bf16x4 hv = pack4((spt * aS[0] + aI[0]) * rdn, (spt * aS[1] + aI[1]) * rdn, (spt * aS[2] + aI[2]) * rdn, (spt * aS[3] + aI[3]) * rdn);
        __hip_atomic_store((unsigned long long*)(hp + vt * 16), __builtin_bit_cast(unsigned long long, hv), __ATOMIC_RELAXED, __HIP_MEMORY_SCOPE_AGENT); } }
    float nsum = 0.f;
    { bf16x8 Vf[2];
#pragma unroll
      for (int ks = 0; ks < 2; ++ks) Vf[ks] = *(const LAS bf16x8*)(VTs + (wid * 16 + fr) * 144 + (ks * 32 + fq * 8) * 2);
#pragma unroll
      for (int kt = 0; kt < 8; ++kt) { accC[kt] *= decay;
#pragma unroll
        for (int ks = 0; ks < 2; ++ks) { const bf16x8 Kf = *(const LAS bf16x8*)(KTs + (kt * 16 + fr) * 144 + (ks * 32 + fq * 8) * 2); accC[kt] = __builtin_amdgcn_mfma_f32_16x16x32_bf16(Kf, Vf[ks], accC[kt], 0, 0, 0); } }
      if (tid < 128) {
#pragma unroll
        for (int q = 0; q < 8; ++q) { const bf16x8 kv = *(const LAS bf16x8*)(KTs + tid * 144 + q * 16);
#pragma unroll
          for (int i = 0; i < 8; ++i) nsum += bf2f((u16)kv[i]); } } }
    mst = scal[1];
    __syncthreads();
#pragma unroll
    for (int kt = 0; kt < 8; ++kt) *(LAS bf16x4*)(Cs + (wid * 16 + fr) * 272 + (kt * 16 + fq * 4) * 2) = pack4(accC[kt][0], accC[kt][1], accC[kt][2], accC[kt][3]);
    if (tid < 128) nvec[tid] = decay * nvec[tid] + nsum;
  }
#undef ML_ISSUE
  if (!lat) {
    float* cpb = p.out + O_SC + sidx * 16384; const unsigned coff = (unsigned)((wid * 16 + fr) * 128 + fq * 4);
#pragma unroll
    for (int kt = 0; kt < 8; ++kt) *(f32x4*)(cpb + (coff + kt * 16)) = accC[kt];
    __syncthreads();
    if (tid < 128) p.out[O_SN + sidx * 128 + tid] = nvec[tid];
    if (tid == 0) p.out[O_SM + sidx] = mst;
  }
  asm volatile("s_waitcnt vmcnt(0)" ::: "memory");
  __syncthreads();
  LAS unsigned* flag = (LAS unsigned*)(fl + 644);
  if (tid == 0) *flag = __hip_atomic_fetch_add(p.ctr + XB_MCNT + l * 144 + (lat ? 32 + b : b) * 4 + h, 1u, __ATOMIC_RELAXED, __HIP_MEMORY_SCOPE_AGENT);
  __syncthreads();
  if (*flag == 1u) {
    const int rsub = tid >> 4, cq = tid & 15; const float* g = p.g_mlstm + l * 128 + cq * 8;
    for (int r0 = 0; r0 < T; r0 += 32) {
      const size_t row = (size_t)(seqbase + r0 + rsub); const int c = h * 128 + cq * 8;
      const unsigned long long* pf = (const unsigned long long*)(p.hdir + row * 512 + c); const unsigned long long* pb = (const unsigned long long*)(p.hdir + ((size_t)NTOK + row) * 512 + c);
      unsigned long long f0 = __hip_atomic_load(pf, __ATOMIC_RELAXED, __HIP_MEMORY_SCOPE_AGENT), f1 = __hip_atomic_load(pf + 1, __ATOMIC_RELAXED, __HIP_MEMORY_SCOPE_AGENT);
      unsigned long long b0 = __hip_atomic_load(pb, __ATOMIC_RELAXED, __HIP_MEMORY_SCOPE_AGENT), b1 = __hip_atomic_load(pb + 1, __ATOMIC_RELAXED, __HIP_MEMORY_SCOPE_AGENT);
      const bf16x8 mo = *(const bf16x8*)(p.zA + row * ZLD + 3072 + c);
      const bf16x4 hf0 = __builtin_bit_cast(bf16x4, f0), hf1 = __builtin_bit_cast(bf16x4, f1), hb0 = __builtin_bit_cast(bf16x4, b0), hb1 = __builtin_bit_cast(bf16x4, b1);
      float s[8], ss = 0.f;
#pragma unroll
      for (int i = 0; i < 4; ++i) { s[i] = bf2f((u16)hf0[i]) + bf2f((u16)hb0[i]); s[i + 4] = bf2f((u16)hf1[i]) + bf2f((u16)hb1[i]); }
#pragma unroll
      for (int i = 0; i < 8; ++i) ss += s[i] * s[i];
      ss += __shfl_xor(ss, 1); ss += __shfl_xor(ss, 2); ss += __shfl_xor(ss, 4); ss += __shfl_xor(ss, 8);
      const float rstd = rsqrtf(ss * (1.f / 128.f) + EPS);
      f32x4 o0, o1;
#pragma unroll
      for (int i = 0; i < 4; ++i) { o0[i] = s[i] * rstd * g[i] * bf2f((u16)mo[i]); o1[i] = s[i + 4] * rstd * g[i + 4] * bf2f((u16)mo[i + 4]); }
      *(bf16x8*)(p.brin + ((size_t)2 * NTOK + row) * 512 + c) = pack8(o0, o1);
    }
  }
}

__device__ void mixers_phase(const Params& p, int ci, int l, LAS unsigned char* lds, int mask = 7) {
  __shared__ int s_item;
  const int tid = tid_opaque();
  for (;;) {
    __syncthreads();
    if (tid == 0) s_item = (int)atomicAdd(p.ctr + XB_CTR + ci, 1u);
    __syncthreads();
    const int item = s_item;
    if (item >= 768) break;
    const int ty = (item < 32 || (item >= 192 && item < 256)) ? 4 : ((item < 64 || (item >= 256 && item < 512)) ? 1 : 2);
    if (!(mask & ty)) continue;
    if (ty == 4) {
      OneSched S; int ld; float scale;
      if (item < 32) { const int b = item >> 3, mt = (item >> 1) & 3, nt = item & 1; ld = 2048; scale = 1.f / sqrtf(1024.f * 128.f);
        S.u.A = (const char*)(p.cs1024 + (size_t)mt * 256 * 2048); S.u.B = (const char*)(p.Yt + (size_t)32 * 512 * 512 + (size_t)b * 512 * 2048 + (size_t)nt * 256 * 2048);
        S.u.pm = NCTX + b * 1024 + mt * 256; S.u.pn = nt; S.u.aux = 0; }
      else { const int i2 = item - 192, b = i2 >> 1, nt = i2 & 1; ld = 512; scale = 1.f / sqrtf(256.f * 128.f);
        S.u.A = (const char*)p.cs256; S.u.B = (const char*)(p.Yt + (size_t)b * 512 * 512 + (size_t)nt * 256 * 512);
        S.u.pm = b * 256; S.u.pn = nt; S.u.aux = 0; }
      EpiFour E{p.brin + (size_t)NTOK * 512, scale};
      gemm_phase<4>(lds, ld, ld, ld, S, E);
    } else if (ty == 1) mlstm_item(p, l, item < 64 ? item - 32 : 32 + (item - 256), lds);
    else attn_item(p, l, item < 192 ? item - 64 : 128 + (item - 512), lds);
  }
}

__device__ void mpost_phase(const Params& p, int l) {
  const int tid = tid_opaque(), wid = tid >> 6, lane = tid & 63;
  for (int row = blockIdx.x * 8 + wid; row < NTOK; row += gridDim.x * 8) {
    const bf16x8 hf = *(const bf16x8*)(p.hdir + (size_t)row * 512 + lane * 8), hb = *(const bf16x8*)(p.hdir + ((size_t)NTOK + row) * 512 + lane * 8);
    const bf16x8 mo = *(const bf16x8*)(p.zA + (size_t)row * ZLD + 3072 + lane * 8);
    float s[8], ss = 0.f;
#pragma unroll
    for (int i = 0; i < 8; ++i) { s[i] = bf2f((u16)hf[i]) + bf2f((u16)hb[i]); ss += s[i] * s[i]; }
    ss += __shfl_xor(ss, 1); ss += __shfl_xor(ss, 2); ss += __shfl_xor(ss, 4); ss += __shfl_xor(ss, 8);
    const float rstd = rsqrtf(ss * (1.f / 128.f) + EPS); const float* g = p.g_mlstm + l * 128 + (lane & 15) * 8; bf16x8 o;
#pragma unroll
    for (int i = 0; i < 8; ++i) o[i] = (short)f2bf(s[i] * rstd * g[i] * bf2f((u16)mo[i]));
    *(bf16x8*)(p.brin + ((size_t)2 * NTOK + row) * 512 + lane * 8) = o;
  }
}

__global__ void __launch_bounds__(512) fwd_megakernel(Params p_) {
  const Params& p = *(const Params*)(const __attribute__((address_space(4))) void*)__builtin_amdgcn_kernarg_segment_ptr();
  extern __shared__ __attribute__((aligned(16))) unsigned char shm_[];
  LAS unsigned char* lds = (LAS unsigned char*)shm_;
  cg::grid_group grid = cg::this_grid();
  const int G = gridDim.x, c = blockIdx.x;
  __shared__ uint4 xb_words; __shared__ int s_segdone[4];
  if (threadIdx.x == 0) xb_words = make_uint4(0u, 0u, 0u, 0u);
  if (threadIdx.x < 4) s_segdone[threadIdx.x] = 0;
  __syncthreads();
  const XcdBarrier xb = xcd_barrier_post(p.ctr, (volatile LAS unsigned*)&xb_words);
#define GSYNC() xcd_barrier(xb)
  if (p.out == nullptr) grid.sync();
  for (int ph = 0; ph < 25; ++ph) {
    const int l = ph == 0 ? 0 : (ph - 1) / 12, kind = ph == 0 ? -1 : (ph - 1) - l * 12;
    if (kind == 3 || kind == 9 || kind == 6 || (kind == 0 && l == 1)) continue;
    const float* md = p.mods + (size_t)l * 5 * 9216;
    int hl = -1, hs = 0;
    if (kind == -1) { phase0(p, lds); hl = 0; hs = 0; }
    else if (kind == 0) norm_phase(p, 0, 0, lds);
    else if (kind == 1 || kind == 10) {
      TileSched S{p.u, kind == 1 ? p.wt_ffn1_in : p.wt_ffn2_in, D, D, 48, 22, G, c, 256}; EpiSwiglu E{p.zA}; gemm_phase<4>(lds, D, D, D, S, E);
      if (kind == 1) { hl = l; hs = 1; } else if (l == 0) { hl = 1; hs = 0; }
    } else if (kind == 2 || kind == 11 || kind == 8) {
      const bool isout = kind == 8; const int Kd = isout ? D : DFF;
      TileSched S{isout ? p.hdir : p.zA, isout ? p.wt_out : (kind == 2 ? p.wt_ffn1_out : p.wt_ffn2_out), Kd, Kd, 64, 4, G, c, 192};
      EpiResidNorm E{p, l, kind};
      gemm_phase<3>(lds, Kd, Kd, Kd, S, E);
      if (kind == 2) { hl = l; hs = 1; }
    } else if (kind == 4) { TileSched S{p.u, p.wt_big, D, D, 48, 31, G, c, 256}; EpiBig E{p.zA, p.gb, p.Yt, p.out, l, p.gate, p.b_mgate}; gemm_phase<4>(lds, D, D, D, S, E); }
    else if (kind == 5) mixers_phase(p, l, l, lds);
    else if (kind == 6) mpost_phase(p, l);
    else { BranchSched S{p.brin, p.wt_br, G, c}; EpiBranch E{p.zA, p.gb, p.hdir}; gemm_phase<3>(lds, 512, 512, 512, S, E); }
    if (hl >= 0) prep_seg(p, hl, hs, lds, (volatile LAS int*)s_segdone);
    GSYNC();
  }
}


extern "C" void kernel_launch(void* const* d_in, const int* in_sizes, int n_in, void* d_out, int out_size, void* d_ws, size_t ws_size, hipStream_t stream) {
  static int grid_blocks = 0;
  if (!grid_blocks) {
    int dev = 0, cus = 0, per_cu = 0;
    hipGetDevice(&dev);
    hipDeviceGetAttribute(&cus, hipDeviceAttributeMultiprocessorCount, dev);
    hipFuncSetAttribute((const void*)fwd_megakernel, hipFuncAttributeMaxDynamicSharedMemorySize, LDS_BYTES);
    hipOccupancyMaxActiveBlocksPerMultiprocessor(&per_cu, (const void*)fwd_megakernel, 512, LDS_BYTES);
    if (per_cu < 1) per_cu = 1;
    grid_blocks = cus * 1;
    (void)hipGetLastError();
  }
  Params p{};
  const float** ip = (const float**)&p;
  for (int i = 0; i < 27; ++i) ip[i] = (const float*)d_in[i];
  p.out = (float*)d_out;
  char* w = (char*)d_ws; size_t off = 0;
  auto take = [&](size_t bytes) { char* r = w + off; off += (bytes + 255) & ~(size_t)255; return r; };
  p.wt_ffn1_in = (u16*)take((size_t)2 * DFF * D * 2); p.wt_ffn1_out = (u16*)take((size_t)D * DFF * 2);
  p.wt_ffn2_in = (u16*)take((size_t)2 * DFF * D * 2); p.wt_ffn2_out = (u16*)take((size_t)D * DFF * 2);
  p.wt_big = (u16*)take((size_t)NBIG * D * 2); p.wt_br = (u16*)take((size_t)3 * D * 512 * 2); p.wt_out = (u16*)take((size_t)D * D * 2);
  p.u = (u16*)take((size_t)NTOK * D * 2);
  p.zA = (u16*)take((size_t)NTOK * ZLD * 2); p.gb = (u16*)take((size_t)NTOK * GBLD * 2);
  p.Yt = (u16*)take((size_t)NTOK * 1024 * 2); p.brin = (u16*)take((size_t)3 * NTOK * 512 * 2); p.hdir = (u16*)take((size_t)2 * NTOK * 512 * 2);
  p.cs1024 = (u16*)take((size_t)1024 * 2048 * 2); p.cs256 = (u16*)take((size_t)256 * 512 * 2);
  p.mods = (float*)take((size_t)2 * 5 * 9216 * 4); p.gate = (float*)take((size_t)NTOK * 16 * 4); p.rope = (float*)take((size_t)1024 * 32 * 2 * 4);
  p.lam = (float*)take(256); p.part = (float*)take((size_t)6 * 48 * 4 * 256 * 4); p.ctr = (unsigned*)take(BAR_TOTAL_WORDS * 4);
  if (off > ws_size) { fprintf(stderr, "kernel_launch: workspace too small: need %zu have %zu\n", off, ws_size); return; }
  if (hipMemsetAsync(p.ctr, 0, BAR_TOTAL_WORDS * 4, stream) != hipSuccess) { fprintf(stderr, "memset failed\n"); return; }
  void* args[] = {&p};
  hipError_t e = hipLaunchCooperativeKernel((const void*)fwd_megakernel, dim3(grid_blocks), dim3(512), args, LDS_BYTES, stream);
  if (e != hipSuccess) fprintf(stderr, "cooperative launch failed: %s (grid %d)\n", hipGetErrorString(e), grid_blocks);
}
```
